# Optimizing an MI355X kernel written in HIP

```python
import jax, jax.numpy as jnp
from jax import lax
import numpy as np

D_MODEL = 2048
BATCH = 4
SEQ = 8192
DEPTH = 2
DEC_BATCH = 8
DEC_SEQ = 64
PAST_LEN = 1024

CHUNK = 64
N_EVEN = (DEPTH + 1) // 2
N_ODD = DEPTH // 2
D_FF = 5632
A_WIDTH = D_MODEL // 2
A_GROUPS = 4
A_GROUP_DIM = A_WIDTH // A_GROUPS
A_CHUNK = 128
B_WIDTH = D_MODEL // 2
B_CONV_WIDTH = 31
B_HIST = B_CONV_WIDTH - 1
C_WINDOWS = (2, 4, 8, 16)
C_GROUPS = 4
C_GROUP_DIM = D_MODEL // C_GROUPS
C_HIST = max(C_WINDOWS) - 1
MIX_IN = 2 * A_WIDTH + 2 * B_WIDTH
MIX_OUT = A_WIDTH + B_WIDTH
EPS = 1e-6

kernel_name = 'chunk_causal_gmlp_conformer_pool_stream_step'


def rms_norm(x, g):
    xf = x.astype(jnp.float32)
    y = xf * lax.rsqrt(jnp.mean(xf * xf, axis=-1, keepdims=True) + EPS)
    return (y * g.astype(jnp.float32)).astype(x.dtype)


def layer_norm(x, g, b):
    xf = x.astype(jnp.float32)
    mu = jnp.mean(xf, axis=-1, keepdims=True)
    d = xf - mu
    var = jnp.mean(d * d, axis=-1, keepdims=True)
    y = d * lax.rsqrt(var + EPS) * g.astype(jnp.float32) + b.astype(jnp.float32)
    return y.astype(x.dtype)


def modulate(xn, shift, scale):
    return xn * (1 + scale[:, None, :]) + shift[:, None, :]


def swiglu(x, wg, wu, wd):
    return (jax.nn.silu(x @ wg) * (x @ wu)) @ wd


def chunk_mask():
    i = jnp.arange(A_CHUNK)
    return (i[None, :] // CHUNK) <= (i[:, None] // CHUNK)


def spatial_gating(vn, ws, bs):
    w = jnp.where(chunk_mask()[None], ws, 0)
    bsz, T = vn.shape[0], vn.shape[1]
    if T >= A_CHUNK:
        vc = vn.reshape(bsz, T // A_CHUNK, A_CHUNK, A_GROUPS, A_GROUP_DIM)
        out = jnp.einsum('gij,bnjgc->bnigc', w, vc) + bs.T[None, None, :, :, None]
        return out.reshape(bsz, T, A_GROUPS, A_GROUP_DIM)
    return jnp.einsum('gij,bjgc->bigc', w[:, :T, :T], vn) + bs[:, :T].T[None, :, :, None]


def mixer_ab(hm, conv_hist, w_in, v_g, v_b, ws, bs, dw, ln_g, ln_b, w_out):
    bsz, T, _ = hm.shape
    proj = hm @ w_in
    a_u, a_v = jnp.split(jax.nn.gelu(proj[..., :2 * A_WIDTH]), 2, axis=-1)
    b_a, b_g = jnp.split(proj[..., 2 * A_WIDTH:], 2, axis=-1)
    vn = layer_norm(a_v, v_g, v_b)
    gate = spatial_gating(vn.reshape(bsz, T, A_GROUPS, A_GROUP_DIM), ws, bs)
    a_out = a_u * gate.reshape(bsz, T, A_WIDTH)
    glu = b_a * jax.nn.sigmoid(b_g)
    xpad = jnp.concatenate([conv_hist.astype(glu.dtype), glu], axis=1)
    conv = lax.conv_general_dilated(
        xpad, dw[:, None, :].astype(xpad.dtype), window_strides=(1,), padding='VALID',
        dimension_numbers=('NWC', 'WIO', 'NWC'), feature_group_count=B_WIDTH)
    b_out = jax.nn.silu(layer_norm(conv, ln_g, ln_b))
    y = jnp.concatenate([a_out, b_out], axis=-1) @ w_out
    return y, vn, xpad[:, -B_HIST:]


def mixer_c(hm, pool_hist, start_pos, w_grp, b_grp, scale):
    bsz, T, _ = hm.shape
    xpad = jnp.concatenate([pool_hist.astype(hm.dtype), hm], axis=1)
    csum = jnp.concatenate([jnp.zeros((bsz, 1, D_MODEL), jnp.float32),
                            jnp.cumsum(xpad.astype(jnp.float32), axis=1)], axis=1)
    end = csum[:, C_HIST + 1:]
    pos = start_pos + jnp.arange(T)
    pooled = []
    for g, w in enumerate(C_WINDOWS):
        sl = slice(g * C_GROUP_DIM, (g + 1) * C_GROUP_DIM)
        s = end[..., sl] - csum[:, C_HIST + 1 - w:C_HIST + 1 - w + T, sl]
        cnt = jnp.minimum(w, pos + 1).astype(jnp.float32)
        pooled.append(s / cnt[None, :, None])
    pooled = (jnp.concatenate(pooled, axis=-1) - hm.astype(jnp.float32)).astype(hm.dtype)
    pg = pooled.reshape(bsz, T, C_GROUPS, C_GROUP_DIM)
    y = jnp.einsum('btgc,gcd->btgd', pg, w_grp) + b_grp
    return y.reshape(bsz, T, D_MODEL) * scale, xpad[:, -C_HIST:]


def run_trunk(x, c, start_pos, conv_hist, pool_hist, p):
    h = x
    new_conv, new_pool, new_av = [], [], []
    for l in range(DEPTH):
        mod = (jax.nn.silu(c) @ p['ada_w'][l] + p['ada_b'][l]).reshape(c.shape[0], 3, 3, D_MODEL)
        hn = modulate(rms_norm(h, p['norm_g'][l, 0]), mod[:, 0, 0], mod[:, 0, 1])
        h = h + 0.5 * mod[:, 0, 2][:, None] * swiglu(
            hn, p['ffn_w_gate'][l, 0], p['ffn_w_up'][l, 0], p['ffn_w_down'][l, 0])
        hn = modulate(rms_norm(h, p['norm_g'][l, 1]), mod[:, 1, 0], mod[:, 1, 1])
        if l % 2 == 0:
            e = l // 2
            y, vn, ch = mixer_ab(hn, conv_hist[e], p['ab_w_in'][e], p['a_v_norm_g'][e],
                                 p['a_v_norm_b'][e], p['a_ws'][e], p['a_bs'][e], p['b_dw'][e],
                                 p['b_ln_g'][e], p['b_ln_b'][e], p['ab_w_out'][e])
            new_conv.append(ch)
            new_av.append(vn)
        else:
            o = l // 2
            y, ph = mixer_c(hn, pool_hist[o], start_pos, p['c_w_grp'][o], p['c_b_grp'][o],
                            p['c_scale'][o])
            new_pool.append(ph)
        h = h + mod[:, 1, 2][:, None] * y
        hn = modulate(rms_norm(h, p['norm_g'][l, 2]), mod[:, 2, 0], mod[:, 2, 1])
        h = h + 0.5 * mod[:, 2, 2][:, None] * swiglu(
            hn, p['ffn_w_gate'][l, 1], p['ffn_w_up'][l, 1], p['ffn_w_down'][l, 1])
    return rms_norm(h, p['final_norm_g']), jnp.stack(new_conv), jnp.stack(new_pool), jnp.stack(new_av)


def setup_inputs(seed: int = 0) -> dict:
    key = jax.random.key(seed)
    ks = jax.random.split(key, 25)
    f32 = jnp.float32

    def nrm(k, shape, s):
        return jax.random.normal(k, shape, f32) * s

    ada_b = nrm(ks[7], (DEPTH, 3, 3, D_MODEL), 0.02).at[:, :, 2].add(1.0).reshape(DEPTH, 9 * D_MODEL)
    return {
        'x_prompt': nrm(ks[0], (BATCH, SEQ, D_MODEL), 1.0),
        'x_sample': nrm(ks[1], (DEC_BATCH, DEC_SEQ, D_MODEL), 1.0),
        'c_prompt': nrm(ks[2], (BATCH, D_MODEL), 1.0),
        'c_sample': nrm(ks[3], (DEC_BATCH, D_MODEL), 1.0),
        'state_conv_b': nrm(ks[4], (N_EVEN, DEC_BATCH, B_HIST, B_WIDTH), 0.5),
        'state_pool_c': nrm(ks[5], (N_ODD, DEC_BATCH, C_HIST, D_MODEL), 1.0),
        'ada_w': nrm(ks[6], (DEPTH, D_MODEL, 9 * D_MODEL), 0.25 * D_MODEL ** -0.5),
        'ada_b': ada_b,
        'norm_g': 1.0 + nrm(ks[8], (DEPTH, 3, D_MODEL), 0.02),
        'final_norm_g': 1.0 + nrm(ks[9], (D_MODEL,), 0.02),
        'ffn_w_gate': nrm(ks[10], (DEPTH, 2, D_MODEL, D_FF), D_MODEL ** -0.5),
        'ffn_w_up': nrm(ks[11], (DEPTH, 2, D_MODEL, D_FF), D_MODEL ** -0.5),
        'ffn_w_down': nrm(ks[12], (DEPTH, 2, D_FF, D_MODEL), D_FF ** -0.5),
        'ab_w_in': nrm(ks[13], (N_EVEN, D_MODEL, MIX_IN), D_MODEL ** -0.5),
        'a_v_norm_g': 1.0 + nrm(ks[14], (N_EVEN, A_WIDTH), 0.02),
        'a_v_norm_b': nrm(ks[15], (N_EVEN, A_WIDTH), 0.02),
        'a_ws': nrm(ks[16], (N_EVEN, A_GROUPS, A_CHUNK, A_CHUNK), A_CHUNK ** -0.5),
        'a_bs': 1.0 + nrm(ks[17], (N_EVEN, A_GROUPS, A_CHUNK), 0.02),
        'b_dw': nrm(ks[18], (N_EVEN, B_CONV_WIDTH, B_WIDTH), B_CONV_WIDTH ** -0.5),
        'b_ln_g': 1.0 + nrm(ks[19], (N_EVEN, B_WIDTH), 0.02),
        'b_ln_b': nrm(ks[20], (N_EVEN, B_WIDTH), 0.02),
        'ab_w_out': nrm(ks[21], (N_EVEN, MIX_OUT, D_MODEL), MIX_OUT ** -0.5),
        'c_w_grp': nrm(ks[22], (N_ODD, C_GROUPS, C_GROUP_DIM, C_GROUP_DIM), C_GROUP_DIM ** -0.5),
        'c_b_grp': nrm(ks[23], (N_ODD, C_GROUPS, C_GROUP_DIM), 0.02),
        'c_scale': 1.0 + nrm(ks[24], (N_ODD, D_MODEL), 0.02),
    }


def reference(x_prompt, x_sample, c_prompt, c_sample, state_conv_b, state_pool_c,
              ada_w, ada_b, norm_g, final_norm_g, ffn_w_gate, ffn_w_up, ffn_w_down,
              ab_w_in, a_v_norm_g, a_v_norm_b, a_ws, a_bs, b_dw, b_ln_g, b_ln_b, ab_w_out,
              c_w_grp, c_b_grp, c_scale):
    p = {
        'ada_w': ada_w, 'ada_b': ada_b, 'norm_g': norm_g, 'final_norm_g': final_norm_g,
        'ffn_w_gate': ffn_w_gate, 'ffn_w_up': ffn_w_up, 'ffn_w_down': ffn_w_down,
        'ab_w_in': ab_w_in, 'a_v_norm_g': a_v_norm_g, 'a_v_norm_b': a_v_norm_b,
        'a_ws': a_ws, 'a_bs': a_bs, 'b_dw': b_dw, 'b_ln_g': b_ln_g, 'b_ln_b': b_ln_b,
        'ab_w_out': ab_w_out, 'c_w_grp': c_w_grp, 'c_b_grp': c_b_grp, 'c_scale': c_scale,
    }
    bp = x_prompt.shape[0]
    conv0 = jnp.zeros((N_EVEN, bp, B_HIST, B_WIDTH), x_prompt.dtype)
    pool0 = jnp.zeros((N_ODD, bp, C_HIST, D_MODEL), x_prompt.dtype)
    y_prompt, new_conv_prompt, new_pool_prompt, _ = run_trunk(
        x_prompt, c_prompt, 0, conv0, pool0, p)
    y_sample, new_conv_sample, new_pool_sample, new_av_sample = run_trunk(
        x_sample, c_sample, PAST_LEN, state_conv_b, state_pool_c, p)
    return (y_prompt, y_sample, new_conv_prompt, new_conv_sample,
            new_pool_prompt, new_pool_sample, new_av_sample)
```

```cpp
#include <hip/hip_runtime.h>
#include <cstdio>
#include <cstdint>

#ifndef MK_N_LAUNCHES
#define MK_N_LAUNCHES 1
#endif

#ifndef DUP_MASK
#define DUP_MASK 0u
#endif

constexpr int D = 2048, DFF = 5632, NPR = 4 * 8192, NSR = 8 * 64, M = NPR + NSR;
constexpr int NSTREAM = 12, MODS = 9 * D, MODL = NSTREAM * MODS;
constexpr int AW = 1024;
constexpr float EPS = 1e-6f;

constexpr size_t MiB = 1u << 20;
constexpr size_t WS_CTL = 0, CTL_ZERO_BYTES = 4 * MiB;
constexpr size_t WS_VSTAT = 64 * 1024;
constexpr size_t WS_MOD = 1 * MiB;
constexpr size_t WS_SS = 3 * MiB;
constexpr size_t WS_SB = 4 * MiB + 512 * 1024;
constexpr size_t WS_WM = 4 * MiB;
constexpr size_t WS_WGU = 8 * MiB;
constexpr size_t WS_WD = 184 * MiB;
constexpr size_t WS_WIN = 272 * MiB;
constexpr size_t WS_WOUT = 288 * MiB;
constexpr size_t WS_WC = 296 * MiB;
constexpr size_t WS_HN = 300 * MiB;
constexpr size_t WS_ACT = 432 * MiB;
constexpr size_t WS_U = WS_ACT, WS_V = WS_ACT + 65 * MiB, WS_GLU = WS_ACT + 130 * MiB, WS_CAT = WS_ACT + 195 * MiB, WS_PC = WS_ACT;
constexpr size_t WS_SLAB = 790 * MiB;
constexpr size_t WS_END = 836 * MiB;
constexpr size_t WS_DUMMY = 840 * MiB;
static_assert(WS_SLAB + (size_t)11 * NSR * D * 4 <= WS_END, "slab map");
static_assert(WS_VSTAT + (size_t)M * 8 <= WS_MOD && WS_MOD + (size_t)2 * MODL * 4 <= WS_SS && WS_SS + (size_t)6 * M * 4 <= CTL_ZERO_BYTES && WS_WM + 4 * 128 * 128 * 2 <= WS_SB && WS_SB + (size_t)5 * 12 * 11264 * 4 <= WS_WGU, "ctl map");
static_assert(WS_WGU + 4 * (size_t)11264 * 2048 * 2 <= WS_WD && WS_WD + 4 * (size_t)2048 * 5632 * 2 <= WS_WIN && WS_WIN + (size_t)4096 * 2048 * 2 <= WS_WOUT, "weights map");
static_assert(WS_HN + (size_t)M * D * 2 <= WS_ACT && WS_ACT + (size_t)M * DFF * 2 <= WS_END && WS_CAT + (size_t)M * D * 2 <= WS_END && (size_t)M * AW * 2 <= 65 * MiB, "act map");
constexpr int CW_TMO = 0, CW_BAR = 4096;

constexpr size_t O_Y = 0, O_NCP = (size_t)M * D, O_NCS = O_NCP + 4 * 30 * 1024, O_NPP = O_NCS + 8 * 30 * 1024, O_NPS = O_NPP + 4 * 15 * 2048, O_NAV = O_NPS + 8 * 15 * 2048, O_END = O_NAV + 8 * 64 * 1024;

constexpr int RING_BYTES = 131072, LDSCTL_OFF = RING_BYTES, MISC_OFF = LDSCTL_OFF + 320, LDS_BYTES = 147456;
constexpr int NWAVES = 8;

#define GAS __attribute__((address_space(1)))
#define LAS __attribute__((address_space(3)))
typedef unsigned short bf16;
typedef unsigned v4u __attribute__((ext_vector_type(4)));
typedef unsigned v2u __attribute__((ext_vector_type(2)));
typedef float f32x4 __attribute__((ext_vector_type(4)));
typedef float f32x2 __attribute__((ext_vector_type(2)));
typedef short bf16x8 __attribute__((ext_vector_type(8)));
#define LDS_WAIT() asm volatile("s_waitcnt lgkmcnt(0)" ::: "memory")
#define VM_WAIT() asm volatile("s_waitcnt vmcnt(0)" ::: "memory")

__device__ __forceinline__ unsigned f2bf(float f) { unsigned u = __builtin_bit_cast(unsigned, f); return (u + 0x7fffu + ((u >> 16) & 1u)) >> 16; }
__device__ __forceinline__ unsigned pk2(float lo, float hi) { return f2bf(lo) | (f2bf(hi) << 16); }
__device__ __forceinline__ unsigned cvt_pk_bf16(float lo, float hi) { unsigned r; asm volatile("v_cvt_pk_bf16_f32 %0, %1, %2" : "=v"(r) : "v"(lo), "v"(hi)); return r; }
__device__ __forceinline__ float bflo(unsigned w) { return __builtin_bit_cast(float, w << 16); }
__device__ __forceinline__ float bfhi(unsigned w) { return __builtin_bit_cast(float, w & 0xffff0000u); }
__device__ __forceinline__ float sigmoidf_(float x) { return __builtin_amdgcn_rcpf(1.0f + __builtin_amdgcn_exp2f(-1.4426950409f * x)); }
__device__ __forceinline__ float siluf_(float x) { return x * sigmoidf_(x); }
__device__ __forceinline__ float gelu_tanh(float x) { return x * __builtin_amdgcn_rcpf(1.0f + __builtin_amdgcn_exp2f(-2.302208198f * x * (1.0f + 0.044715f * x * x))); }
__device__ __forceinline__ float wave_sum(float v) {
#pragma unroll
    for (int o = 1; o < 64; o <<= 1) v += __shfl_xor(v, o);
    return v;
}
__device__ __forceinline__ int stream_of_row(int r) { return r < NPR ? (r >> 13) : 4 + ((r - NPR) >> 6); }

namespace pg8 {
typedef unsigned short bf16_t;
constexpr int BM = 256, BK = 64, HALF = 128, HTB = HALF * BK * 2, STAGE_BYTES = 8 * HTB, NXCD = 8, WGM = 8;
__host__ __device__ __forceinline__ int lds_byte(int r, int c) { const int st = (r >> 4) * 2 + (c >> 5), rr = r & 15, cc = c & 31, ob = rr * 64 + cc * 2; return st * 1024 + (ob ^ (((ob >> 9) & 1) << 5)); }
__host__ __device__ __forceinline__ void stage_rc(int b, int& R, int& C) { const int st = b / 1024, sb = b % 1024, swz = sb ^ (((sb >> 9) & 1) << 5); R = (st >> 1) * 16 + swz / 64; C = (st & 1) * 32 + (swz % 64) / 2; }
__host__ __device__ __forceinline__ int perm32(int rho) { const int n = rho >> 4, i = rho & 15; return 8 * (i >> 2) + 4 * n + (i & 3); }

struct Unit { int pm, pn, kt0, ktn, slab; };
struct Gemm { const bf16_t* A; const bf16_t* Bt; int M, N, K, lda, tpg; };

struct StaticOrder {
    int nMp, nMt, nN, nwgP, nTail, G, c, ntk, ksplit, ktper, wgm;
    __host__ __device__ void init(int Mp, int Mt, int N_, int K_, int G_, int c_, int ksplit_, int wgm_ = WGM) { wgm = wgm_; nMp = Mp / BM; nMt = Mt / BM; nN = N_ / BM; nwgP = nMp * nN; G = G_; c = c_; ntk = K_ / BK; ksplit = ksplit_; ktper = ntk / ksplit_; nTail = nMt * nN * ksplit_; }
    __host__ __device__ bool next(int i, Unit& u) const {
        const long L = (long)i * G + c;
        if (L < nwgP) {
            int wgid = (int)L; { const int q = nwgP / NXCD, r = nwgP % NXCD, xcd = wgid % NXCD, off = wgid / NXCD; wgid = (xcd < r ? xcd * (q + 1) : r * (q + 1) + (xcd - r) * q) + off; }
            const int nig = wgm * nN, gid = wgid / nig, fm = gid * wgm, gsz = (nMp - fm) < wgm ? (nMp - fm) : wgm;
            u.pm = fm + ((wgid % nig) % gsz); u.pn = (wgid % nig) / gsz; u.kt0 = 0; u.ktn = ntk; u.slab = -1; return true;
        }
        const long j = L - nwgP; if (j >= nTail) return false;
        const int kc = (int)j % ksplit, t = (int)j / ksplit;
        u.pm = nMp + t / nN; u.pn = t % nN; u.kt0 = kc * ktper; u.ktn = ktper; u.slab = ksplit > 1 ? kc : -1; return true;
    }
};


struct EpiSwiGLU {
    static constexpr bool PERM = true;
    bf16_t* O; int ldc; const float* ss; const float* sb;
    __device__ __forceinline__ void preload(const Unit& u, float (&pre)[8], int wr, int fr) const {
#pragma unroll
        for (int i = 0; i < 8; ++i) pre[i] = ss ? ss[u.pm * BM + wr * 64 + fr + (i >> 2) * HALF + (i & 3) * 16] : 0.f; }
    __device__ __forceinline__ void operator()(const f32x4 (&acc)[2][2][4][2], const Unit& u, int wr, int wc, int fr, int fq, const float (&pre)[8]) const {
        const int row0 = u.pm * BM + wr * 64 + fr, col0 = u.pn * HALF + wc * 32 + 8 * fq, wrow0 = u.pn * BM + wc * 32 + 8 * fq;
#pragma unroll
        for (int ai = 0; ai < 2; ++ai) {
            f32x4 sg0 = (f32x4){0.f, 0.f, 0.f, 0.f}, sg1 = sg0, su0 = sg0, su1 = sg0;
            if (ss) { const float* sp = sb + (size_t)stream_of_row(u.pm * BM + ai * HALF + wr * 64) * 11264 + wrow0;
                sg0 = *(const f32x4*)sp; sg1 = *(const f32x4*)(sp + 4); su0 = *(const f32x4*)(sp + HALF); su1 = *(const f32x4*)(sp + HALF + 4); }
#pragma unroll
            for (int m = 0; m < 4; ++m) {
                const int r = row0 + ai * HALF + m * 16;
                const float rstd = ss ? rsqrtf(pre[ai * 4 + m] * (1.0f / D) + EPS) : 1.0f;
                bf16_t* rowp = O + (size_t)r * ldc + col0;
                const f32x4 g0 = acc[ai][0][m][0] * rstd + sg0, g1 = acc[ai][0][m][1] * rstd + sg1, u0 = acc[ai][1][m][0] * rstd + su0, u1 = acc[ai][1][m][1] * rstd + su1;
                v4u w;
                w.x = cvt_pk_bf16(siluf_(g0[0]) * u0[0], siluf_(g0[1]) * u0[1]); w.y = cvt_pk_bf16(siluf_(g0[2]) * u0[2], siluf_(g0[3]) * u0[3]);
                w.z = cvt_pk_bf16(siluf_(g1[0]) * u1[0], siluf_(g1[1]) * u1[1]); w.w = cvt_pk_bf16(siluf_(g1[2]) * u1[2], siluf_(g1[3]) * u1[3]);
                __builtin_nontemporal_store(w, (v4u*)rowp);
            }
        }
    }
};

template <bool HB> struct EpiRes {
    static constexpr bool PERM = true;
    const float* base_p; const float* base_s; float* out; const float* gate; const float* bias; const float* cs; float* slab; bf16_t* an; const float* ng_n; const float* sc_n; float* ss; float alpha; int pad_;
    __device__ __forceinline__ void preload(const Unit&, float (&)[8], int, int) const {}
    __device__ __forceinline__ void operator()(const f32x4 (&acc)[2][2][4][2], const Unit& u, int wr, int wc, int fr, int fq, const float (&)[8]) const {
        const int col0 = u.pn * BM + wc * 32 + 8 * fq;
#pragma unroll
        for (int ai = 0; ai < 2; ++ai) {
            const int rbase = u.pm * BM + ai * HALF + wr * 64;
            const int s = stream_of_row(rbase);
            float q[4] = {0.f, 0.f, 0.f, 0.f};
#pragma unroll
            for (int bj = 0; bj < 2; ++bj) {
                const int c = col0 + bj * HALF;
                f32x4 gv[2], bv[2], gn[2];
#pragma unroll
                for (int n = 0; n < 2; ++n) { gv[n] = *(const f32x4*)(gate + (size_t)s * MODS + c + 4 * n) * alpha; bv[n] = (f32x4){0.f, 0.f, 0.f, 0.f}; gn[n] = bv[n];
                    if (HB) { gv[n] = gv[n] * *(const f32x4*)(cs + c + 4 * n); bv[n] = *(const f32x4*)(bias + c + 4 * n); }
                    if (an) gn[n] = *(const f32x4*)(ng_n + c + 4 * n) * (*(const f32x4*)(sc_n + (size_t)s * MODS + c + 4 * n) + 1.0f); }
#pragma unroll
                for (int m = 0; m < 4; ++m) {
                    const int r = rbase + m * 16 + fr;
                    if (u.slab >= 0) {
                        float* sp = slab + ((size_t)u.slab * NSR + (size_t)(r - NPR)) * D + c;
                        *(f32x4*)sp = gv[0] * (acc[ai][bj][m][0] + bv[0]); *(f32x4*)(sp + 4) = gv[1] * (acc[ai][bj][m][1] + bv[1]);
                    } else {
                        const float* bp = ((rbase < NPR) ? base_p + (size_t)r * D : base_s + (size_t)(r - NPR) * D) + c;
                        const f32x4 o0 = *(const f32x4*)bp + gv[0] * (acc[ai][bj][m][0] + bv[0]), o1 = *(const f32x4*)(bp + 4) + gv[1] * (acc[ai][bj][m][1] + bv[1]);
                        float* op = out + (size_t)r * D + c; *(f32x4*)op = o0; *(f32x4*)(op + 4) = o1;
                        if (ss) q[m] += ((o0[0] * o0[0] + o0[1] * o0[1]) + (o0[2] * o0[2] + o0[3] * o0[3])) + ((o1[0] * o1[0] + o1[1] * o1[1]) + (o1[2] * o1[2] + o1[3] * o1[3]));
                        if (an) { const f32x4 t0 = o0 * gn[0], t1 = o1 * gn[1]; v4u w; w.x = cvt_pk_bf16(t0[0], t0[1]); w.y = cvt_pk_bf16(t0[2], t0[3]); w.z = cvt_pk_bf16(t1[0], t1[1]); w.w = cvt_pk_bf16(t1[2], t1[3]);
                            *(v4u*)(an + (size_t)r * D + c) = w; }
                    }
                }
            }
            if (ss && u.slab < 0) {
#pragma unroll
                for (int m = 0; m < 4; ++m) { float t = q[m]; t += __shfl_xor(t, 16); t += __shfl_xor(t, 32); if (fq == 0) unsafeAtomicAdd(ss + rbase + m * 16 + fr, t); } }
        }
    }
};

struct EpiInProj {
    static constexpr bool PERM = true;
    bf16_t *U, *V, *GLU; float* vstat; float* ncp; float* ncs; const float* ss; const float* sb;
    __device__ __forceinline__ void preload(const Unit& u, float (&pre)[8], int wr, int fr) const {
#pragma unroll
        for (int i = 0; i < 8; ++i) pre[i] = ss[u.pm * BM + wr * 64 + fr + (i >> 2) * HALF + (i & 3) * 16]; }
    __device__ __forceinline__ void operator()(const f32x4 (&acc)[2][2][4][2], const Unit& u, int wr, int wc, int fr, int fq, const float (&pre)[8]) const {
        const int row0 = u.pm * BM + wr * 64 + fr;
        if (u.pn < 8) {
            const bool isv = u.pn >= 4; bf16_t* O = isv ? V : U; const int col0 = (u.pn & 3) * BM + wc * 32 + 8 * fq;
#pragma unroll
            for (int ai = 0; ai < 2; ++ai) {
                const float* sp = sb + (size_t)stream_of_row(u.pm * BM + ai * HALF + wr * 64) * 4096 + u.pn * BM + wc * 32 + 8 * fq;
                f32x4 sv[2][2];
#pragma unroll
                for (int bj = 0; bj < 2; ++bj) { sv[bj][0] = *(const f32x4*)(sp + bj * HALF); sv[bj][1] = *(const f32x4*)(sp + bj * HALF + 4); }
#pragma unroll
                for (int m = 0; m < 4; ++m) { const int r = row0 + ai * HALF + m * 16; float s1 = 0.f, s2 = 0.f;
                    const float rstd = rsqrtf(pre[ai * 4 + m] * (1.0f / D) + EPS);
#pragma unroll
                    for (int bj = 0; bj < 2; ++bj) { f32x4 v0 = acc[ai][bj][m][0] * rstd + sv[bj][0], v1 = acc[ai][bj][m][1] * rstd + sv[bj][1];
#pragma unroll
                        for (int j = 0; j < 4; ++j) { v0[j] = gelu_tanh(v0[j]); v1[j] = gelu_tanh(v1[j]); s1 += v0[j] + v1[j]; s2 += v0[j] * v0[j] + v1[j] * v1[j]; }
                        v4u w; w.x = cvt_pk_bf16(v0[0], v0[1]); w.y = cvt_pk_bf16(v0[2], v0[3]); w.z = cvt_pk_bf16(v1[0], v1[1]); w.w = cvt_pk_bf16(v1[2], v1[3]);
                        *(v4u*)(O + (size_t)r * AW + col0 + bj * HALF) = w; }
                    if (isv) { s1 += __shfl_xor(s1, 16); s1 += __shfl_xor(s1, 32); s2 += __shfl_xor(s2, 16); s2 += __shfl_xor(s2, 32);
                        if (fq == 0) { unsafeAtomicAdd(vstat + 2 * (size_t)r, s1); unsafeAtomicAdd(vstat + 2 * (size_t)r + 1, s2); } }
                }
            }
        } else {
            const int col0 = (u.pn - 8) * HALF + wc * 32 + 8 * fq;
#pragma unroll
            for (int ai = 0; ai < 2; ++ai) {
                const int rbase = u.pm * BM + ai * HALF + wr * 64;
                const bool tailp = (rbase < NPR) && ((rbase & 8191) == 8128), tails = rbase >= NPR;
                const float* sp = sb + (size_t)stream_of_row(rbase) * 4096 + u.pn * BM + wc * 32 + 8 * fq;
                const f32x4 sa0 = *(const f32x4*)sp, sa1 = *(const f32x4*)(sp + 4), sg0 = *(const f32x4*)(sp + HALF), sg1 = *(const f32x4*)(sp + HALF + 4);
#pragma unroll
                for (int m = 0; m < 4; ++m) { const int r = rbase + m * 16 + fr;
                    const float rstd = rsqrtf(pre[ai * 4 + m] * (1.0f / D) + EPS);
                    const f32x4 a0 = acc[ai][0][m][0] * rstd + sa0, a1 = acc[ai][0][m][1] * rstd + sa1, g0 = acc[ai][1][m][0] * rstd + sg0, g1 = acc[ai][1][m][1] * rstd + sg1;
                    f32x4 o0, o1;
#pragma unroll
                    for (int j = 0; j < 4; ++j) { o0[j] = a0[j] * sigmoidf_(g0[j]); o1[j] = a1[j] * sigmoidf_(g1[j]); }
                    v4u w; w.x = cvt_pk_bf16(o0[0], o0[1]); w.y = cvt_pk_bf16(o0[2], o0[3]); w.z = cvt_pk_bf16(o1[0], o1[1]); w.w = cvt_pk_bf16(o1[2], o1[3]);
                    *(v4u*)(GLU + (size_t)r * AW + col0) = w;
                    if (tailp) { const int t = r & 8191; if (t >= 8162) { float* dst = ncp + ((size_t)((r >> 13) * 30 + (t - 8162)) * 1024 + col0); *(f32x4*)dst = o0; *(f32x4*)(dst + 4) = o1; } }
                    if (tails) { const int rr = r - NPR, t = rr & 63; if (t >= 34) { float* dst = ncs + ((size_t)((rr >> 6) * 30 + (t - 34)) * 1024 + col0); *(f32x4*)dst = o0; *(f32x4*)(dst + 4) = o1; } }
                }
            }
        }
    }
};

template <class Epi, bool ALIGN_EPI>
__device__ __forceinline__ void gemm_phase(LAS unsigned char* lds, const Gemm g, const StaticOrder& S, const Epi& E) {
    int tid_ = threadIdx.x; asm volatile("" : "+v"(tid_));
    const int tid = tid_, wid = __builtin_amdgcn_readfirstlane(tid >> 6), lane = tid & 63, wr = wid >> 2, wc = wid & 3, fr = lane & 15, fq = lane >> 4;
    const int K = g.K;
    unsigned voffA[2], voffB[2];
#pragma unroll
    for (int i = 0; i < 2; ++i) { int R, C; stage_rc(tid * 16 + i * 8192, R, C); const int Rb = Epi::PERM ? ((R & ~31) + perm32(R & 31)) : R;
        voffA[i] = (unsigned)(R * g.lda + C) * 2u; voffB[i] = (unsigned)(Rb * K + C) * 2u; }
    const size_t kstep = (size_t)(BK * 2);
    const size_t hA = (size_t)HALF * g.lda * 2, hB = (size_t)HALF * K * 2;
    const size_t tA = 2 * hA, tB = 2 * hB;
    const unsigned ldsw = (unsigned)wid * 1024u;
    const int aoff = lds_byte(wr * 64 + fr, fq * 8), boff = lds_byte(wc * 32 + fr, fq * 8);
#define PG8_SA(b, h) (((b) * 2 + (h)) * HTB)
#define PG8_SB(b, h) ((4 + (b) * 2 + (h)) * HTB)
#define PG8_STAGE(bufoff, gbase, voff) do { _Pragma("unroll") for (int _i = 0; _i < 2; ++_i) \
        __builtin_amdgcn_global_load_lds((const unsigned*)((const char*)(gbase) + (voff)[_i]), (LAS unsigned*)(lds + (bufoff) + ldsw + _i * 8192), 16, 0, 0); } while (0)
#define PG8_LDA(dst, b, h) do { _Pragma("unroll") for (int m = 0; m < 4; ++m) _Pragma("unroll") for (int k = 0; k < 2; ++k) dst[m][k] = *(const LAS bf16x8*)(lds + PG8_SA(b, h) + aoff + m * 2048 + k * 1024); } while (0)
#define PG8_LDB(dst, b, h) do { _Pragma("unroll") for (int n = 0; n < 2; ++n) _Pragma("unroll") for (int k = 0; k < 2; ++k) dst[n][k] = *(const LAS bf16x8*)(lds + PG8_SB(b, h) + boff + n * 2048 + k * 1024); } while (0)
#define PG8_MMA(ai, bj, At, Bt) do { __builtin_amdgcn_s_setprio(1); _Pragma("unroll") for (int m = 0; m < 4; ++m) _Pragma("unroll") for (int n = 0; n < 2; ++n) _Pragma("unroll") for (int k = 0; k < 2; ++k) \
        acc[ai][bj][m][n] = __builtin_amdgcn_mfma_f32_16x16x32_bf16(Bt[n][k], At[m][k], acc[ai][bj][m][n], 0, 0, 0); __builtin_amdgcn_s_setprio(0); } while (0)
#define PG8_WAIT_V(n) asm volatile("s_waitcnt vmcnt(" #n ")" ::: "memory")
#define PG8_WAIT_L(n) asm volatile("s_waitcnt lgkmcnt(" #n ")" ::: "memory")
#define PG8_BAR __builtin_amdgcn_s_barrier()
#define PG8_SCHED __builtin_amdgcn_sched_barrier(0)
#define PG8_APTR(u) ((const char*)g.A + (size_t)(u).pm * tA + (g.tpg ? (size_t)((u).pn / g.tpg) * (size_t)K * 2 : (size_t)0) + (size_t)(u).kt0 * kstep)
#define PG8_BPTR(u) ((const char*)g.Bt + (size_t)(u).pn * tB + (size_t)(u).kt0 * kstep)
    Unit cur, nxt; int ui = 0;
    if (!S.next(0, cur)) return;
    f32x4 acc[2][2][4][2];
#pragma unroll
    for (int a = 0; a < 2; ++a)
#pragma unroll
        for (int b = 0; b < 2; ++b)
#pragma unroll
            for (int m = 0; m < 4; ++m)
#pragma unroll
                for (int n = 0; n < 2; ++n) acc[a][b][m][n] = (f32x4){0.f, 0.f, 0.f, 0.f};
    bf16x8 At[4][2], B0[2][2], B1[2][2];
    const char* cA = PG8_APTR(cur); const char* cB = PG8_BPTR(cur);
    float pre[8]; E.preload(cur, pre, wr, fr);
    PG8_STAGE(PG8_SB(0, 0), cB, voffB); PG8_STAGE(PG8_SB(0, 1), cB + hB, voffB); PG8_STAGE(PG8_SA(0, 0), cA, voffA); PG8_STAGE(PG8_SA(0, 1), cA + hA, voffA);
    if (wr == 1) PG8_BAR;
    PG8_WAIT_V(2); PG8_BAR;
    PG8_STAGE(PG8_SB(1, 0), cB + kstep, voffB); PG8_STAGE(PG8_SA(1, 0), cA + kstep, voffA); PG8_STAGE(PG8_SB(1, 1), cB + hB + kstep, voffB);
    PG8_WAIT_V(6); PG8_BAR;
    for (;;) {
        const bool has_next = S.next(ui + 1, nxt);
        const char* nA = has_next ? PG8_APTR(nxt) : cA; const char* nB = has_next ? PG8_BPTR(nxt) : cB;
        const int nt = cur.ktn;
        for (int t = 0; t < nt; t += 2) {
            const bool last = (t == nt - 2);
            const char* a1 = cA + (size_t)(t + 1) * kstep;
            const char* a2 = last ? nA : cA + (size_t)(t + 2) * kstep; const char* b2 = last ? nB : cB + (size_t)(t + 2) * kstep;
            const char* a3 = a2 + kstep; const char* b3 = b2 + kstep;
            PG8_LDB(B0, 0, 0); PG8_LDB(B1, 0, 1); PG8_SCHED; PG8_LDA(At, 0, 0); PG8_STAGE(PG8_SA(1, 1), a1 + hA, voffA);
            PG8_WAIT_V(8); PG8_WAIT_L(0); PG8_BAR; PG8_MMA(0, 0, At, B0); PG8_MMA(0, 1, At, B1); PG8_BAR; PG8_SCHED;
            PG8_LDA(At, 0, 1); PG8_STAGE(PG8_SB(0, 0), b2, voffB); PG8_STAGE(PG8_SB(0, 1), b2 + hB, voffB); PG8_STAGE(PG8_SA(0, 0), a2, voffA);
            PG8_WAIT_V(8); PG8_WAIT_L(0); PG8_BAR; PG8_MMA(1, 0, At, B0); PG8_MMA(1, 1, At, B1); PG8_BAR; PG8_SCHED;
            PG8_LDB(B0, 1, 0); PG8_LDB(B1, 1, 1); PG8_SCHED; PG8_LDA(At, 1, 0); PG8_STAGE(PG8_SA(0, 1), a2 + hA, voffA);
            PG8_WAIT_V(8); PG8_WAIT_L(0); PG8_BAR; PG8_MMA(0, 0, At, B0); PG8_MMA(0, 1, At, B1); PG8_BAR; PG8_SCHED;
            PG8_LDA(At, 1, 1); PG8_STAGE(PG8_SB(1, 0), b3, voffB); PG8_STAGE(PG8_SB(1, 1), b3 + hB, voffB); PG8_STAGE(PG8_SA(1, 0), a3, voffA);
            PG8_WAIT_V(8); PG8_WAIT_L(0); PG8_BAR; PG8_MMA(1, 0, At, B0); PG8_MMA(1, 1, At, B1); PG8_BAR; PG8_SCHED;
        }
        if constexpr (ALIGN_EPI) { if (wr == 0) PG8_BAR; }
        E(acc, cur, wr, wc, fr, fq, pre);
        if (!has_next) break;
        E.preload(nxt, pre, wr, fr);
#pragma unroll
        for (int a = 0; a < 2; ++a)
#pragma unroll
            for (int b = 0; b < 2; ++b)
#pragma unroll
                for (int m = 0; m < 4; ++m)
#pragma unroll
                    for (int n = 0; n < 2; ++n) acc[a][b][m][n] = (f32x4){0.f, 0.f, 0.f, 0.f};
        cur = nxt; cA = nA; cB = nB; ++ui;
        if constexpr (ALIGN_EPI) { if (wr == 1) PG8_BAR; }
    }
    PG8_WAIT_V(0);
    if constexpr (!ALIGN_EPI) { if (wr == 0) PG8_BAR; }
    PG8_BAR;
#undef PG8_SA
#undef PG8_SB
#undef PG8_STAGE
#undef PG8_LDA
#undef PG8_LDB
#undef PG8_MMA
#undef PG8_WAIT_V
#undef PG8_WAIT_L
#undef PG8_BAR
#undef PG8_SCHED
#undef PG8_APTR
#undef PG8_BPTR
}
}

#define XB_TMO      128
#define XB_XCNT(j)  (256  + 64 * (j))
#define XB_XSUB(j)  (1280 + 64 * (j))
#define XB_XGEN(j)  (2304 + 64 * (j))
#define XB_TOP      3328
#define XB_TOPGEN   3392
#define XCD_BAR_WORDS 3456
#define XB_SPIN_CAP (1u << 18)
__device__ __forceinline__ unsigned xb_ld(unsigned* p)              { return __hip_atomic_load(p, __ATOMIC_RELAXED, __HIP_MEMORY_SCOPE_AGENT); }
__device__ __forceinline__ unsigned xb_add(unsigned* p, unsigned v) { return __hip_atomic_fetch_add(p, v, __ATOMIC_RELAXED, __HIP_MEMORY_SCOPE_AGENT); }
__device__ __forceinline__ unsigned xb_xcc_id() { return (unsigned)__builtin_amdgcn_s_getreg((3 << 11) | 20) & 0xFu; }
#define XB_SPIN(cond, bar) do { unsigned _sp = 0; while (cond) { __builtin_amdgcn_s_sleep(1); \
    if ((++_sp & 255u) == 0u) { if (xb_ld(&(bar)[XB_TMO])) break; if (_sp > XB_SPIN_CAP) { atomicAdd(&(bar)[XB_TMO], 1u); break; } } } } while (0)
struct XcdBarrier { unsigned* bar; unsigned x; volatile LAS unsigned* st; };
__device__ __forceinline__ XcdBarrier xcd_barrier_post(unsigned* bar, volatile LAS unsigned* st) {
    XcdBarrier b; b.bar = bar; b.x = xb_xcc_id(); b.st = st;
    if (threadIdx.x == 0) (void)xb_add(&bar[XB_XCNT(b.x)], 1u);
    return b;
}
__device__ __forceinline__ void xcd_barrier_complete(unsigned* bar, unsigned x, unsigned& nloc, unsigned& nx) {
    const unsigned G = gridDim.x * gridDim.y * gridDim.z;
    unsigned sum, cnt, mine, sp = 0u;
    for (;;) {
        sum = 0u; cnt = 0u; mine = 0u;
#pragma unroll
        for (unsigned j = 0; j < 16; ++j) { const unsigned c = xb_ld(&bar[XB_XCNT(j)]); sum += c; cnt += (c > 0u) ? 1u : 0u; mine = (j == x) ? c : mine; }
        if (sum == G) break;
        __builtin_amdgcn_s_sleep(1);
        if ((++sp & 255u) == 0u) { if (xb_ld(&bar[XB_TMO])) break; if (sp > XB_SPIN_CAP) { atomicAdd(&bar[XB_TMO], 1u); break; } }
    }
    nloc = mine > 0u ? mine : 1u; nx = cnt > 0u ? cnt : 1u;
}
__device__ __forceinline__ void xcd_barrier(const XcdBarrier& b) {
    asm volatile("s_waitcnt vmcnt(0)" ::: "memory");
    __syncthreads();
    if (threadIdx.x == 0) {
        unsigned* bar = b.bar;
        __builtin_amdgcn_s_waitcnt(0);
        unsigned nloc = b.st[0], nx = b.st[1];
        if (nloc == 0u) { xcd_barrier_complete(bar, b.x, nloc, nx); b.st[0] = nloc; b.st[1] = nx; }
        const unsigned old = xb_add(&bar[XB_XSUB(b.x)], 1u);
        const unsigned gen = old / nloc;
        if (old + 1u == (gen + 1u) * nloc) {
            __builtin_amdgcn_fence(__ATOMIC_RELEASE, "agent");
            asm volatile("s_waitcnt vmcnt(0)" ::: "memory");
            const unsigned og = xb_add(&bar[XB_TOP], 1u);
            const unsigned tg = og / nx;
            if (og + 1u == (tg + 1u) * nx) xb_add(&bar[XB_TOPGEN], 1u);
            else XB_SPIN(xb_ld(&bar[XB_TOPGEN]) == tg, bar);
            __builtin_amdgcn_fence(__ATOMIC_ACQUIRE, "agent");
            xb_add(&bar[XB_XGEN(b.x)], 1u);
            asm volatile("s_waitcnt vmcnt(0)" ::: "memory");
        } else {
            XB_SPIN(xb_ld(&bar[XB_XGEN(b.x)]) == gen, bar);
            __builtin_amdgcn_fence(__ATOMIC_ACQUIRE, "agent");
            asm volatile("s_waitcnt vmcnt(0)" ::: "memory");
        }
    }
    __syncthreads();
}

struct Args { const float* in[25]; float* out; unsigned char* ws; int ph_lo, ph_hi; };
typedef const __attribute__((address_space(4))) Args* CArgsP;
enum { I_XP = 0, I_XS, I_CP, I_CS, I_SCONV, I_SPOOL, I_ADAW, I_ADAB, I_NORMG, I_FNORMG, I_WG, I_WU, I_WD, I_WIN, I_AVG, I_AVB, I_AWS, I_ABS, I_BDW, I_BLNG, I_BLNB, I_WOUT, I_CW, I_CB, I_CSC };

__device__ __forceinline__ void p0_transpose_item(const float* W, int K, int N, bf16* WT, int dest0, int k0, int n0, int lane) {
    const float* src = W + (size_t)k0 * N + n0 + lane;
    float v[64];
#pragma unroll
    for (int i = 0; i < 64; ++i) v[i] = __builtin_nontemporal_load(src + (size_t)i * N);
    bf16* dst = WT + (size_t)(dest0 + lane) * K + k0;
#pragma unroll
    for (int c = 0; c < 8; ++c) { v4u o; o.x = pk2(v[8 * c], v[8 * c + 1]); o.y = pk2(v[8 * c + 2], v[8 * c + 3]); o.z = pk2(v[8 * c + 4], v[8 * c + 5]); o.w = pk2(v[8 * c + 6], v[8 * c + 7]); *(v4u*)(dst + 8 * c) = o; }
}
__device__ __forceinline__ void p0_ada_item(CArgsP a, float* mod, LAS float* scr, int idx, int lane) {
    const int ks = idx & 15, cb = (idx >> 4) % 72, l = idx / (16 * 72), k0 = ks * 128, n = cb * 256 + 4 * lane;
#pragma unroll
    for (int s = 0; s < NSTREAM; ++s)
#pragma unroll
        for (int h = 0; h < 2; ++h) { const int k = lane + 64 * h; const float cv = (s < 4) ? a->in[I_CP][s * D + k0 + k] : a->in[I_CS][(s - 4) * D + k0 + k]; scr[s * 128 + k] = siluf_(cv); }
    LDS_WAIT(); asm volatile("" ::: "memory");
    f32x4 acc[NSTREAM];
#pragma unroll
    for (int s = 0; s < NSTREAM; ++s) acc[s] = (f32x4){0.f, 0.f, 0.f, 0.f};
    const float* Wp = a->in[I_ADAW] + ((size_t)l * D + k0) * MODS + n;
#pragma unroll 4
    for (int k = 0; k < 128; ++k) { const f32x4 w = *(const f32x4*)(Wp + (size_t)k * MODS);
#pragma unroll
        for (int s = 0; s < NSTREAM; ++s) acc[s] += w * scr[s * 128 + k]; }
    if (ks == 0) { const f32x4 b = *(const f32x4*)(a->in[I_ADAB] + (size_t)l * MODS + n);
#pragma unroll
        for (int s = 0; s < NSTREAM; ++s) acc[s] += b; }
#pragma unroll
    for (int s = 0; s < NSTREAM; ++s) { float* dst = mod + (size_t)l * MODL + (size_t)s * MODS + n;
#pragma unroll
        for (int j = 0; j < 4; ++j) unsafeAtomicAdd(dst + j, acc[s][j]); }
    LDS_WAIT(); asm volatile("" ::: "memory");
}
constexpr int P0_ADA = 2 * 72 * 16, P0_GU = 32 * 88, P0_WD = 88 * 32, P0_WIN = 32 * 64, P0_WOUT = 32 * 32, P0_WC = 8 * 8, P0_WM = 16;
constexpr int P0_TR = 8 * P0_GU + 4 * P0_WD + P0_WIN + P0_WOUT + 4 * P0_WC, P0_TOTAL = P0_ADA + P0_TR + P0_WM;
__device__ __forceinline__ void p0_prologue(CArgsP a, LAS unsigned char* lds, int gw, int NGW, int wave, int lane) {
    LAS float* scr = (LAS float*)(lds + wave * 16384);
    unsigned char* ws = a->ws;
    for (int it = gw; it < P0_TOTAL + (int)((DUP_MASK >> 4) & 1u) * (P0_TOTAL - P0_ADA); it += NGW) {
        int r = it < P0_TOTAL ? it : it - P0_TOTAL + P0_ADA;
        if (r < P0_ADA) { if ((DUP_MASK >> 7) & 1u) p0_ada_item(a, (float*)(ws + WS_DUMMY), scr, r, lane); p0_ada_item(a, (float*)(ws + WS_MOD), scr, r, lane); continue; } r -= P0_ADA;
        if (r < 8 * P0_GU) { const int up = r >= 4 * P0_GU, rr = up ? r - 4 * P0_GU : r, f = rr / P0_GU, i2 = rr % P0_GU, kb = i2 / 88, nb = i2 % 88, n0 = 64 * nb;
            p0_transpose_item(a->in[up ? I_WU : I_WG] + (size_t)f * D * DFF, D, DFF, (bf16*)(ws + WS_WGU) + (size_t)f * 11264 * 2048, 256 * (n0 >> 7) + (n0 & 127) + (up ? 128 : 0), 64 * kb, n0, lane); continue; }
        r -= 8 * P0_GU;
        if (r < 4 * P0_WD) { const int f = r / P0_WD, i2 = r % P0_WD, kb = i2 / 32, nb = i2 % 32;
            p0_transpose_item(a->in[I_WD] + (size_t)f * DFF * D, DFF, D, (bf16*)(ws + WS_WD) + (size_t)f * 2048 * 5632, 64 * nb, 64 * kb, 64 * nb, lane); continue; }
        r -= 4 * P0_WD;
        if (r < P0_WIN) { const int kb = r / 64, nb = r % 64, n0 = 64 * nb; int d0;
            if (n0 < 2048) d0 = n0; else if (n0 < 3072) { const int j = n0 - 2048; d0 = 2048 + 256 * (j >> 7) + (j & 127); } else { const int j = n0 - 3072; d0 = 2048 + 256 * (j >> 7) + 128 + (j & 127); }
            p0_transpose_item(a->in[I_WIN], D, 4096, (bf16*)(ws + WS_WIN), d0, 64 * kb, n0, lane); continue; }
        r -= P0_WIN;
        if (r < P0_WOUT) { const int kb = r / 32, nb = r % 32; p0_transpose_item(a->in[I_WOUT], D, D, (bf16*)(ws + WS_WOUT), 64 * nb, 64 * kb, 64 * nb, lane); continue; }
        r -= P0_WOUT;
        if (r < 4 * P0_WC) { const int g = r / P0_WC, i2 = r % P0_WC, kb = i2 / 8, nb = i2 % 8;
            p0_transpose_item(a->in[I_CW] + (size_t)g * 512 * 512, 512, 512, (bf16*)(ws + WS_WC), g * 512 + 64 * nb, 64 * kb, 64 * nb, lane); continue; }
        r -= 4 * P0_WC;
        { bf16* wm = (bf16*)(ws + WS_WM);
#pragma unroll 4
          for (int i = 0; i < 64; ++i) { const int idx = r * 4096 + i * 64 + lane, ii = (idx >> 7) & 127, jj = idx & 127; const float v = a->in[I_AWS][idx]; wm[idx] = (bf16)(((jj >> 6) <= (ii >> 6)) ? f2bf(v) : 0u); } }
    }
}

__device__ __forceinline__ void thin_norm(const float* hp, const float* hs, const float* ng, const float* shift, const float* scale, bf16* HN, int gw, int NGW, int lane) {
    const int r0 = (int)(((long)gw * M) / NGW), r1 = (int)(((long)(gw + 1) * M) / NGW);
    int cur_s = -1; f32x4 gs[8], sh[8];
#pragma unroll
    for (int j = 0; j < 8; ++j) { gs[j] = (f32x4){0.f, 0.f, 0.f, 0.f}; sh[j] = gs[j]; }
    for (int r = r0; r < r1; ++r) {
        const int s = stream_of_row(r);
        if (s != cur_s) { cur_s = s;
#pragma unroll
            for (int j = 0; j < 8; ++j) { const int c = 4 * lane + 256 * j; gs[j] = *(const f32x4*)(ng + c) * (*(const f32x4*)(scale + (size_t)s * MODS + c) + 1.0f); sh[j] = *(const f32x4*)(shift + (size_t)s * MODS + c); } }
        const float* xr = (r < NPR) ? hp + (size_t)r * D : hs + (size_t)(r - NPR) * D;
        f32x4 v[8]; float ss = 0.f;
#pragma unroll
        for (int j = 0; j < 8; ++j) { v[j] = *(const f32x4*)(xr + 4 * lane + 256 * j); ss += (v[j].x * v[j].x + v[j].y * v[j].y) + (v[j].z * v[j].z + v[j].w * v[j].w); }
        const float rstd = rsqrtf(wave_sum(ss) * (1.0f / D) + EPS);
        bf16* orow = HN + (size_t)r * D;
#pragma unroll
        for (int j = 0; j < 8; ++j) { const f32x4 o = v[j] * rstd * gs[j] + sh[j]; v2u w; w.x = pk2(o.x, o.y); w.y = pk2(o.z, o.w); *(v2u*)(orow + 4 * lane + 256 * j) = w; }
    }
}
__device__ __forceinline__ void final_norm(float* h, float* yo, const float* ng, int gw, int NGW, int lane) {
    const int r0 = (int)(((long)gw * M) / NGW), r1 = (int)(((long)(gw + 1) * M) / NGW);
    f32x4 gs[8];
#pragma unroll
    for (int j = 0; j < 8; ++j) gs[j] = *(const f32x4*)(ng + 4 * lane + 256 * j);
    for (int r = r0; r < r1; ++r) {
        float* xr = h + (size_t)r * D;
        f32x4 v[8]; float ss = 0.f;
#pragma unroll
        for (int j = 0; j < 8; ++j) { v[j] = *(const f32x4*)(xr + 4 * lane + 256 * j); ss += (v[j].x * v[j].x + v[j].y * v[j].y) + (v[j].z * v[j].z + v[j].w * v[j].w); }
        const float rstd = rsqrtf(wave_sum(ss) * (1.0f / D) + EPS);
#pragma unroll
        for (int j = 0; j < 8; ++j) *(f32x4*)(yo + (size_t)r * D + 4 * lane + 256 * j) = v[j] * rstd * gs[j];
    }
}

constexpr int VNT_STRIDE_DW = 68;
__device__ __forceinline__ void mix_gate_unit(CArgsP a, LAS unsigned char* lds, int ch, int g, int tid, int wave, int lane) {
    unsigned char* ws = a->ws;
    LAS unsigned* vnT = (LAS unsigned*)lds;
    LAS float* st = (LAS float*)(lds + 256 * VNT_STRIDE_DW * 4);
    const bool smp = ch >= 256; const int r0 = smp ? NPR + 64 * (ch - 256) : 128 * ch, nrows = smp ? 64 : 128;
    const float* vstat = (const float*)(ws + WS_VSTAT); const bf16* V = (const bf16*)(ws + WS_V); const bf16* U = (const bf16*)(ws + WS_U); bf16* CAT = (bf16*)(ws + WS_CAT);
    if (tid < 128) { float mean = 0.f, rstd = 0.f;
        if (tid < nrows) { const float s1 = vstat[2 * (size_t)(r0 + tid)], s2 = vstat[2 * (size_t)(r0 + tid) + 1]; mean = s1 * (1.0f / AW); const float var = fmaxf(s2 * (1.0f / AW) - mean * mean, 0.f); rstd = rsqrtf(var + EPS); }
        st[2 * tid] = mean; st[2 * tid + 1] = rstd; }
    __syncthreads();
#pragma unroll 1
    for (int it = 0; it < 4; ++it) {
        const int idx = it * 512 + tid, p = idx & 63, o = idx >> 6, c = g * 256 + 8 * o;
        const f32x4 g0 = *(const f32x4*)(a->in[I_AVG] + c), g1 = *(const f32x4*)(a->in[I_AVG] + c + 4), b0 = *(const f32x4*)(a->in[I_AVB] + c), b1 = *(const f32x4*)(a->in[I_AVB] + c + 4);
        float na[8], nb[8];
#pragma unroll
        for (int h = 0; h < 2; ++h) { const int j = 2 * p + h; float* dstv = h ? nb : na;
            if (j < nrows) { const v4u w = *(const v4u*)(V + (size_t)(r0 + j) * AW + c); const float mean = st[2 * j], rstd = st[2 * j + 1];
                dstv[0] = (bflo(w.x) - mean) * rstd * g0[0] + b0[0]; dstv[1] = (bfhi(w.x) - mean) * rstd * g0[1] + b0[1]; dstv[2] = (bflo(w.y) - mean) * rstd * g0[2] + b0[2]; dstv[3] = (bfhi(w.y) - mean) * rstd * g0[3] + b0[3];
                dstv[4] = (bflo(w.z) - mean) * rstd * g1[0] + b1[0]; dstv[5] = (bfhi(w.z) - mean) * rstd * g1[1] + b1[1]; dstv[6] = (bflo(w.w) - mean) * rstd * g1[2] + b1[2]; dstv[7] = (bfhi(w.w) - mean) * rstd * g1[3] + b1[3];
                if (smp) { float* av = a->out + O_NAV + (size_t)((ch - 256) * 64 + j) * AW + c; *(f32x4*)av = (f32x4){dstv[0], dstv[1], dstv[2], dstv[3]}; *(f32x4*)(av + 4) = (f32x4){dstv[4], dstv[5], dstv[6], dstv[7]}; }
            } else {
#pragma unroll
                for (int i = 0; i < 8; ++i) dstv[i] = 0.f; } }
#pragma unroll
        for (int i = 0; i < 8; ++i) vnT[(8 * o + i) * VNT_STRIDE_DW + p] = pk2(na[i], nb[i]);
    }
    __syncthreads();
    const int lr = lane & 15, lq = lane >> 4;
    f32x4 acc[2][8];
#pragma unroll
    for (int ct = 0; ct < 2; ++ct)
#pragma unroll
        for (int it = 0; it < 8; ++it) acc[ct][it] = (f32x4){0.f, 0.f, 0.f, 0.f};
    const bf16* wm = (const bf16*)(ws + WS_WM) + (size_t)g * 16384;
#pragma unroll
    for (int ks = 0; ks < 4; ++ks) {
        bf16x8 af[2];
#pragma unroll
        for (int ct = 0; ct < 2; ++ct) af[ct] = *(const LAS bf16x8*)((const LAS unsigned char*)vnT + (32 * wave + 16 * ct + lr) * (VNT_STRIDE_DW * 4) + ks * 64 + lq * 16);
#pragma unroll
        for (int it = 0; it < 8; ++it) { const bf16x8 bfrag = *(const bf16x8*)(wm + (16 * it + lr) * 128 + 32 * ks + 8 * lq);
#pragma unroll
            for (int ct = 0; ct < 2; ++ct) acc[ct][it] = __builtin_amdgcn_mfma_f32_16x16x32_bf16(af[ct], bfrag, acc[ct][it], 0, 0, 0); }
    }
#pragma unroll
    for (int it = 0; it < 8; ++it) { const int i = 16 * it + lr;
        if (i < nrows) { const float bsv = a->in[I_ABS][g * 128 + i];
#pragma unroll
            for (int ct = 0; ct < 2; ++ct) { const int cb = g * 256 + 32 * wave + 16 * ct + 4 * lq;
                const v2u uw = *(const v2u*)(U + (size_t)(r0 + i) * AW + cb);
                v2u w; w.x = pk2(bflo(uw.x) * (acc[ct][it][0] + bsv), bfhi(uw.x) * (acc[ct][it][1] + bsv)); w.y = pk2(bflo(uw.y) * (acc[ct][it][2] + bsv), bfhi(uw.y) * (acc[ct][it][3] + bsv));
                *(v2u*)(CAT + (size_t)(r0 + i) * D + cb) = w; } } }
    __syncthreads();
}
__device__ __forceinline__ f32x2 conv_row(const bf16* GLU, const float* hist, int rowbase, int t, int c) {
    if (t >= 0) { const unsigned w = *(const unsigned*)(GLU + (size_t)(rowbase + t) * AW + c); return (f32x2){bflo(w), bfhi(w)}; }
    if (hist) return *(const f32x2*)(hist + (size_t)(30 + t) * 1024 + c);
    return (f32x2){0.f, 0.f};
}
__device__ __forceinline__ void mix_conv_unit(CArgsP a, LAS unsigned char* lds, int b, int tid, int wave, int lane) {
    unsigned char* ws = a->ws;
    LAS float* red = (LAS float*)lds;
    LAS float* stt = red + 128;
    int rowbase, t0; const float* hist = nullptr;
    if (b < 1024) { rowbase = 8192 * (b >> 8); t0 = 32 * (b & 255); } else { const int q = b - 1024; rowbase = NPR + 64 * (q >> 1); t0 = 32 * (q & 1); hist = a->in[I_SCONV] + (size_t)(q >> 1) * 30 * 1024; }
    const bf16* GLU = (const bf16*)(ws + WS_GLU); bf16* CAT = (bf16*)(ws + WS_CAT);
    const int c = 2 * tid;
    const f32x2 lg = *(const f32x2*)(a->in[I_BLNG] + c), lb = *(const f32x2*)(a->in[I_BLNB] + c);
    f32x2 wk[31];
#pragma unroll
    for (int k = 0; k < 31; ++k) wk[k] = *(const f32x2*)(a->in[I_BDW] + (size_t)k * 1024 + c);
    f32x2 x[38];
#pragma unroll
    for (int i = 0; i < 30; ++i) x[i] = conv_row(GLU, hist, rowbase, t0 - 30 + i, c);
#pragma unroll 1
    for (int sub = 0; sub < 4; ++sub) {
        const int tt0 = t0 + 8 * sub;
#pragma unroll
        for (int i = 0; i < 8; ++i) x[30 + i] = conv_row(GLU, hist, rowbase, tt0 + i, c);
        f32x2 acc[8];
#pragma unroll
        for (int t = 0; t < 8; ++t) acc[t] = (f32x2){0.f, 0.f};
#pragma unroll
        for (int k = 0; k < 31; ++k)
#pragma unroll
            for (int t = 0; t < 8; ++t) acc[t] += x[t + k] * wk[k];
#pragma unroll
        for (int t = 0; t < 8; ++t) { const float s1 = wave_sum(acc[t].x + acc[t].y), s2 = wave_sum(acc[t].x * acc[t].x + acc[t].y * acc[t].y);
            if (lane == 0) { red[(wave * 8 + t) * 2] = s1; red[(wave * 8 + t) * 2 + 1] = s2; } }
        __syncthreads();
        if (tid < 8) { float s1 = 0.f, s2 = 0.f;
#pragma unroll
            for (int w = 0; w < 8; ++w) { s1 += red[(w * 8 + tid) * 2]; s2 += red[(w * 8 + tid) * 2 + 1]; }
            const float mean = s1 * (1.0f / AW), var = fmaxf(s2 * (1.0f / AW) - mean * mean, 0.f); stt[2 * tid] = mean; stt[2 * tid + 1] = rsqrtf(var + EPS); }
        __syncthreads();
#pragma unroll
        for (int t = 0; t < 8; ++t) { const float mean = stt[2 * t], rstd = stt[2 * t + 1];
            const float y0 = (acc[t].x - mean) * rstd * lg.x + lb.x, y1 = (acc[t].y - mean) * rstd * lg.y + lb.y;
            *(unsigned*)(CAT + (size_t)(rowbase + tt0 + t) * D + AW + c) = pk2(siluf_(y0), siluf_(y1)); }
#pragma unroll
        for (int i = 0; i < 30; ++i) x[i] = x[i + 8];
    }
    __syncthreads();
}
__device__ __forceinline__ f32x4 tc_hm(const float* h, const float* hist, const LAS float* rs, int rowbase, int t0, int t, int c, f32x4 gs, f32x4 sh) {
    if (t >= 0) return *(const f32x4*)(h + (size_t)(rowbase + t) * D + c) * rs[t - t0 + 15] * gs + sh;
    if (hist) return *(const f32x4*)(hist + (size_t)(15 + t) * D + c);
    return (f32x4){0.f, 0.f, 0.f, 0.f};
}
__device__ __forceinline__ void tc_unit(CArgsP a, LAS unsigned char* lds, const float* h, const float* ssq, const float* ng, const float* shift, const float* scale, int b, int tid, int wave, int lane) {
    unsigned char* ws = a->ws;
    LAS float* rs = (LAS float*)lds;
    int rowbase, t0, s, T, pos0; const float* hist = nullptr; float* np;
    if (b < 1024) { s = b >> 8; rowbase = 8192 * s; t0 = 32 * (b & 255); T = 8192; pos0 = 0; np = a->out + O_NPP + (size_t)s * 15 * D; }
    else { const int q = b - 1024; s = 4 + (q >> 1); rowbase = NPR + 64 * (q >> 1); t0 = 32 * (q & 1); T = 64; pos0 = 1024; hist = a->in[I_SPOOL] + (size_t)(q >> 1) * 15 * D; np = a->out + O_NPS + (size_t)(q >> 1) * 15 * D; }
    if (tid < 47) { const int t = t0 - 15 + tid; if (t >= 0) rs[tid] = rsqrtf(ssq[rowbase + t] * (1.0f / D) + EPS); }
    __syncthreads();
    const int c = 4 * tid, grp = __builtin_amdgcn_readfirstlane(tid >> 7), w = 2 << grp;
    const f32x4 gs = *(const f32x4*)(ng + c) * (*(const f32x4*)(scale + (size_t)s * MODS + c) + 1.0f), sh = *(const f32x4*)(shift + (size_t)s * MODS + c);
    bf16* PC = (bf16*)(ws + WS_PC);
    f32x4 S = (f32x4){0.f, 0.f, 0.f, 0.f};
    for (int k = 1; k < w; ++k) S += tc_hm(h, hist, rs, rowbase, t0, t0 - k, c, gs, sh);
#pragma unroll 4
    for (int tt = 0; tt < 32; ++tt) { const int t = t0 + tt;
        const f32x4 cur = tc_hm(h, hist, rs, rowbase, t0, t, c, gs, sh);
        S += cur;
        const int pos = pos0 + t; const float inv = 1.0f / (float)(pos + 1 < w ? pos + 1 : w);
        const f32x4 p = S * inv - cur;
        v2u o; o.x = pk2(p.x, p.y); o.y = pk2(p.z, p.w); *(v2u*)(PC + (size_t)(rowbase + t) * D + c) = o;
        if (t >= T - 15) *(f32x4*)(np + (size_t)(t - (T - 15)) * D + c) = cur;
        S -= tc_hm(h, hist, rs, rowbase, t0, t - w + 1, c, gs, sh);
    }
    __syncthreads();
}

__device__ __forceinline__ void slab_reduce(const float* base_s, float* hS, const float* slab, int ks, bf16* an, const float* ng_n, const float* sc_n, float* ss, int gw, int NGW, int lane) {
    for (int r = gw; r < NSR; r += NGW) {
        const int s = 4 + (r >> 6);
        f32x4 v[8]; float q = 0.f;
#pragma unroll
        for (int j = 0; j < 8; ++j) v[j] = *(const f32x4*)(base_s + (size_t)r * D + 4 * lane + 256 * j);
#pragma unroll 1
        for (int k = 0; k < ks; ++k) {
#pragma unroll
            for (int j = 0; j < 8; ++j) v[j] += *(const f32x4*)(slab + ((size_t)k * NSR + r) * D + 4 * lane + 256 * j); }
#pragma unroll
        for (int j = 0; j < 8; ++j) { const int c = 4 * lane + 256 * j; *(f32x4*)(hS + (size_t)r * D + c) = v[j]; q += (v[j].x * v[j].x + v[j].y * v[j].y) + (v[j].z * v[j].z + v[j].w * v[j].w);
            if (an) { const f32x4 t = v[j] * (*(const f32x4*)(ng_n + c) * (*(const f32x4*)(sc_n + (size_t)s * MODS + c) + 1.0f)); v2u w; w.x = pk2(t.x, t.y); w.y = pk2(t.z, t.w); *(v2u*)(an + (size_t)(NPR + r) * D + c) = w; } }
        if (ss) { q = wave_sum(q); if (lane == 0) ss[NPR + r] = q; }
    }
}
constexpr int SHL_STRIDE = D + 8;
__device__ __forceinline__ void sb_gemv(LAS unsigned char* lds, const bf16* Wt, int nrows, const float* shift, float* sb, int gw, int NGW, int tid, int lane) {
    LAS bf16* shl = (LAS bf16*)lds;
    __syncthreads();
    for (int i = tid; i < 16 * (D / 8); i += NWAVES * 64) { const int s = i / (D / 8), c8 = i % (D / 8); v4u w = (v4u){0u, 0u, 0u, 0u};
        if (s < NSTREAM) { const float* p = shift + (size_t)s * MODS + 8 * c8; const f32x4 a = *(const f32x4*)p, b = *(const f32x4*)(p + 4); w.x = pk2(a.x, a.y); w.y = pk2(a.z, a.w); w.z = pk2(b.x, b.y); w.w = pk2(b.z, b.w); }
        *(LAS v4u*)(shl + s * SHL_STRIDE + 8 * c8) = w; }
    __syncthreads();
    const int lr = lane & 15, lq = lane >> 4;
    for (int tile = gw; tile < nrows / 16; tile += NGW) {
        const int n0 = 16 * tile;
        f32x4 acc = (f32x4){0.f, 0.f, 0.f, 0.f};
        const bf16* wp = Wt + (size_t)(n0 + lr) * D + 8 * lq; const LAS bf16* ap = shl + lr * SHL_STRIDE + 8 * lq;
#pragma unroll 8
        for (int ks = 0; ks < D / 32; ++ks) acc = __builtin_amdgcn_mfma_f32_16x16x32_bf16(*(const LAS bf16x8*)(ap + 32 * ks), *(const bf16x8*)(wp + 32 * ks), acc, 0, 0, 0);
#pragma unroll
        for (int j = 0; j < 4; ++j) { const int s = 4 * lq + j; if (s < NSTREAM) sb[(size_t)s * nrows + n0 + lr] = acc[j]; }
    }
}

constexpr int NPL = 13, NPH = 2 + 2 * NPL;
constexpr int KS_G2 = 11, KS_G4 = 8;
__global__ void __launch_bounds__(NWAVES * 64, 2) mk_fwd(Args args) {
    extern __shared__ __attribute__((aligned(16))) unsigned char lds_raw[];
    LAS unsigned char* lds = (LAS unsigned char*)lds_raw;
    volatile LAS unsigned* MISC = (volatile LAS unsigned*)(lds + MISC_OFF);
    const int G = gridDim.x, bx = blockIdx.x, vcu = (G % 8 == 0) ? (bx % 8) * (G / 8) + bx / 8 : bx, NGW = G * NWAVES;
    for (int u = threadIdx.x; u < (LDS_BYTES - LDSCTL_OFF) / 4; u += NWAVES * 64) ((LAS unsigned*)(lds + LDSCTL_OFF))[u] = 0u;
    __syncthreads();
    const int lo = args.ph_lo, hi = args.ph_hi;
    XcdBarrier bar; bar.bar = (unsigned*)(args.ws + WS_CTL) + CW_BAR; bar.x = 0; bar.st = nullptr;
    if (hi - lo > 1) bar = xcd_barrier_post((unsigned*)(args.ws + WS_CTL) + CW_BAR, MISC + 8);
#ifndef PH_MASK
#define PH_MASK 0xFFFFFFFFu
#endif
#define SITE(i) ((PH_MASK >> (i)) & 1u)
#define REP(i) for (int rep_ = 0; rep_ < 1 + (int)((DUP_MASK >> (i)) & 1u); ++rep_)
#define IN(k) (lo <= (k) && (k) < hi)
#define SEAM(k) do { if ((k) + 1 < hi) { xcd_barrier(bar); if ((DUP_MASK >> 7) & 1u) xcd_barrier(bar); } } while (0)
#define SITE_IDS int tid = threadIdx.x; asm volatile("" : "+v"(tid)); const int lane = tid & 63, wave = __builtin_amdgcn_readfirstlane(tid >> 6), gw = vcu * NWAVES + wave; (void)lane; (void)gw; \
    CArgsP ap = (CArgsP)__builtin_amdgcn_kernarg_segment_ptr(); asm volatile("" : "+s"(ap)); unsigned char* ws = ap->ws; float* h = ap->out; float* hS = h + (size_t)NPR * D; (void)hS; \
    const float* modl = (const float*)(ws + WS_MOD) + (size_t)l * MODL; const float* ngl = ap->in[I_NORMG] + (size_t)l * 3 * D; (void)modl; (void)ngl; \
    bf16* HN = (bf16*)(ws + WS_HN); bf16* ACT = (bf16*)(ws + WS_ACT); float* SLAB = (float*)(ws + WS_SLAB); float* SSQ = (float*)(ws + WS_SS); (void)HN; (void)ACT; (void)SLAB; (void)SSQ

    { const int l = 0; if (SITE(0) && IN(0)) { SITE_IDS; p0_prologue(ap, lds, gw, NGW, wave, lane); SEAM(0); } }

#pragma unroll 1
    for (int l = 0; l < 2; ++l) {
        const int pb = 1 + NPL * l;
        if (l == 0 && SITE(1) && IN(pb + 0)) { SITE_IDS; const float* mod0 = (const float*)(ws + WS_MOD); const float* mod1 = mod0 + MODL; float* SB = (float*)(ws + WS_SB);
            REP(1) thin_norm(ap->in[I_XP], ap->in[I_XS], ngl, modl + 0 * D, modl + 1 * D, HN, gw, NGW, lane);
            sb_gemv(lds, (const bf16*)(ws + WS_WGU) + (size_t)1 * 11264 * 2048, 11264, mod0 + 6 * D, SB + (size_t)1 * 12 * 11264, gw, NGW, tid, lane);
            sb_gemv(lds, (const bf16*)(ws + WS_WGU) + (size_t)2 * 11264 * 2048, 11264, mod1 + 0 * D, SB + (size_t)2 * 12 * 11264, gw, NGW, tid, lane);
            sb_gemv(lds, (const bf16*)(ws + WS_WGU) + (size_t)3 * 11264 * 2048, 11264, mod1 + 6 * D, SB + (size_t)3 * 12 * 11264, gw, NGW, tid, lane);
            sb_gemv(lds, (const bf16*)(ws + WS_WIN), 4096, mod0 + 3 * D, SB + (size_t)4 * 12 * 11264, gw, NGW, tid, lane);
            SEAM(pb + 0); }
        if (SITE(2) && IN(pb + 1)) { SITE_IDS; pg8::Gemm g{HN, (const bf16*)(ws + WS_WGU) + (size_t)(2 * l) * 11264 * 2048, M, 11264, D, D, 0}; pg8::StaticOrder S; S.init(NPR, NSR, 11264, D, G, bx, 1);
            pg8::EpiSwiGLU E{ACT, DFF, l == 0 ? nullptr : SSQ + (size_t)2 * M, (const float*)(ws + WS_SB) + (size_t)2 * 12 * 11264}; REP(0) pg8::gemm_phase<pg8::EpiSwiGLU, true>(lds, g, S, E); SEAM(pb + 1); }
        if (SITE(3) && IN(pb + 2)) { SITE_IDS; pg8::Gemm g{ACT, (const bf16*)(ws + WS_WD) + (size_t)(2 * l) * 2048 * 5632, M, D, DFF, DFF, 0}; pg8::StaticOrder S; S.init(NPR, NSR, D, DFF, G, bx, KS_G2, 4);
            pg8::EpiRes<false> E{l == 0 ? ap->in[I_XP] : h, l == 0 ? ap->in[I_XS] : hS, h, modl + 2 * D, nullptr, nullptr, SLAB, l == 0 ? HN : nullptr, ngl + D, modl + 4 * D, SSQ + (size_t)(l == 0 ? 0 : 3) * M, 0.5f, 0};
            if ((DUP_MASK >> 5) & 1u) { pg8::EpiRes<false> E2 = E; E2.out = (float*)(ws + WS_DUMMY); E2.an = nullptr; E2.ss = nullptr; pg8::gemm_phase<pg8::EpiRes<false>, true>(lds, g, S, E2); }
            pg8::gemm_phase<pg8::EpiRes<false>, true>(lds, g, S, E); SEAM(pb + 2); }
        if (SITE(3) && IN(pb + 3)) { SITE_IDS; slab_reduce(l == 0 ? ap->in[I_XS] : hS, hS, SLAB, KS_G2, l == 0 ? HN : nullptr, ngl + D, modl + 4 * D, SSQ + (size_t)(l == 0 ? 0 : 3) * M, gw, NGW, lane); SEAM(pb + 3); }
        if (l == 0) {
            if (SITE(5) && IN(pb + 5)) { SITE_IDS; pg8::Gemm g{HN, (const bf16*)(ws + WS_WIN), M, 4096, D, D, 0}; pg8::StaticOrder S; S.init(NPR, NSR, 4096, D, G, bx, 1);
                pg8::EpiInProj E{(bf16*)(ws + WS_U), (bf16*)(ws + WS_V), (bf16*)(ws + WS_GLU), (float*)(ws + WS_VSTAT), h + O_NCP, h + O_NCS, SSQ, (const float*)(ws + WS_SB) + (size_t)4 * 12 * 11264};
                if ((DUP_MASK >> 6) & 1u) { pg8::EpiInProj E2 = E; E2.vstat = (float*)(ws + WS_DUMMY); pg8::gemm_phase<pg8::EpiInProj, true>(lds, g, S, E2); }
                pg8::gemm_phase<pg8::EpiInProj, true>(lds, g, S, E); SEAM(pb + 5); }
            if (SITE(6) && IN(pb + 6)) { SITE_IDS;
                REP(2) for (int u = vcu; u < 1056 + 1040; u += G) { if (u < 1056) { if (SITE(20)) mix_gate_unit(ap, lds, u >> 2, u & 3, tid, wave, lane); } else { if (SITE(21)) mix_conv_unit(ap, lds, u - 1056, tid, wave, lane); } }
                SEAM(pb + 6); }
            if (SITE(7) && IN(pb + 7)) { SITE_IDS; pg8::Gemm g{(const bf16*)(ws + WS_CAT), (const bf16*)(ws + WS_WOUT), M, D, D, D, 0}; pg8::StaticOrder S; S.init(NPR, NSR, D, D, G, bx, KS_G4);
                pg8::EpiRes<false> E{h, hS, h, modl + 5 * D, nullptr, nullptr, SLAB, HN, ngl + 2 * D, modl + 7 * D, SSQ + (size_t)1 * M, 1.0f, 0};
                if ((DUP_MASK >> 6) & 1u) { pg8::EpiRes<false> E2 = E; E2.out = (float*)(ws + WS_DUMMY); E2.an = nullptr; E2.ss = nullptr; pg8::gemm_phase<pg8::EpiRes<false>, true>(lds, g, S, E2); }
                pg8::gemm_phase<pg8::EpiRes<false>, true>(lds, g, S, E); SEAM(pb + 7); }
            if (SITE(7) && IN(pb + 8)) { SITE_IDS; slab_reduce(hS, hS, SLAB, KS_G4, HN, ngl + 2 * D, modl + 7 * D, SSQ + (size_t)1 * M, gw, NGW, lane); SEAM(pb + 8); }
        } else {
            if (SITE(8) && IN(pb + 4)) { SITE_IDS; REP(3) for (int u = vcu; u < 1040; u += G) tc_unit(ap, lds, h, SSQ + (size_t)3 * M, ngl + D, modl + 3 * D, modl + 4 * D, u, tid, wave, lane); SEAM(pb + 4); }
            if (SITE(9) && IN(pb + 7)) { SITE_IDS; pg8::Gemm g{(const bf16*)(ws + WS_PC), (const bf16*)(ws + WS_WC), M, D, 512, D, 2}; pg8::StaticOrder S; S.init(NPR, NSR, D, 512, G, bx, 1);
                pg8::EpiRes<true> E{h, hS, h, modl + 5 * D, ap->in[I_CB], ap->in[I_CSC], SLAB, HN, ngl + 2 * D, modl + 7 * D, SSQ + (size_t)4 * M, 1.0f, 0};
                if ((DUP_MASK >> 6) & 1u) { pg8::EpiRes<true> E2 = E; E2.out = (float*)(ws + WS_DUMMY); E2.an = nullptr; E2.ss = nullptr; pg8::gemm_phase<pg8::EpiRes<true>, true>(lds, g, S, E2); }
                pg8::gemm_phase<pg8::EpiRes<true>, true>(lds, g, S, E); SEAM(pb + 7); }
        }
        if (SITE(11) && IN(pb + 10)) { SITE_IDS; pg8::Gemm g{HN, (const bf16*)(ws + WS_WGU) + (size_t)(2 * l + 1) * 11264 * 2048, M, 11264, D, D, 0}; pg8::StaticOrder S; S.init(NPR, NSR, 11264, D, G, bx, 1);
            pg8::EpiSwiGLU E{ACT, DFF, SSQ + (size_t)(l == 0 ? 1 : 4) * M, (const float*)(ws + WS_SB) + (size_t)(2 * l + 1) * 12 * 11264}; REP(0) pg8::gemm_phase<pg8::EpiSwiGLU, true>(lds, g, S, E); SEAM(pb + 10); }
        if (SITE(12) && IN(pb + 11)) { SITE_IDS; pg8::Gemm g{ACT, (const bf16*)(ws + WS_WD) + (size_t)(2 * l + 1) * 2048 * 5632, M, D, DFF, DFF, 0}; pg8::StaticOrder S; S.init(NPR, NSR, D, DFF, G, bx, KS_G2, 4);
            const float* ng1 = ap->in[I_NORMG] + (size_t)3 * D; const float* mod1 = (const float*)(ws + WS_MOD) + MODL;
            pg8::EpiRes<false> E{h, hS, h, modl + 8 * D, nullptr, nullptr, SLAB, l == 0 ? HN : nullptr, ng1, mod1 + 1 * D, l == 0 ? SSQ + (size_t)2 * M : nullptr, 0.5f, 0};
            if ((DUP_MASK >> 5) & 1u) { pg8::EpiRes<false> E2 = E; E2.out = (float*)(ws + WS_DUMMY); E2.an = nullptr; E2.ss = nullptr; pg8::gemm_phase<pg8::EpiRes<false>, true>(lds, g, S, E2); }
            pg8::gemm_phase<pg8::EpiRes<false>, true>(lds, g, S, E); SEAM(pb + 11); }
        if (SITE(12) && IN(pb + 12)) { SITE_IDS; const float* ng1 = ap->in[I_NORMG] + (size_t)3 * D; const float* mod1 = (const float*)(ws + WS_MOD) + MODL;
            slab_reduce(hS, hS, SLAB, KS_G2, l == 0 ? HN : nullptr, ng1, mod1 + 1 * D, l == 0 ? SSQ + (size_t)2 * M : nullptr, gw, NGW, lane); SEAM(pb + 12); }
    }
    { const int l = 0; if (SITE(13) && IN(NPH - 1)) { SITE_IDS; if ((DUP_MASK >> 7) & 1u) final_norm(h, (float*)(ws + WS_DUMMY), ap->in[I_FNORMG], gw, NGW, lane); final_norm(h, h, ap->in[I_FNORMG], gw, NGW, lane); } }
#undef IN
#undef SEAM
#undef SITE
#undef SITE_IDS
}

extern "C" void kernel_launch(void* const* d_in, const int* in_sizes, int n_in, void* d_out, int out_size, void* d_ws, size_t ws_size, hipStream_t stream) {
    static int grid = 0;
    if (grid == 0) {
        if (n_in != 25 || in_sizes[0] != NPR * D || (size_t)out_size != O_END || ws_size < WS_END) { fprintf(stderr, "kernel_launch: unexpected shapes (n_in %d, in0 %d, out %d, ws %zu); nothing launched\n", n_in, n_in > 0 ? in_sizes[0] : -1, out_size, ws_size); grid = -1; return; }
        int dev = 0, cus = 0, per_cu = 0;
        if (hipGetDevice(&dev) != hipSuccess || hipDeviceGetAttribute(&cus, hipDeviceAttributeMultiprocessorCount, dev) != hipSuccess) { fprintf(stderr, "kernel_launch: device query failed\n"); grid = -1; return; }
        if (hipFuncSetAttribute((const void*)mk_fwd, hipFuncAttributeMaxDynamicSharedMemorySize, LDS_BYTES) != hipSuccess) { fprintf(stderr, "kernel_launch: hipFuncSetAttribute failed\n"); grid = -1; return; }
        if (hipOccupancyMaxActiveBlocksPerMultiprocessor(&per_cu, (const void*)mk_fwd, NWAVES * 64, LDS_BYTES) != hipSuccess || per_cu < 1) fprintf(stderr, "kernel_launch: note: occupancy query reports %d workgroups per CU\n", per_cu);
        (void)hipGetLastError();
        grid = cus;
    }
    if (grid < 0) return;
    if (hipMemsetAsync((char*)d_ws + WS_CTL, 0, CTL_ZERO_BYTES, stream) != hipSuccess) { fprintf(stderr, "kernel_launch: memset failed\n"); return; }
    Args a{};
    for (int i = 0; i < 25; ++i) a.in[i] = (const float*)d_in[i];
    a.out = (float*)d_out; a.ws = (unsigned char*)d_ws;
#if MK_N_LAUNCHES == 1
    a.ph_lo = 0; a.ph_hi = NPH;
    hipLaunchKernelGGL(mk_fwd, dim3(grid), dim3(NWAVES * 64), LDS_BYTES, stream, a);
#else
    for (int p = 0; p < NPH; ++p) { if (p == 1 + 4 || p == 1 + 9 || p == 1 + NPL + 0 || p == 1 + NPL + 5 || p == 1 + NPL + 6 || p == 1 + NPL + 8 || p == 1 + NPL + 9) continue; a.ph_lo = p; a.ph_hi = p + 1; hipLaunchKernelGGL(mk_fwd, dim3(grid), dim3(NWAVES * 64), LDS_BYTES, stream, a); }
#endif
    const hipError_t le = hipPeekAtLastError();
    if (le != hipSuccess) fprintf(stderr, "kernel_launch: launch failed: %s\n", hipGetErrorName(le));
}
```

```cpp
#include <hip/hip_runtime.h>
#include <cstdio>
#include <cstdint>

#ifndef MK_N_LAUNCHES
#define MK_N_LAUNCHES 1
#endif

#ifndef DUP_MASK
#define DUP_MASK 0u
#endif

constexpr int D = 2048, DFF = 5632, NPR = 4 * 8192, NSR = 8 * 64, M = NPR + NSR;
constexpr int NSTREAM = 12, MODS = 9 * D, MODL = NSTREAM * MODS;
constexpr int AW = 1024;
constexpr float EPS = 1e-6f;

constexpr size_t MiB = 1u << 20;
constexpr size_t WS_CTL = 0, CTL_ZERO_BYTES = 4 * MiB;
constexpr size_t WS_VSTAT = 64 * 1024;
constexpr size_t WS_MOD = 1 * MiB;
constexpr size_t WS_SS = 3 * MiB;
constexpr size_t WS_SB = 4 * MiB + 512 * 1024;
constexpr size_t WS_WM = 4 * MiB;
constexpr size_t WS_WGU = 8 * MiB;
constexpr size_t WS_WD = 184 * MiB;
constexpr size_t WS_WIN = 272 * MiB;
constexpr size_t WS_WOUT = 288 * MiB;
constexpr size_t WS_WC = 296 * MiB;
constexpr size_t WS_HN = 300 * MiB;
constexpr size_t WS_ACT = 432 * MiB;
constexpr size_t WS_U = WS_ACT, WS_V = WS_ACT + 65 * MiB, WS_GLU = WS_ACT + 130 * MiB, WS_CAT = WS_ACT + 195 * MiB, WS_PC = WS_ACT;
constexpr size_t WS_SLAB = 790 * MiB;
constexpr size_t WS_END = 836 * MiB;
constexpr size_t WS_DUMMY = 840 * MiB;
static_assert(WS_SLAB + (size_t)11 * NSR * D * 4 <= WS_END, "slab map");
static_assert(WS_VSTAT + (size_t)M * 8 <= WS_MOD && WS_MOD + (size_t)2 * MODL * 4 <= WS_SS && WS_SS + (size_t)6 * M * 4 <= CTL_ZERO_BYTES && WS_WM + 4 * 128 * 128 * 2 <= WS_SB && WS_SB + (size_t)5 * 12 * 11264 * 4 <= WS_WGU, "ctl map");
static_assert(WS_WGU + 4 * (size_t)11264 * 2048 * 2 <= WS_WD && WS_WD + 4 * (size_t)2048 * 5632 * 2 <= WS_WIN && WS_WIN + (size_t)4096 * 2048 * 2 <= WS_WOUT, "weights map");
static_assert(WS_HN + (size_t)M * D * 2 <= WS_ACT && WS_ACT + (size_t)M * DFF * 2 <= WS_END && WS_CAT + (size_t)M * D * 2 <= WS_END && (size_t)M * AW * 2 <= 65 * MiB, "act map");
constexpr int CW_TMO = 0, CW_BAR = 4096;

constexpr size_t O_Y = 0, O_NCP = (size_t)M * D, O_NCS = O_NCP + 4 * 30 * 1024, O_NPP = O_NCS + 8 * 30 * 1024, O_NPS = O_NPP + 4 * 15 * 2048, O_NAV = O_NPS + 8 * 15 * 2048, O_END = O_NAV + 8 * 64 * 1024;

constexpr int RING_BYTES = 131072, LDSCTL_OFF = RING_BYTES, MISC_OFF = LDSCTL_OFF + 320, LDS_BYTES = 147456;
constexpr int NWAVES = 8;

#define GAS __attribute__((address_space(1)))
#define LAS __attribute__((address_space(3)))
typedef unsigned short bf16;
typedef unsigned v4u __attribute__((ext_vector_type(4)));
typedef unsigned v2u __attribute__((ext_vector_type(2)));
typedef float f32x4 __attribute__((ext_vector_type(4)));
typedef float f32x2 __attribute__((ext_vector_type(2)));
typedef short bf16x8 __attribute__((ext_vector_type(8)));
#define LDS_WAIT() asm volatile("s_waitcnt lgkmcnt(0)" ::: "memory")
#define VM_WAIT() asm volatile("s_waitcnt vmcnt(0)" ::: "memory")

__device__ __forceinline__ unsigned f2bf(float f) { unsigned u = __builtin_bit_cast(unsigned, f); return (u + 0x7fffu + ((u >> 16) & 1u)) >> 16; }
__device__ __forceinline__ unsigned pk2(float lo, float hi) { return f2bf(lo) | (f2bf(hi) << 16); }
__device__ __forceinline__ unsigned cvt_pk_bf16(float lo, float hi) { unsigned r; asm volatile("v_cvt_pk_bf16_f32 %0, %1, %2" : "=v"(r) : "v"(lo), "v"(hi)); return r; }
__device__ __forceinline__ float bflo(unsigned w) { return __builtin_bit_cast(float, w << 16); }
__device__ __forceinline__ float bfhi(unsigned w) { return __builtin_bit_cast(float, w & 0xffff0000u); }
__device__ __forceinline__ float sigmoidf_(float x) { return __builtin_amdgcn_rcpf(1.0f + __builtin_amdgcn_exp2f(-1.4426950409f * x)); }
__device__ __forceinline__ float siluf_(float x) { return x * sigmoidf_(x); }
__device__ __forceinline__ float gelu_tanh(float x) { return x * __builtin_amdgcn_rcpf(1.0f + __builtin_amdgcn_exp2f(-2.302208198f * x * (1.0f + 0.044715f * x * x))); }
__device__ __forceinline__ float wave_sum(float v) {
#pragma unroll
    for (int o = 1; o < 64; o <<= 1) v += __shfl_xor(v, o);
    return v;
}
__device__ __forceinline__ int stream_of_row(int r) { return r < NPR ? (r >> 13) : 4 + ((r - NPR) >> 6); }

namespace pg8 {
typedef unsigned short bf16_t;
constexpr int BM = 256, BK = 64, HALF = 128, HTB = HALF * BK * 2, STAGE_BYTES = 8 * HTB, NXCD = 8, WGM = 8;
__host__ __device__ __forceinline__ int lds_byte(int r, int c) { const int st = (r >> 4) * 2 + (c >> 5), rr = r & 15, cc = c & 31, ob = rr * 64 + cc * 2; return st * 1024 + (ob ^ (((ob >> 9) & 1) << 5)); }
__host__ __device__ __forceinline__ void stage_rc(int b, int& R, int& C) { const int st = b / 1024, sb = b % 1024, swz = sb ^ (((sb >> 9) & 1) << 5); R = (st >> 1) * 16 + swz / 64; C = (st & 1) * 32 + (swz % 64) / 2; }
__host__ __device__ __forceinline__ int perm32(int rho) { const int n = rho >> 4, i = rho & 15; return 8 * (i >> 2) + 4 * n + (i & 3); }

struct Unit { int pm, pn, kt0, ktn, slab; };
struct Gemm { const bf16_t* A; const bf16_t* Bt; int M, N, K, lda, tpg; };

struct StaticOrder {
    int nMp, nMt, nN, nwgP, nTail, G, c, ntk, ksplit, ktper, wgm;
    __host__ __device__ void init(int Mp, int Mt, int N_, int K_, int G_, int c_, int ksplit_, int wgm_ = WGM) { wgm = wgm_; nMp = Mp / BM; nMt = Mt / BM; nN = N_ / BM; nwgP = nMp * nN; G = G_; c = c_; ntk = K_ / BK; ksplit = ksplit_; ktper = ntk / ksplit_; nTail = nMt * nN * ksplit_; }
    __host__ __device__ bool next(int i, Unit& u) const {
        const long L = (long)i * G + c;
        if (L < nwgP) {
            int wgid = (int)L; { const int q = nwgP / NXCD, r = nwgP % NXCD, xcd = wgid % NXCD, off = wgid / NXCD; wgid = (xcd < r ? xcd * (q + 1) : r * (q + 1) + (xcd - r) * q) + off; }
            const int nig = wgm * nN, gid = wgid / nig, fm = gid * wgm, gsz = (nMp - fm) < wgm ? (nMp - fm) : wgm;
            u.pm = fm + ((wgid % nig) % gsz); u.pn = (wgid % nig) / gsz; u.kt0 = 0; u.ktn = ntk; u.slab = -1; return true;
        }
        const long j = L - nwgP; if (j >= nTail) return false;
        const int kc = (int)j % ksplit, t = (int)j / ksplit;
        u.pm = nMp + t / nN; u.pn = t % nN; u.kt0 = kc * ktper; u.ktn = ktper; u.slab = ksplit > 1 ? kc : -1; return true;
    }
};


struct EpiSwiGLU {
    static constexpr bool PERM = true;
    bf16_t* O; int ldc; const float* ss; const float* sb;
    __device__ __forceinline__ void preload(const Unit& u, float (&pre)[8], int wr, int fr) const {
#pragma unroll
        for (int i = 0; i < 8; ++i) pre[i] = ss ? ss[u.pm * BM + wr * 64 + fr + (i >> 2) * HALF + (i & 3) * 16] : 0.f; }
    __device__ __forceinline__ void operator()(const f32x4 (&acc)[2][2][4][2], const Unit& u, int wr, int wc, int fr, int fq, const float (&pre)[8]) const {
        const int row0 = u.pm * BM + wr * 64 + fr, col0 = u.pn * HALF + wc * 32 + 8 * fq, wrow0 = u.pn * BM + wc * 32 + 8 * fq;
#pragma unroll
        for (int ai = 0; ai < 2; ++ai) {
            f32x4 sg0 = (f32x4){0.f, 0.f, 0.f, 0.f}, sg1 = sg0, su0 = sg0, su1 = sg0;
            if (ss) { const float* sp = sb + (size_t)stream_of_row(u.pm * BM + ai * HALF + wr * 64) * 11264 + wrow0;
                sg0 = *(const f32x4*)sp; sg1 = *(const f32x4*)(sp + 4); su0 = *(const f32x4*)(sp + HALF); su1 = *(const f32x4*)(sp + HALF + 4); }
#pragma unroll
            for (int m = 0; m < 4; ++m) {
                const int r = row0 + ai * HALF + m * 16;
                const float rstd = ss ? rsqrtf(pre[ai * 4 + m] * (1.0f / D) + EPS) : 1.0f;
                bf16_t* rowp = O + (size_t)r * ldc + col0;
                const f32x4 g0 = acc[ai][0][m][0] * rstd + sg0, g1 = acc[ai][0][m][1] * rstd + sg1, u0 = acc[ai][1][m][0] * rstd + su0, u1 = acc[ai][1][m][1] * rstd + su1;
                v4u w;
                w.x = cvt_pk_bf16(siluf_(g0[0]) * u0[0], siluf_(g0[1]) * u0[1]); w.y = cvt_pk_bf16(siluf_(g0[2]) * u0[2], siluf_(g0[3]) * u0[3]);
                w.z = cvt_pk_bf16(siluf_(g1[0]) * u1[0], siluf_(g1[1]) * u1[1]); w.w = cvt_pk_bf16(siluf_(g1[2]) * u1[2], siluf_(g1[3]) * u1[3]);
                __builtin_nontemporal_store(w, (v4u*)rowp);
            }
        }
    }
};

template <bool HB> struct EpiRes {
    static constexpr bool PERM = true;
    const float* base_p; const float* base_s; float* out; const float* gate; const float* bias; const float* cs; float* slab; bf16_t* an; const float* ng_n; const float* sc_n; float* ss; float alpha; int pad_;
    __device__ __forceinline__ void preload(const Unit&, float (&)[8], int, int) const {}
    __device__ __forceinline__ void operator()(const f32x4 (&acc)[2][2][4][2], const Unit& u, int wr, int wc, int fr, int fq, const float (&)[8]) const {
        const int col0 = u.pn * BM + wc * 32 + 8 * fq;
#pragma unroll
        for (int ai = 0; ai < 2; ++ai) {
            const int rbase = u.pm * BM + ai * HALF + wr * 64;
            const int s = stream_of_row(rbase);
            float q[4] = {0.f, 0.f, 0.f, 0.f};
#pragma unroll
            for (int bj = 0; bj < 2; ++bj) {
                const int c = col0 + bj * HALF;
                f32x4 gv[2], bv[2], gn[2];
#pragma unroll
                for (int n = 0; n < 2; ++n) { gv[n] = *(const f32x4*)(gate + (size_t)s * MODS + c + 4 * n) * alpha; bv[n] = (f32x4){0.f, 0.f, 0.f, 0.f}; gn[n] = bv[n];
                    if (HB) { gv[n] = gv[n] * *(const f32x4*)(cs + c + 4 * n); bv[n] = *(const f32x4*)(bias + c + 4 * n); }
                    if (an) gn[n] = *(const f32x4*)(ng_n + c + 4 * n) * (*(const f32x4*)(sc_n + (size_t)s * MODS + c + 4 * n) + 1.0f); }
#pragma unroll
                for (int m = 0; m < 4; ++m) {
                    const int r = rbase + m * 16 + fr;
                    if (u.slab >= 0) {
                        float* sp = slab + ((size_t)u.slab * NSR + (size_t)(r - NPR)) * D + c;
                        *(f32x4*)sp = gv[0] * (acc[ai][bj][m][0] + bv[0]); *(f32x4*)(sp + 4) = gv[1] * (acc[ai][bj][m][1] + bv[1]);
                    } else {
                        const float* bp = ((rbase < NPR) ? base_p + (size_t)r * D : base_s + (size_t)(r - NPR) * D) + c;
                        const f32x4 o0 = *(const f32x4*)bp + gv[0] * (acc[ai][bj][m][0] + bv[0]), o1 = *(const f32x4*)(bp + 4) + gv[1] * (acc[ai][bj][m][1] + bv[1]);
                        float* op = out + (size_t)r * D + c; *(f32x4*)op = o0; *(f32x4*)(op + 4) = o1;
                        if (ss) q[m] += ((o0[0] * o0[0] + o0[1] * o0[1]) + (o0[2] * o0[2] + o0[3] * o0[3])) + ((o1[0] * o1[0] + o1[1] * o1[1]) + (o1[2] * o1[2] + o1[3] * o1[3]));
                        if (an) { const f32x4 t0 = o0 * gn[0], t1 = o1 * gn[1]; v4u w; w.x = cvt_pk_bf16(t0[0], t0[1]); w.y = cvt_pk_bf16(t0[2], t0[3]); w.z = cvt_pk_bf16(t1[0], t1[1]); w.w = cvt_pk_bf16(t1[2], t1[3]);
                            *(v4u*)(an + (size_t)r * D + c) = w; }
                    }
                }
            }
            if (ss && u.slab < 0) {
#pragma unroll
                for (int m = 0; m < 4; ++m) { float t = q[m]; t += __shfl_xor(t, 16); t += __shfl_xor(t, 32); if (fq == 0) unsafeAtomicAdd(ss + rbase + m * 16 + fr, t); } }
        }
    }
};

struct EpiInProj {
    static constexpr bool PERM = true;
    bf16_t *U, *V, *GLU; float* vstat; float* ncp; float* ncs; const float* ss; const float* sb;
    __device__ __forceinline__ void preload(const Unit& u, float (&pre)[8], int wr, int fr) const {
#pragma unroll
        for (int i = 0; i < 8; ++i) pre[i] = ss[u.pm * BM + wr * 64 + fr + (i >> 2) * HALF + (i & 3) * 16]; }
    __device__ __forceinline__ void operator()(const f32x4 (&acc)[2][2][4][2], const Unit& u, int wr, int wc, int fr, int fq, const float (&pre)[8]) const {
        const int row0 = u.pm * BM + wr * 64 + fr;
        if (u.pn < 8) {
            const bool isv = u.pn >= 4; bf16_t* O = isv ? V : U; const int col0 = (u.pn & 3) * BM + wc * 32 + 8 * fq;
#pragma unroll
            for (int ai = 0; ai < 2; ++ai) {
                const float* sp = sb + (size_t)stream_of_row(u.pm * BM + ai * HALF + wr * 64) * 4096 + u.pn * BM + wc * 32 + 8 * fq;
                f32x4 sv[2][2];
#pragma unroll
                for (int bj = 0; bj < 2; ++bj) { sv[bj][0] = *(const f32x4*)(sp + bj * HALF); sv[bj][1] = *(const f32x4*)(sp + bj * HALF + 4); }
#pragma unroll
                for (int m = 0; m < 4; ++m) { const int r = row0 + ai * HALF + m * 16; float s1 = 0.f, s2 = 0.f;
                    const float rstd = rsqrtf(pre[ai * 4 + m] * (1.0f / D) + EPS);
#pragma unroll
                    for (int bj = 0; bj < 2; ++bj) { f32x4 v0 = acc[ai][bj][m][0] * rstd + sv[bj][0], v1 = acc[ai][bj][m][1] * rstd + sv[bj][1];
#pragma unroll
                        for (int j = 0; j < 4; ++j) { v0[j] = gelu_tanh(v0[j]); v1[j] = gelu_tanh(v1[j]); s1 += v0[j] + v1[j]; s2 += v0[j] * v0[j] + v1[j] * v1[j]; }
                        v4u w; w.x = cvt_pk_bf16(v0[0], v0[1]); w.y = cvt_pk_bf16(v0[2], v0[3]); w.z = cvt_pk_bf16(v1[0], v1[1]); w.w = cvt_pk_bf16(v1[2], v1[3]);
                        *(v4u*)(O + (size_t)r * AW + col0 + bj * HALF) = w; }
                    if (isv) { s1 += __shfl_xor(s1, 16); s1 += __shfl_xor(s1, 32); s2 += __shfl_xor(s2, 16); s2 += __shfl_xor(s2, 32);
                        if (fq == 0) { unsafeAtomicAdd(vstat + 2 * (size_t)r, s1); unsafeAtomicAdd(vstat + 2 * (size_t)r + 1, s2); } }
                }
            }
        } else {
            const int col0 = (u.pn - 8) * HALF + wc * 32 + 8 * fq;
#pragma unroll
            for (int ai = 0; ai < 2; ++ai) {
                const int rbase = u.pm * BM + ai * HALF + wr * 64;
                const bool tailp = (rbase < NPR) && ((rbase & 8191) == 8128), tails = rbase >= NPR;
                const float* sp = sb + (size_t)stream_of_row(rbase) * 4096 + u.pn * BM + wc * 32 + 8 * fq;
                const f32x4 sa0 = *(const f32x4*)sp, sa1 = *(const f32x4*)(sp + 4), sg0 = *(const f32x4*)(sp + HALF), sg1 = *(const f32x4*)(sp + HALF + 4);
#pragma unroll
                for (int m = 0; m < 4; ++m) { const int r = rbase + m * 16 + fr;
                    const float rstd = rsqrtf(pre[ai * 4 + m] * (1.0f / D) + EPS);
                    const f32x4 a0 = acc[ai][0][m][0] * rstd + sa0, a1 = acc[ai][0][m][1] * rstd + sa1, g0 = acc[ai][1][m][0] * rstd + sg0, g1 = acc[ai][1][m][1] * rstd + sg1;
                    f32x4 o0, o1;
#pragma unroll
                    for (int j = 0; j < 4; ++j) { o0[j] = a0[j] * sigmoidf_(g0[j]); o1[j] = a1[j] * sigmoidf_(g1[j]); }
                    v4u w; w.x = cvt_pk_bf16(o0[0], o0[1]); w.y = cvt_pk_bf16(o0[2], o0[3]); w.z = cvt_pk_bf16(o1[0], o1[1]); w.w = cvt_pk_bf16(o1[2], o1[3]);
                    *(v4u*)(GLU + (size_t)r * AW + col0) = w;
                    if (tailp) { const int t = r & 8191; if (t >= 8162) { float* dst = ncp + ((size_t)((r >> 13) * 30 + (t - 8162)) * 1024 + col0); *(f32x4*)dst = o0; *(f32x4*)(dst + 4) = o1; } }
                    if (tails) { const int rr = r - NPR, t = rr & 63; if (t >= 34) { float* dst = ncs + ((size_t)((rr >> 6) * 30 + (t - 34)) * 1024 + col0); *(f32x4*)dst = o0; *(f32x4*)(dst + 4) = o1; } }
                }
            }
        }
    }
};

template <class Epi, bool ALIGN_EPI>
__device__ __forceinline__ void gemm_phase(LAS unsigned char* lds, const Gemm g, const StaticOrder& S, const Epi& E) {
    int tid_ = threadIdx.x; asm volatile("" : "+v"(tid_));
    const int tid = tid_, wid = __builtin_amdgcn_readfirstlane(tid >> 6), lane = tid & 63, wr = wid >> 2, wc = wid & 3, fr = lane & 15, fq = lane >> 4;
    const int K = g.K;
    unsigned voffA[2], voffB[2];
#pragma unroll
    for (int i = 0; i < 2; ++i) { int R, C; stage_rc(tid * 16 + i * 8192, R, C); const int Rb = Epi::PERM ? ((R & ~31) + perm32(R & 31)) : R;
        voffA[i] = (unsigned)(R * g.lda + C) * 2u; voffB[i] = (unsigned)(Rb * K + C) * 2u; }
    const size_t kstep = (size_t)(BK * 2);
    const size_t hA = (size_t)HALF * g.lda * 2, hB = (size_t)HALF * K * 2;
    const size_t tA = 2 * hA, tB = 2 * hB;
    const unsigned ldsw = (unsigned)wid * 1024u;
    const int aoff = lds_byte(wr * 64 + fr, fq * 8), boff = lds_byte(wc * 32 + fr, fq * 8);
#define PG8_SA(b, h) (((b) * 2 + (h)) * HTB)
#define PG8_SB(b, h) ((4 + (b) * 2 + (h)) * HTB)
#define PG8_STAGE(bufoff, gbase, voff) do { _Pragma("unroll") for (int _i = 0; _i < 2; ++_i) \
        __builtin_amdgcn_global_load_lds((const unsigned*)((const char*)(gbase) + (voff)[_i]), (LAS unsigned*)(lds + (bufoff) + ldsw + _i * 8192), 16, 0, 0); } while (0)
#define PG8_LDA(dst, b, h) do { _Pragma("unroll") for (int m = 0; m < 4; ++m) _Pragma("unroll") for (int k = 0; k < 2; ++k) dst[m][k] = *(const LAS bf16x8*)(lds + PG8_SA(b, h) + aoff + m * 2048 + k * 1024); } while (0)
#define PG8_LDB(dst, b, h) do { _Pragma("unroll") for (int n = 0; n < 2; ++n) _Pragma("unroll") for (int k = 0; k < 2; ++k) dst[n][k] = *(const LAS bf16x8*)(lds + PG8_SB(b, h) + boff + n * 2048 + k * 1024); } while (0)
#define PG8_MMA(ai, bj, At, Bt) do { __builtin_amdgcn_s_setprio(1); _Pragma("unroll") for (int m = 0; m < 4; ++m) _Pragma("unroll") for (int n = 0; n < 2; ++n) _Pragma("unroll") for (int k = 0; k < 2; ++k) \
        acc[ai][bj][m][n] = __builtin_amdgcn_mfma_f32_16x16x32_bf16(Bt[n][k], At[m][k], acc[ai][bj][m][n], 0, 0, 0); __builtin_amdgcn_s_setprio(0); } while (0)
#define PG8_WAIT_V(n) asm volatile("s_waitcnt vmcnt(" #n ")" ::: "memory")
#define PG8_WAIT_L(n) asm volatile("s_waitcnt lgkmcnt(" #n ")" ::: "memory")
#define PG8_BAR __builtin_amdgcn_s_barrier()
#define PG8_SCHED __builtin_amdgcn_sched_barrier(0)
#define PG8_APTR(u) ((const char*)g.A + (size_t)(u).pm * tA + (g.tpg ? (size_t)((u).pn / g.tpg) * (size_t)K * 2 : (size_t)0) + (size_t)(u).kt0 * kstep)
#define PG8_BPTR(u) ((const char*)g.Bt + (size_t)(u).pn * tB + (size_t)(u).kt0 * kstep)
    Unit cur, nxt; int ui = 0;
    if (!S.next(0, cur)) return;
    f32x4 acc[2][2][4][2];
#pragma unroll
    for (int a = 0; a < 2; ++a)
#pragma unroll
        for (int b = 0; b < 2; ++b)
#pragma unroll
            for (int m = 0; m < 4; ++m)
#pragma unroll
                for (int n = 0; n < 2; ++n) acc[a][b][m][n] = (f32x4){0.f, 0.f, 0.f, 0.f};
    bf16x8 At[4][2], B0[2][2], B1[2][2];
    const char* cA = PG8_APTR(cur); const char* cB = PG8_BPTR(cur);
    float pre[8]; E.preload(cur, pre, wr, fr);
    PG8_STAGE(PG8_SB(0, 0), cB, voffB); PG8_STAGE(PG8_SB(0, 1), cB + hB, voffB); PG8_STAGE(PG8_SA(0, 0), cA, voffA); PG8_STAGE(PG8_SA(0, 1), cA + hA, voffA);
    if (wr == 1) PG8_BAR;
    PG8_WAIT_V(2); PG8_BAR;
    PG8_STAGE(PG8_SB(1, 0), cB + kstep, voffB); PG8_STAGE(PG8_SA(1, 0), cA + kstep, voffA); PG8_STAGE(PG8_SB(1, 1), cB + hB + kstep, voffB);
    PG8_WAIT_V(6); PG8_BAR;
    for (;;) {
        const bool has_next = S.next(ui + 1, nxt);
        const char* nA = has_next ? PG8_APTR(nxt) : cA; const char* nB = has_next ? PG8_BPTR(nxt) : cB;
        const int nt = cur.ktn;
        for (int t = 0; t < nt; t += 2) {
            const bool last = (t == nt - 2);
            const char* a1 = cA + (size_t)(t + 1) * kstep;
            const char* a2 = last ? nA : cA + (size_t)(t + 2) * kstep; const char* b2 = last ? nB : cB + (size_t)(t + 2) * kstep;
            const char* a3 = a2 + kstep; const char* b3 = b2 + kstep;
            PG8_LDB(B0, 0, 0); PG8_LDB(B1, 0, 1); PG8_SCHED; PG8_LDA(At, 0, 0); PG8_STAGE(PG8_SA(1, 1), a1 + hA, voffA);
            PG8_WAIT_V(8); PG8_WAIT_L(0); PG8_BAR; PG8_MMA(0, 0, At, B0); PG8_MMA(0, 1, At, B1); PG8_BAR; PG8_SCHED;
            PG8_LDA(At, 0, 1); PG8_STAGE(PG8_SB(0, 0), b2, voffB); PG8_STAGE(PG8_SB(0, 1), b2 + hB, voffB); PG8_STAGE(PG8_SA(0, 0), a2, voffA);
            PG8_WAIT_V(8); PG8_WAIT_L(0); PG8_BAR; PG8_MMA(1, 0, At, B0); PG8_MMA(1, 1, At, B1); PG8_BAR; PG8_SCHED;
            PG8_LDB(B0, 1, 0); PG8_LDB(B1, 1, 1); PG8_SCHED; PG8_LDA(At, 1, 0); PG8_STAGE(PG8_SA(0, 1), a2 + hA, voffA);
            PG8_WAIT_V(8); PG8_WAIT_L(0); PG8_BAR; PG8_MMA(0, 0, At, B0); PG8_MMA(0, 1, At, B1); PG8_BAR; PG8_SCHED;
            PG8_LDA(At, 1, 1); PG8_STAGE(PG8_SB(1, 0), b3, voffB); PG8_STAGE(PG8_SB(1, 1), b3 + hB, voffB); PG8_STAGE(PG8_SA(1, 0), a3, voffA);
            PG8_WAIT_V(8); PG8_WAIT_L(0); PG8_BAR; PG8_MMA(1, 0, At, B0); PG8_MMA(1, 1, At, B1); PG8_BAR; PG8_SCHED;
        }
        if constexpr (ALIGN_EPI) { if (wr == 0) PG8_BAR; }
        E(acc, cur, wr, wc, fr, fq, pre);
        if (!has_next) break;
        E.preload(nxt, pre, wr, fr);
#pragma unroll
        for (int a = 0; a < 2; ++a)
#pragma unroll
            for (int b = 0; b < 2; ++b)
#pragma unroll
                for (int m = 0; m < 4; ++m)
#pragma unroll
                    for (int n = 0; n < 2; ++n) acc[a][b][m][n] = (f32x4){0.f, 0.f, 0.f, 0.f};
        cur = nxt; cA = nA; cB = nB; ++ui;
        if constexpr (ALIGN_EPI) { if (wr == 1) PG8_BAR; }
    }
    PG8_WAIT_V(0);
    if constexpr (!ALIGN_EPI) { if (wr == 0) PG8_BAR; }
    PG8_BAR;
#undef PG8_SA
#undef PG8_SB
#undef PG8_STAGE
#undef PG8_LDA
#undef PG8_LDB
#undef PG8_MMA
#undef PG8_WAIT_V
#undef PG8_WAIT_L
#undef PG8_BAR
#undef PG8_SCHED
#undef PG8_APTR
#undef PG8_BPTR
}
}

#define XB_TMO      128
#define XB_XCNT(j)  (256  + 64 * (j))
#define XB_XSUB(j)  (1280 + 64 * (j))
#define XB_XGEN(j)  (2304 + 64 * (j))
#define XB_TOP      3328
#define XB_TOPGEN   3392
#define XCD_BAR_WORDS 3456
#define XB_SPIN_CAP (1u << 18)
__device__ __forceinline__ unsigned xb_ld(unsigned* p)              { return __hip_atomic_load(p, __ATOMIC_RELAXED, __HIP_MEMORY_SCOPE_AGENT); }
__device__ __forceinline__ unsigned xb_add(unsigned* p, unsigned v) { return __hip_atomic_fetch_add(p, v, __ATOMIC_RELAXED, __HIP_MEMORY_SCOPE_AGENT); }
__device__ __forceinline__ unsigned xb_xcc_id() { return (unsigned)__builtin_amdgcn_s_getreg((3 << 11) | 20) & 0xFu; }
#define XB_SPIN(cond, bar) do { unsigned _sp = 0; while (cond) { __builtin_amdgcn_s_sleep(1); \
    if ((++_sp & 255u) == 0u) { if (xb_ld(&(bar)[XB_TMO])) break; if (_sp > XB_SPIN_CAP) { atomicAdd(&(bar)[XB_TMO], 1u); break; } } } } while (0)
struct XcdBarrier { unsigned* bar; unsigned x; volatile LAS unsigned* st; };
__device__ __forceinline__ XcdBarrier xcd_barrier_post(unsigned* bar, volatile LAS unsigned* st) {
    XcdBarrier b; b.bar = bar; b.x = xb_xcc_id(); b.st = st;
    if (threadIdx.x == 0) (void)xb_add(&bar[XB_XCNT(b.x)], 1u);
    return b;
}
__device__ __forceinline__ void xcd_barrier_complete(unsigned* bar, unsigned x, unsigned& nloc, unsigned& nx) {
    const unsigned G = gridDim.x * gridDim.y * gridDim.z;
    unsigned sum, cnt, mine, sp = 0u;
    for (;;) {
        sum = 0u; cnt = 0u; mine = 0u;
#pragma unroll
        for (unsigned j = 0; j < 16; ++j) { const unsigned c = xb_ld(&bar[XB_XCNT(j)]); sum += c; cnt += (c > 0u) ? 1u : 0u; mine = (j == x) ? c : mine; }
        if (sum == G) break;
        __builtin_amdgcn_s_sleep(1);
        if ((++sp & 255u) == 0u) { if (xb_ld(&bar[XB_TMO])) break; if (sp > XB_SPIN_CAP) { atomicAdd(&bar[XB_TMO], 1u); break; } }
    }
    nloc = mine > 0u ? mine : 1u; nx = cnt > 0u ? cnt : 1u;
}
__device__ __forceinline__ void xcd_barrier(const XcdBarrier& b) {
    asm volatile("s_waitcnt vmcnt(0)" ::: "memory");
    __syncthreads();
    if (threadIdx.x == 0) {
        unsigned* bar = b.bar;
        __builtin_amdgcn_s_waitcnt(0);
        unsigned nloc = b.st[0], nx = b.st[1];
        if (nloc == 0u) { xcd_barrier_complete(bar, b.x, nloc, nx); b.st[0] = nloc; b.st[1] = nx; }
        const unsigned old = xb_add(&bar[XB_XSUB(b.x)], 1u);
        const unsigned gen = old / nloc;
        if (old + 1u == (gen + 1u) * nloc) {
            __builtin_amdgcn_fence(__ATOMIC_RELEASE, "agent");
            asm volatile("s_waitcnt vmcnt(0)" ::: "memory");
            const unsigned og = xb_add(&bar[XB_TOP], 1u);
            const unsigned tg = og / nx;
            if (og + 1u == (tg + 1u) * nx) xb_add(&bar[XB_TOPGEN], 1u);
            else XB_SPIN(xb_ld(&bar[XB_TOPGEN]) == tg, bar);
            __builtin_amdgcn_fence(__ATOMIC_ACQUIRE, "agent");
            xb_add(&bar[XB_XGEN(b.x)], 1u);
            asm volatile("s_waitcnt vmcnt(0)" ::: "memory");
        } else {
            XB_SPIN(xb_ld(&bar[XB_XGEN(b.x)]) == gen, bar);
            __builtin_amdgcn_fence(__ATOMIC_ACQUIRE, "agent");
            asm volatile("s_waitcnt vmcnt(0)" ::: "memory");
        }
    }
    __syncthreads();
}

struct Args { const float* in[25]; float* out; unsigned char* ws; int ph_lo, ph_hi; };
typedef const __attribute__((address_space(4))) Args* CArgsP;
enum { I_XP = 0, I_XS, I_CP, I_CS, I_SCONV, I_SPOOL, I_ADAW, I_ADAB, I_NORMG, I_FNORMG, I_WG, I_WU, I_WD, I_WIN, I_AVG, I_AVB, I_AWS, I_ABS, I_BDW, I_BLNG, I_BLNB, I_WOUT, I_CW, I_CB, I_CSC };

__device__ __forceinline__ void p0_transpose_item(const float* W, int K, int N, bf16* WT, int dest0, LAS float* scr, int k0, int n0, int lane) {
    float v[32];
#pragma unroll
    for (int i = 0; i < 32; ++i) v[i] = __builtin_nontemporal_load(W + (size_t)(k0 + 2 * i + (lane >> 5)) * N + n0 + (lane & 31));
#pragma unroll
    for (int i = 0; i < 32; ++i) scr[(2 * i + (lane >> 5)) * 33 + (lane & 31)] = v[i];
    LDS_WAIT(); asm volatile("" ::: "memory");
    const int c = lane & 7;
#pragma unroll
    for (int j = 0; j < 4; ++j) { const int n = (lane >> 3) + 8 * j; const LAS float* s = scr + (8 * c) * 33 + n;
        v4u o; o.x = pk2(s[0 * 33], s[1 * 33]); o.y = pk2(s[2 * 33], s[3 * 33]); o.z = pk2(s[4 * 33], s[5 * 33]); o.w = pk2(s[6 * 33], s[7 * 33]);
        *(v4u*)(WT + (size_t)(dest0 + n) * K + k0 + 8 * c) = o; }
    LDS_WAIT(); asm volatile("" ::: "memory");
}
__device__ __forceinline__ void p0_ada_item(CArgsP a, float* mod, LAS float* scr, int idx, int lane) {
    const int ks = idx & 15, cb = (idx >> 4) % 72, l = idx / (16 * 72), k0 = ks * 128, n = cb * 256 + 4 * lane;
#pragma unroll
    for (int s = 0; s < NSTREAM; ++s)
#pragma unroll
        for (int h = 0; h < 2; ++h) { const int k = lane + 64 * h; const float cv = (s < 4) ? a->in[I_CP][s * D + k0 + k] : a->in[I_CS][(s - 4) * D + k0 + k]; scr[s * 128 + k] = siluf_(cv); }
    LDS_WAIT(); asm volatile("" ::: "memory");
    f32x4 acc[NSTREAM];
#pragma unroll
    for (int s = 0; s < NSTREAM; ++s) acc[s] = (f32x4){0.f, 0.f, 0.f, 0.f};
    const float* Wp = a->in[I_ADAW] + ((size_t)l * D + k0) * MODS + n;
#pragma unroll 4
    for (int k = 0; k < 128; ++k) { const f32x4 w = *(const f32x4*)(Wp + (size_t)k * MODS);
#pragma unroll
        for (int s = 0; s < NSTREAM; ++s) acc[s] += w * scr[s * 128 + k]; }
    if (ks == 0) { const f32x4 b = *(const f32x4*)(a->in[I_ADAB] + (size_t)l * MODS + n);
#pragma unroll
        for (int s = 0; s < NSTREAM; ++s) acc[s] += b; }
#pragma unroll
    for (int s = 0; s < NSTREAM; ++s) { float* dst = mod + (size_t)l * MODL + (size_t)s * MODS + n;
#pragma unroll
        for (int j = 0; j < 4; ++j) unsafeAtomicAdd(dst + j, acc[s][j]); }
    LDS_WAIT(); asm volatile("" ::: "memory");
}
constexpr int P0_ADA = 2 * 72 * 16, P0_GU = 5632, P0_WD = 5632, P0_WIN = 4096, P0_WOUT = 2048, P0_WC = 128, P0_WM = 16;
constexpr int P0_TR = 8 * P0_GU + 4 * P0_WD + P0_WIN + P0_WOUT + 4 * P0_WC, P0_TOTAL = P0_ADA + P0_TR + P0_WM;
__device__ __forceinline__ void p0_prologue(CArgsP a, LAS unsigned char* lds, int gw, int NGW, int wave, int lane) {
    LAS float* scr = (LAS float*)(lds + wave * 16384);
    unsigned char* ws = a->ws;
    for (int it = gw; it < P0_TOTAL + (int)((DUP_MASK >> 4) & 1u) * (P0_TOTAL - P0_ADA); it += NGW) {
        int r = it < P0_TOTAL ? it : it - P0_TOTAL + P0_ADA;
        if (r < P0_ADA) { if ((DUP_MASK >> 7) & 1u) p0_ada_item(a, (float*)(ws + WS_DUMMY), scr, r, lane); p0_ada_item(a, (float*)(ws + WS_MOD), scr, r, lane); continue; } r -= P0_ADA;
        if (r < 8 * P0_GU) { const int up = r >= 4 * P0_GU, rr = up ? r - 4 * P0_GU : r, f = rr / P0_GU, i2 = rr % P0_GU, kb = i2 / 176, nb = i2 % 176, n0 = 32 * nb;
            p0_transpose_item(a->in[up ? I_WU : I_WG] + (size_t)f * D * DFF, D, DFF, (bf16*)(ws + WS_WGU) + (size_t)f * 11264 * 2048, 256 * (n0 >> 7) + (n0 & 127) + (up ? 128 : 0), scr, 64 * kb, n0, lane); continue; }
        r -= 8 * P0_GU;
        if (r < 4 * P0_WD) { const int f = r / P0_WD, i2 = r % P0_WD, kb = i2 / 64, nb = i2 % 64;
            p0_transpose_item(a->in[I_WD] + (size_t)f * DFF * D, DFF, D, (bf16*)(ws + WS_WD) + (size_t)f * 2048 * 5632, 32 * nb, scr, 64 * kb, 32 * nb, lane); continue; }
        r -= 4 * P0_WD;
        if (r < P0_WIN) { const int kb = r / 128, nb = r % 128, n0 = 32 * nb; int d0;
            if (n0 < 2048) d0 = n0; else if (n0 < 3072) { const int j = n0 - 2048; d0 = 2048 + 256 * (j >> 7) + (j & 127); } else { const int j = n0 - 3072; d0 = 2048 + 256 * (j >> 7) + 128 + (j & 127); }
            p0_transpose_item(a->in[I_WIN], D, 4096, (bf16*)(ws + WS_WIN), d0, scr, 64 * kb, n0, lane); continue; }
        r -= P0_WIN;
        if (r < P0_WOUT) { const int kb = r / 64, nb = r % 64; p0_transpose_item(a->in[I_WOUT], D, D, (bf16*)(ws + WS_WOUT), 32 * nb, scr, 64 * kb, 32 * nb, lane); continue; }
        r -= P0_WOUT;
        if (r < 4 * P0_WC) { const int g = r / P0_WC, i2 = r % P0_WC, kb = i2 / 16, nb = i2 % 16;
            p0_transpose_item(a->in[I_CW] + (size_t)g * 512 * 512, 512, 512, (bf16*)(ws + WS_WC), g * 512 + 32 * nb, scr, 64 * kb, 32 * nb, lane); continue; }
        r -= 4 * P0_WC;
        { bf16* wm = (bf16*)(ws + WS_WM);
#pragma unroll 4
          for (int i = 0; i < 64; ++i) { const int idx = r * 4096 + i * 64 + lane, ii = (idx >> 7) & 127, jj = idx & 127; const float v = a->in[I_AWS][idx]; wm[idx] = (bf16)(((jj >> 6) <= (ii >> 6)) ? f2bf(v) : 0u); } }
    }
}

__device__ __forceinline__ void thin_norm(const float* hp, const float* hs, const float* ng, const float* shift, const float* scale, bf16* HN, int gw, int NGW, int lane) {
    const int r0 = (int)(((long)gw * M) / NGW), r1 = (int)(((long)(gw + 1) * M) / NGW);
    int cur_s = -1; f32x4 gs[8], sh[8];
#pragma unroll
    for (int j = 0; j < 8; ++j) { gs[j] = (f32x4){0.f, 0.f, 0.f, 0.f}; sh[j] = gs[j]; }
    for (int r = r0; r < r1; ++r) {
        const int s = stream_of_row(r);
        if (s != cur_s) { cur_s = s;
#pragma unroll
            for (int j = 0; j < 8; ++j) { const int c = 4 * lane + 256 * j; gs[j] = *(const f32x4*)(ng + c) * (*(const f32x4*)(scale + (size_t)s * MODS + c) + 1.0f); sh[j] = *(const f32x4*)(shift + (size_t)s * MODS + c); } }
        const float* xr = (r < NPR) ? hp + (size_t)r * D : hs + (size_t)(r - NPR) * D;
        f32x4 v[8]; float ss = 0.f;
#pragma unroll
        for (int j = 0; j < 8; ++j) { v[j] = *(const f32x4*)(xr + 4 * lane + 256 * j); ss += (v[j].x * v[j].x + v[j].y * v[j].y) + (v[j].z * v[j].z + v[j].w * v[j].w); }
        const float rstd = rsqrtf(wave_sum(ss) * (1.0f / D) + EPS);
        bf16* orow = HN + (size_t)r * D;
#pragma unroll
        for (int j = 0; j < 8; ++j) { const f32x4 o = v[j] * rstd * gs[j] + sh[j]; v2u w; w.x = pk2(o.x, o.y); w.y = pk2(o.z, o.w); *(v2u*)(orow + 4 * lane + 256 * j) = w; }
    }
}
__device__ __forceinline__ void final_norm(float* h, float* yo, const float* ng, int gw, int NGW, int lane) {
    const int r0 = (int)(((long)gw * M) / NGW), r1 = (int)(((long)(gw + 1) * M) / NGW);
    f32x4 gs[8];
#pragma unroll
    for (int j = 0; j < 8; ++j) gs[j] = *(const f32x4*)(ng + 4 * lane + 256 * j);
    for (int r = r0; r < r1; ++r) {
        float* xr = h + (size_t)r * D;
        f32x4 v[8]; float ss = 0.f;
#pragma unroll
        for (int j = 0; j < 8; ++j) { v[j] = *(const f32x4*)(xr + 4 * lane + 256 * j); ss += (v[j].x * v[j].x + v[j].y * v[j].y) + (v[j].z * v[j].z + v[j].w * v[j].w); }
        const float rstd = rsqrtf(wave_sum(ss) * (1.0f / D) + EPS);
#pragma unroll
        for (int j = 0; j < 8; ++j) *(f32x4*)(yo + (size_t)r * D + 4 * lane + 256 * j) = v[j] * rstd * gs[j];
    }
}

constexpr int VNT_STRIDE_DW = 68;
__device__ __forceinline__ void mix_gate_unit(CArgsP a, LAS unsigned char* lds, int ch, int g, int tid, int wave, int lane) {
    unsigned char* ws = a->ws;
    LAS unsigned* vnT = (LAS unsigned*)lds;
    LAS float* st = (LAS float*)(lds + 256 * VNT_STRIDE_DW * 4);
    const bool smp = ch >= 256; const int r0 = smp ? NPR + 64 * (ch - 256) : 128 * ch, nrows = smp ? 64 : 128;
    const float* vstat = (const float*)(ws + WS_VSTAT); const bf16* V = (const bf16*)(ws + WS_V); const bf16* U = (const bf16*)(ws + WS_U); bf16* CAT = (bf16*)(ws + WS_CAT);
    if (tid < 128) { float mean = 0.f, rstd = 0.f;
        if (tid < nrows) { const float s1 = vstat[2 * (size_t)(r0 + tid)], s2 = vstat[2 * (size_t)(r0 + tid) + 1]; mean = s1 * (1.0f / AW); const float var = fmaxf(s2 * (1.0f / AW) - mean * mean, 0.f); rstd = rsqrtf(var + EPS); }
        st[2 * tid] = mean; st[2 * tid + 1] = rstd; }
    __syncthreads();
#pragma unroll 1
    for (int it = 0; it < 4; ++it) {
        const int idx = it * 512 + tid, p = idx & 63, o = idx >> 6, c = g * 256 + 8 * o;
        const f32x4 g0 = *(const f32x4*)(a->in[I_AVG] + c), g1 = *(const f32x4*)(a->in[I_AVG] + c + 4), b0 = *(const f32x4*)(a->in[I_AVB] + c), b1 = *(const f32x4*)(a->in[I_AVB] + c + 4);
        float na[8], nb[8];
#pragma unroll
        for (int h = 0; h < 2; ++h) { const int j = 2 * p + h; float* dstv = h ? nb : na;
            if (j < nrows) { const v4u w = *(const v4u*)(V + (size_t)(r0 + j) * AW + c); const float mean = st[2 * j], rstd = st[2 * j + 1];
                dstv[0] = (bflo(w.x) - mean) * rstd * g0[0] + b0[0]; dstv[1] = (bfhi(w.x) - mean) * rstd * g0[1] + b0[1]; dstv[2] = (bflo(w.y) - mean) * rstd * g0[2] + b0[2]; dstv[3] = (bfhi(w.y) - mean) * rstd * g0[3] + b0[3];
                dstv[4] = (bflo(w.z) - mean) * rstd * g1[0] + b1[0]; dstv[5] = (bfhi(w.z) - mean) * rstd * g1[1] + b1[1]; dstv[6] = (bflo(w.w) - mean) * rstd * g1[2] + b1[2]; dstv[7] = (bfhi(w.w) - mean) * rstd * g1[3] + b1[3];
                if (smp) { float* av = a->out + O_NAV + (size_t)((ch - 256) * 64 + j) * AW + c; *(f32x4*)av = (f32x4){dstv[0], dstv[1], dstv[2], dstv[3]}; *(f32x4*)(av + 4) = (f32x4){dstv[4], dstv[5], dstv[6], dstv[7]}; }
            } else {
#pragma unroll
                for (int i = 0; i < 8; ++i) dstv[i] = 0.f; } }
#pragma unroll
        for (int i = 0; i < 8; ++i) vnT[(8 * o + i) * VNT_STRIDE_DW + p] = pk2(na[i], nb[i]);
    }
    __syncthreads();
    const int lr = lane & 15, lq = lane >> 4;
    f32x4 acc[2][8];
#pragma unroll
    for (int ct = 0; ct < 2; ++ct)
#pragma unroll
        for (int it = 0; it < 8; ++it) acc[ct][it] = (f32x4){0.f, 0.f, 0.f, 0.f};
    const bf16* wm = (const bf16*)(ws + WS_WM) + (size_t)g * 16384;
#pragma unroll
    for (int ks = 0; ks < 4; ++ks) {
        bf16x8 af[2];
#pragma unroll
        for (int ct = 0; ct < 2; ++ct) af[ct] = *(const LAS bf16x8*)((const LAS unsigned char*)vnT + (32 * wave + 16 * ct + lr) * (VNT_STRIDE_DW * 4) + ks * 64 + lq * 16);
#pragma unroll
        for (int it = 0; it < 8; ++it) { const bf16x8 bfrag = *(const bf16x8*)(wm + (16 * it + lr) * 128 + 32 * ks + 8 * lq);
#pragma unroll
            for (int ct = 0; ct < 2; ++ct) acc[ct][it] = __builtin_amdgcn_mfma_f32_16x16x32_bf16(af[ct], bfrag, acc[ct][it], 0, 0, 0); }
    }
#pragma unroll
    for (int it = 0; it < 8; ++it) { const int i = 16 * it + lr;
        if (i < nrows) { const float bsv = a->in[I_ABS][g * 128 + i];
#pragma unroll
            for (int ct = 0; ct < 2; ++ct) { const int cb = g * 256 + 32 * wave + 16 * ct + 4 * lq;
                const v2u uw = *(const v2u*)(U + (size_t)(r0 + i) * AW + cb);
                v2u w; w.x = pk2(bflo(uw.x) * (acc[ct][it][0] + bsv), bfhi(uw.x) * (acc[ct][it][1] + bsv)); w.y = pk2(bflo(uw.y) * (acc[ct][it][2] + bsv), bfhi(uw.y) * (acc[ct][it][3] + bsv));
                *(v2u*)(CAT + (size_t)(r0 + i) * D + cb) = w; } } }
    __syncthreads();
}
__device__ __forceinline__ f32x2 conv_row(const bf16* GLU, const float* hist, int rowbase, int t, int c) {
    if (t >= 0) { const unsigned w = *(const unsigned*)(GLU + (size_t)(rowbase + t) * AW + c); return (f32x2){bflo(w), bfhi(w)}; }
    if (hist) return *(const f32x2*)(hist + (size_t)(30 + t) * 1024 + c);
    return (f32x2){0.f, 0.f};
}
__device__ __forceinline__ void mix_conv_unit(CArgsP a, LAS unsigned char* lds, int b, int tid, int wave, int lane) {
    unsigned char* ws = a->ws;
    LAS float* red = (LAS float*)lds;
    LAS float* stt = red + 128;
    int rowbase, t0; const float* hist = nullptr;
    if (b < 1024) { rowbase = 8192 * (b >> 8); t0 = 32 * (b & 255); } else { const int q = b - 1024; rowbase = NPR + 64 * (q >> 1); t0 = 32 * (q & 1); hist = a->in[I_SCONV] + (size_t)(q >> 1) * 30 * 1024; }
    const bf16* GLU = (const bf16*)(ws + WS_GLU); bf16* CAT = (bf16*)(ws + WS_CAT);
    const int c = 2 * tid;
    const f32x2 lg = *(const f32x2*)(a->in[I_BLNG] + c), lb = *(const f32x2*)(a->in[I_BLNB] + c);
    f32x2 wk[31];
#pragma unroll
    for (int k = 0; k < 31; ++k) wk[k] = *(const f32x2*)(a->in[I_BDW] + (size_t)k * 1024 + c);
    f32x2 x[38];
#pragma unroll
    for (int i = 0; i < 30; ++i) x[i] = conv_row(GLU, hist, rowbase, t0 - 30 + i, c);
#pragma unroll 1
    for (int sub = 0; sub < 4; ++sub) {
        const int tt0 = t0 + 8 * sub;
#pragma unroll
        for (int i = 0; i < 8; ++i) x[30 + i] = conv_row(GLU, hist, rowbase, tt0 + i, c);
        f32x2 acc[8];
#pragma unroll
        for (int t = 0; t < 8; ++t) acc[t] = (f32x2){0.f, 0.f};
#pragma unroll
        for (int k = 0; k < 31; ++k)
#pragma unroll
            for (int t = 0; t < 8; ++t) acc[t] += x[t + k] * wk[k];
#pragma unroll
        for (int t = 0; t < 8; ++t) { const float s1 = wave_sum(acc[t].x + acc[t].y), s2 = wave_sum(acc[t].x * acc[t].x + acc[t].y * acc[t].y);
            if (lane == 0) { red[(wave * 8 + t) * 2] = s1; red[(wave * 8 + t) * 2 + 1] = s2; } }
        __syncthreads();
        if (tid < 8) { float s1 = 0.f, s2 = 0.f;
#pragma unroll
            for (int w = 0; w < 8; ++w) { s1 += red[(w * 8 + tid) * 2]; s2 += red[(w * 8 + tid) * 2 + 1]; }
            const float mean = s1 * (1.0f / AW), var = fmaxf(s2 * (1.0f / AW) - mean * mean, 0.f); stt[2 * tid] = mean; stt[2 * tid + 1] = rsqrtf(var + EPS); }
        __syncthreads();
#pragma unroll
        for (int t = 0; t < 8; ++t) { const float mean = stt[2 * t], rstd = stt[2 * t + 1];
            const float y0 = (acc[t].x - mean) * rstd * lg.x + lb.x, y1 = (acc[t].y - mean) * rstd * lg.y + lb.y;
            *(unsigned*)(CAT + (size_t)(rowbase + tt0 + t) * D + AW + c) = pk2(siluf_(y0), siluf_(y1)); }
#pragma unroll
        for (int i = 0; i < 30; ++i) x[i] = x[i + 8];
    }
    __syncthreads();
}
__device__ __forceinline__ f32x4 tc_hm(const float* h, const float* hist, const LAS float* rs, int rowbase, int t0, int t, int c, f32x4 gs, f32x4 sh) {
    if (t >= 0) return *(const f32x4*)(h + (size_t)(rowbase + t) * D + c) * rs[t - t0 + 15] * gs + sh;
    if (hist) return *(const f32x4*)(hist + (size_t)(15 + t) * D + c);
    return (f32x4){0.f, 0.f, 0.f, 0.f};
}
__device__ __forceinline__ void tc_unit(CArgsP a, LAS unsigned char* lds, const float* h, const float* ssq, const float* ng, const float* shift, const float* scale, int b, int tid, int wave, int lane) {
    unsigned char* ws = a->ws;
    LAS float* rs = (LAS float*)lds;
    int rowbase, t0, s, T, pos0; const float* hist = nullptr; float* np;
    if (b < 1024) { s = b >> 8; rowbase = 8192 * s; t0 = 32 * (b & 255); T = 8192; pos0 = 0; np = a->out + O_NPP + (size_t)s * 15 * D; }
    else { const int q = b - 1024; s = 4 + (q >> 1); rowbase = NPR + 64 * (q >> 1); t0 = 32 * (q & 1); T = 64; pos0 = 1024; hist = a->in[I_SPOOL] + (size_t)(q >> 1) * 15 * D; np = a->out + O_NPS + (size_t)(q >> 1) * 15 * D; }
    if (tid < 47) { const int t = t0 - 15 + tid; if (t >= 0) rs[tid] = rsqrtf(ssq[rowbase + t] * (1.0f / D) + EPS); }
    __syncthreads();
    const int c = 4 * tid, grp = __builtin_amdgcn_readfirstlane(tid >> 7), w = 2 << grp;
    const f32x4 gs = *(const f32x4*)(ng + c) * (*(const f32x4*)(scale + (size_t)s * MODS + c) + 1.0f), sh = *(const f32x4*)(shift + (size_t)s * MODS + c);
    bf16* PC = (bf16*)(ws + WS_PC);
    f32x4 S = (f32x4){0.f, 0.f, 0.f, 0.f};
    for (int k = 1; k < w; ++k) S += tc_hm(h, hist, rs, rowbase, t0, t0 - k, c, gs, sh);
#pragma unroll 4
    for (int tt = 0; tt < 32; ++tt) { const int t = t0 + tt;
        const f32x4 cur = tc_hm(h, hist, rs, rowbase, t0, t, c, gs, sh);
        S += cur;
        const int pos = pos0 + t; const float inv = 1.0f / (float)(pos + 1 < w ? pos + 1 : w);
        const f32x4 p = S * inv - cur;
        v2u o; o.x = pk2(p.x, p.y); o.y = pk2(p.z, p.w); *(v2u*)(PC + (size_t)(rowbase + t) * D + c) = o;
        if (t >= T - 15) *(f32x4*)(np + (size_t)(t - (T - 15)) * D + c) = cur;
        S -= tc_hm(h, hist, rs, rowbase, t0, t - w + 1, c, gs, sh);
    }
    __syncthreads();
}

__device__ __forceinline__ void slab_reduce(const float* base_s, float* hS, const float* slab, int ks, bf16* an, const float* ng_n, const float* sc_n, float* ss, int gw, int NGW, int lane) {
    for (int r = gw; r < NSR; r += NGW) {
        const int s = 4 + (r >> 6);
        f32x4 v[8]; float q = 0.f;
#pragma unroll
        for (int j = 0; j < 8; ++j) v[j] = *(const f32x4*)(base_s + (size_t)r * D + 4 * lane + 256 * j);
#pragma unroll 1
        for (int k = 0; k < ks; ++k) {
#pragma unroll
            for (int j = 0; j < 8; ++j) v[j] += *(const f32x4*)(slab + ((size_t)k * NSR + r) * D + 4 * lane + 256 * j); }
#pragma unroll
        for (int j = 0; j < 8; ++j) { const int c = 4 * lane + 256 * j; *(f32x4*)(hS + (size_t)r * D + c) = v[j]; q += (v[j].x * v[j].x + v[j].y * v[j].y) + (v[j].z * v[j].z + v[j].w * v[j].w);
            if (an) { const f32x4 t = v[j] * (*(const f32x4*)(ng_n + c) * (*(const f32x4*)(sc_n + (size_t)s * MODS + c) + 1.0f)); v2u w; w.x = pk2(t.x, t.y); w.y = pk2(t.z, t.w); *(v2u*)(an + (size_t)(NPR + r) * D + c) = w; } }
        if (ss) { q = wave_sum(q); if (lane == 0) ss[NPR + r] = q; }
    }
}
constexpr int SHL_STRIDE = D + 8;
__device__ __forceinline__ void sb_gemv(LAS unsigned char* lds, const bf16* Wt, int nrows, const float* shift, float* sb, int gw, int NGW, int tid, int lane) {
    LAS bf16* shl = (LAS bf16*)lds;
    __syncthreads();
    for (int i = tid; i < 16 * (D / 8); i += NWAVES * 64) { const int s = i / (D / 8), c8 = i % (D / 8); v4u w = (v4u){0u, 0u, 0u, 0u};
        if (s < NSTREAM) { const float* p = shift + (size_t)s * MODS + 8 * c8; const f32x4 a = *(const f32x4*)p, b = *(const f32x4*)(p + 4); w.x = pk2(a.x, a.y); w.y = pk2(a.z, a.w); w.z = pk2(b.x, b.y); w.w = pk2(b.z, b.w); }
        *(LAS v4u*)(shl + s * SHL_STRIDE + 8 * c8) = w; }
    __syncthreads();
    const int lr = lane & 15, lq = lane >> 4;
    for (int tile = gw; tile < nrows / 16; tile += NGW) {
        const int n0 = 16 * tile;
        f32x4 acc = (f32x4){0.f, 0.f, 0.f, 0.f};
        const bf16* wp = Wt + (size_t)(n0 + lr) * D + 8 * lq; const LAS bf16* ap = shl + lr * SHL_STRIDE + 8 * lq;
#pragma unroll 8
        for (int ks = 0; ks < D / 32; ++ks) acc = __builtin_amdgcn_mfma_f32_16x16x32_bf16(*(const LAS bf16x8*)(ap + 32 * ks), *(const bf16x8*)(wp + 32 * ks), acc, 0, 0, 0);
#pragma unroll
        for (int j = 0; j < 4; ++j) { const int s = 4 * lq + j; if (s < NSTREAM) sb[(size_t)s * nrows + n0 + lr] = acc[j]; }
    }
}

constexpr int NPL = 13, NPH = 2 + 2 * NPL;
constexpr int KS_G2 = 11, KS_G4 = 8;
__global__ void __launch_bounds__(NWAVES * 64, 2) mk_fwd(Args args) {
    extern __shared__ __attribute__((aligned(16))) unsigned char lds_raw[];
    LAS unsigned char* lds = (LAS unsigned char*)lds_raw;
    volatile LAS unsigned* MISC = (volatile LAS unsigned*)(lds + MISC_OFF);
    const int G = gridDim.x, bx = blockIdx.x, vcu = (G % 8 == 0) ? (bx % 8) * (G / 8) + bx / 8 : bx, NGW = G * NWAVES;
    for (int u = threadIdx.x; u < (LDS_BYTES - LDSCTL_OFF) / 4; u += NWAVES * 64) ((LAS unsigned*)(lds + LDSCTL_OFF))[u] = 0u;
    __syncthreads();
    const int lo = args.ph_lo, hi = args.ph_hi;
    XcdBarrier bar; bar.bar = (unsigned*)(args.ws + WS_CTL) + CW_BAR; bar.x = 0; bar.st = nullptr;
    if (hi - lo > 1) bar = xcd_barrier_post((unsigned*)(args.ws + WS_CTL) + CW_BAR, MISC + 8);
#ifndef PH_MASK
#define PH_MASK 0xFFFFFFFFu
#endif
#define SITE(i) ((PH_MASK >> (i)) & 1u)
#define REP(i) for (int rep_ = 0; rep_ < 1 + (int)((DUP_MASK >> (i)) & 1u); ++rep_)
#define IN(k) (lo <= (k) && (k) < hi)
#define SEAM(k) do { if ((k) + 1 < hi) { xcd_barrier(bar); if ((DUP_MASK >> 7) & 1u) xcd_barrier(bar); } } while (0)
#define SITE_IDS int tid = threadIdx.x; asm volatile("" : "+v"(tid)); const int lane = tid & 63, wave = __builtin_amdgcn_readfirstlane(tid >> 6), gw = vcu * NWAVES + wave; (void)lane; (void)gw; \
    CArgsP ap = (CArgsP)__builtin_amdgcn_kernarg_segment_ptr(); asm volatile("" : "+s"(ap)); unsigned char* ws = ap->ws; float* h = ap->out; float* hS = h + (size_t)NPR * D; (void)hS; \
    const float* modl = (const float*)(ws + WS_MOD) + (size_t)l * MODL; const float* ngl = ap->in[I_NORMG] + (size_t)l * 3 * D; (void)modl; (void)ngl; \
    bf16* HN = (bf16*)(ws + WS_HN); bf16* ACT = (bf16*)(ws + WS_ACT); float* SLAB = (float*)(ws + WS_SLAB); float* SSQ = (float*)(ws + WS_SS); (void)HN; (void)ACT; (void)SLAB; (void)SSQ

    { const int l = 0; if (SITE(0) && IN(0)) { SITE_IDS; p0_prologue(ap, lds, gw, NGW, wave, lane); SEAM(0); } }

#pragma unroll 1
    for (int l = 0; l < 2; ++l) {
        const int pb = 1 + NPL * l;
        if (l == 0 && SITE(1) && IN(pb + 0)) { SITE_IDS; const float* mod0 = (const float*)(ws + WS_MOD); const float* mod1 = mod0 + MODL; float* SB = (float*)(ws + WS_SB);
            REP(1) thin_norm(ap->in[I_XP], ap->in[I_XS], ngl, modl + 0 * D, modl + 1 * D, HN, gw, NGW, lane);
            sb_gemv(lds, (const bf16*)(ws + WS_WGU) + (size_t)1 * 11264 * 2048, 11264, mod0 + 6 * D, SB + (size_t)1 * 12 * 11264, gw, NGW, tid, lane);
            sb_gemv(lds, (const bf16*)(ws + WS_WGU) + (size_t)2 * 11264 * 2048, 11264, mod1 + 0 * D, SB + (size_t)2 * 12 * 11264, gw, NGW, tid, lane);
            sb_gemv(lds, (const bf16*)(ws + WS_WGU) + (size_t)3 * 11264 * 2048, 11264, mod1 + 6 * D, SB + (size_t)3 * 12 * 11264, gw, NGW, tid, lane);
            sb_gemv(lds, (const bf16*)(ws + WS_WIN), 4096, mod0 + 3 * D, SB + (size_t)4 * 12 * 11264, gw, NGW, tid, lane);
            SEAM(pb + 0); }
        if (SITE(2) && IN(pb + 1)) { SITE_IDS; pg8::Gemm g{HN, (const bf16*)(ws + WS_WGU) + (size_t)(2 * l) * 11264 * 2048, M, 11264, D, D, 0}; pg8::StaticOrder S; S.init(NPR, NSR, 11264, D, G, bx, 1);
            pg8::EpiSwiGLU E{ACT, DFF, l == 0 ? nullptr : SSQ + (size_t)2 * M, (const float*)(ws + WS_SB) + (size_t)2 * 12 * 11264}; REP(0) pg8::gemm_phase<pg8::EpiSwiGLU, true>(lds, g, S, E); SEAM(pb + 1); }
        if (SITE(3) && IN(pb + 2)) { SITE_IDS; pg8::Gemm g{ACT, (const bf16*)(ws + WS_WD) + (size_t)(2 * l) * 2048 * 5632, M, D, DFF, DFF, 0}; pg8::StaticOrder S; S.init(NPR, NSR, D, DFF, G, bx, KS_G2, 4);
            pg8::EpiRes<false> E{l == 0 ? ap->in[I_XP] : h, l == 0 ? ap->in[I_XS] : hS, h, modl + 2 * D, nullptr, nullptr, SLAB, l == 0 ? HN : nullptr, ngl + D, modl + 4 * D, SSQ + (size_t)(l == 0 ? 0 : 3) * M, 0.5f, 0};
            if ((DUP_MASK >> 5) & 1u) { pg8::EpiRes<false> E2 = E; E2.out = (float*)(ws + WS_DUMMY); E2.an = nullptr; E2.ss = nullptr; pg8::gemm_phase<pg8::EpiRes<false>, true>(lds, g, S, E2); }
            pg8::gemm_phase<pg8::EpiRes<false>, true>(lds, g, S, E); SEAM(pb + 2); }
        if (SITE(3) && IN(pb + 3)) { SITE_IDS; slab_reduce(l == 0 ? ap->in[I_XS] : hS, hS, SLAB, KS_G2, l == 0 ? HN : nullptr, ngl + D, modl + 4 * D, SSQ + (size_t)(l == 0 ? 0 : 3) * M, gw, NGW, lane); SEAM(pb + 3); }
        if (l == 0) {
            if (SITE(5) && IN(pb + 5)) { SITE_IDS; pg8::Gemm g{HN, (const bf16*)(ws + WS_WIN), M, 4096, D, D, 0}; pg8::StaticOrder S; S.init(NPR, NSR, 4096, D, G, bx, 1);
                pg8::EpiInProj E{(bf16*)(ws + WS_U), (bf16*)(ws + WS_V), (bf16*)(ws + WS_GLU), (float*)(ws + WS_VSTAT), h + O_NCP, h + O_NCS, SSQ, (const float*)(ws + WS_SB) + (size_t)4 * 12 * 11264};
                if ((DUP_MASK >> 6) & 1u) { pg8::EpiInProj E2 = E; E2.vstat = (float*)(ws + WS_DUMMY); pg8::gemm_phase<pg8::EpiInProj, true>(lds, g, S, E2); }
                pg8::gemm_phase<pg8::EpiInProj, true>(lds, g, S, E); SEAM(pb + 5); }
            if (SITE(6) && IN(pb + 6)) { SITE_IDS;
                REP(2) for (int u = vcu; u < 1056 + 1040; u += G) { if (u < 1056) { if (SITE(20)) mix_gate_unit(ap, lds, u >> 2, u & 3, tid, wave, lane); } else { if (SITE(21)) mix_conv_unit(ap, lds, u - 1056, tid, wave, lane); } }
                SEAM(pb + 6); }
            if (SITE(7) && IN(pb + 7)) { SITE_IDS; pg8::Gemm g{(const bf16*)(ws + WS_CAT), (const bf16*)(ws + WS_WOUT), M, D, D, D, 0}; pg8::StaticOrder S; S.init(NPR, NSR, D, D, G, bx, KS_G4);
                pg8::EpiRes<false> E{h, hS, h, modl + 5 * D, nullptr, nullptr, SLAB, HN, ngl + 2 * D, modl + 7 * D, SSQ + (size_t)1 * M, 1.0f, 0};
                if ((DUP_MASK >> 6) & 1u) { pg8::EpiRes<false> E2 = E; E2.out = (float*)(ws + WS_DUMMY); E2.an = nullptr; E2.ss = nullptr; pg8::gemm_phase<pg8::EpiRes<false>, true>(lds, g, S, E2); }
                pg8::gemm_phase<pg8::EpiRes<false>, true>(lds, g, S, E); SEAM(pb + 7); }
            if (SITE(7) && IN(pb + 8)) { SITE_IDS; slab_reduce(hS, hS, SLAB, KS_G4, HN, ngl + 2 * D, modl + 7 * D, SSQ + (size_t)1 * M, gw, NGW, lane); SEAM(pb + 8); }
        } else {
            if (SITE(8) && IN(pb + 4)) { SITE_IDS; REP(3) for (int u = vcu; u < 1040; u += G) tc_unit(ap, lds, h, SSQ + (size_t)3 * M, ngl + D, modl + 3 * D, modl + 4 * D, u, tid, wave, lane); SEAM(pb + 4); }
            if (SITE(9) && IN(pb + 7)) { SITE_IDS; pg8::Gemm g{(const bf16*)(ws + WS_PC), (const bf16*)(ws + WS_WC), M, D, 512, D, 2}; pg8::StaticOrder S; S.init(NPR, NSR, D, 512, G, bx, 1);
                pg8::EpiRes<true> E{h, hS, h, modl + 5 * D, ap->in[I_CB], ap->in[I_CSC], SLAB, HN, ngl + 2 * D, modl + 7 * D, SSQ + (size_t)4 * M, 1.0f, 0};
                if ((DUP_MASK >> 6) & 1u) { pg8::EpiRes<true> E2 = E; E2.out = (float*)(ws + WS_DUMMY); E2.an = nullptr; E2.ss = nullptr; pg8::gemm_phase<pg8::EpiRes<true>, true>(lds, g, S, E2); }
                pg8::gemm_phase<pg8::EpiRes<true>, true>(lds, g, S, E); SEAM(pb + 7); }
        }
        if (SITE(11) && IN(pb + 10)) { SITE_IDS; pg8::Gemm g{HN, (const bf16*)(ws + WS_WGU) + (size_t)(2 * l + 1) * 11264 * 2048, M, 11264, D, D, 0}; pg8::StaticOrder S; S.init(NPR, NSR, 11264, D, G, bx, 1);
            pg8::EpiSwiGLU E{ACT, DFF, SSQ + (size_t)(l == 0 ? 1 : 4) * M, (const float*)(ws + WS_SB) + (size_t)(2 * l + 1) * 12 * 11264}; REP(0) pg8::gemm_phase<pg8::EpiSwiGLU, true>(lds, g, S, E); SEAM(pb + 10); }
        if (SITE(12) && IN(pb + 11)) { SITE_IDS; pg8::Gemm g{ACT, (const bf16*)(ws + WS_WD) + (size_t)(2 * l + 1) * 2048 * 5632, M, D, DFF, DFF, 0}; pg8::StaticOrder S; S.init(NPR, NSR, D, DFF, G, bx, KS_G2, 4);
            const float* ng1 = ap->in[I_NORMG] + (size_t)3 * D; const float* mod1 = (const float*)(ws + WS_MOD) + MODL;
            pg8::EpiRes<false> E{h, hS, h, modl + 8 * D, nullptr, nullptr, SLAB, l == 0 ? HN : nullptr, ng1, mod1 + 1 * D, l == 0 ? SSQ + (size_t)2 * M : nullptr, 0.5f, 0};
            if ((DUP_MASK >> 5) & 1u) { pg8::EpiRes<false> E2 = E; E2.out = (float*)(ws + WS_DUMMY); E2.an = nullptr; E2.ss = nullptr; pg8::gemm_phase<pg8::EpiRes<false>, true>(lds, g, S, E2); }
            pg8::gemm_phase<pg8::EpiRes<false>, true>(lds, g, S, E); SEAM(pb + 11); }
        if (SITE(12) && IN(pb + 12)) { SITE_IDS; const float* ng1 = ap->in[I_NORMG] + (size_t)3 * D; const float* mod1 = (const float*)(ws + WS_MOD) + MODL;
            slab_reduce(hS, hS, SLAB, KS_G2, l == 0 ? HN : nullptr, ng1, mod1 + 1 * D, l == 0 ? SSQ + (size_t)2 * M : nullptr, gw, NGW, lane); SEAM(pb + 12); }
    }
    { const int l = 0; if (SITE(13) && IN(NPH - 1)) { SITE_IDS; if ((DUP_MASK >> 7) & 1u) final_norm(h, (float*)(ws + WS_DUMMY), ap->in[I_FNORMG], gw, NGW, lane); final_norm(h, h, ap->in[I_FNORMG], gw, NGW, lane); } }
#undef IN
#undef SEAM
#undef SITE
#undef SITE_IDS
}

extern "C" void kernel_launch(void* const* d_in, const int* in_sizes, int n_in, void* d_out, int out_size, void* d_ws, size_t ws_size, hipStream_t stream) {
    static int grid = 0;
    if (grid == 0) {
        if (n_in != 25 || in_sizes[0] != NPR * D || (size_t)out_size != O_END || ws_size < WS_END) { fprintf(stderr, "kernel_launch: unexpected shapes (n_in %d, in0 %d, out %d, ws %zu); nothing launched\n", n_in, n_in > 0 ? in_sizes[0] : -1, out_size, ws_size); grid = -1; return; }
        int dev = 0, cus = 0, per_cu = 0;
        if (hipGetDevice(&dev) != hipSuccess || hipDeviceGetAttribute(&cus, hipDeviceAttributeMultiprocessorCount, dev) != hipSuccess) { fprintf(stderr, "kernel_launch: device query failed\n"); grid = -1; return; }
        if (hipFuncSetAttribute((const void*)mk_fwd, hipFuncAttributeMaxDynamicSharedMemorySize, LDS_BYTES) != hipSuccess) { fprintf(stderr, "kernel_launch: hipFuncSetAttribute failed\n"); grid = -1; return; }
        if (hipOccupancyMaxActiveBlocksPerMultiprocessor(&per_cu, (const void*)mk_fwd, NWAVES * 64, LDS_BYTES) != hipSuccess || per_cu < 1) fprintf(stderr, "kernel_launch: note: occupancy query reports %d workgroups per CU\n", per_cu);
        (void)hipGetLastError();
        grid = cus;
    }
    if (grid < 0) return;
    if (hipMemsetAsync((char*)d_ws + WS_CTL, 0, CTL_ZERO_BYTES, stream) != hipSuccess) { fprintf(stderr, "kernel_launch: memset failed\n"); return; }
    Args a{};
    for (int i = 0; i < 25; ++i) a.in[i] = (const float*)d_in[i];
    a.out = (float*)d_out; a.ws = (unsigned char*)d_ws;
#if MK_N_LAUNCHES == 1
    a.ph_lo = 0; a.ph_hi = NPH;
    hipLaunchKernelGGL(mk_fwd, dim3(grid), dim3(NWAVES * 64), LDS_BYTES, stream, a);
#else
    for (int p = 0; p < NPH; ++p) { if (p == 1 + 4 || p == 1 + 9 || p == 1 + NPL + 0 || p == 1 + NPL + 5 || p == 1 + NPL + 6 || p == 1 + NPL + 8 || p == 1 + NPL + 9) continue; a.ph_lo = p; a.ph_hi = p + 1; hipLaunchKernelGGL(mk_fwd, dim3(grid), dim3(NWAVES * 64), LDS_BYTES, stream, a); }
#endif
    const hipError_t le = hipPeekAtLastError();
    if (le != hipSuccess) fprintf(stderr, "kernel_launch: launch failed: %s\n", hipGetErrorName(le));
}
```

```cpp
#include <hip/hip_runtime.h>
#include <cstdio>
#include <cstdint>

#ifndef MK_N_LAUNCHES
#define MK_N_LAUNCHES 1
#endif

#ifndef DUP_MASK
#define DUP_MASK 0u
#endif

constexpr int D = 2048, DFF = 5632, NPR = 4 * 8192, NSR = 8 * 64, M = NPR + NSR;
constexpr int NSTREAM = 12, MODS = 9 * D, MODL = NSTREAM * MODS;
constexpr int AW = 1024;
constexpr float EPS = 1e-6f;

constexpr size_t MiB = 1u << 20;
constexpr size_t WS_CTL = 0, CTL_ZERO_BYTES = 64 * 1024;
constexpr size_t WS_VSTAT = 64 * 1024;
constexpr size_t WS_MOD = 1 * MiB;
constexpr size_t WS_SS = 3 * MiB;
constexpr size_t WS_SB = 4 * MiB + 512 * 1024;
constexpr size_t WS_WM = 4 * MiB;
constexpr size_t WS_WGU = 8 * MiB;
constexpr size_t WS_WD = 184 * MiB;
constexpr size_t WS_WIN = 272 * MiB;
constexpr size_t WS_WOUT = 288 * MiB;
constexpr size_t WS_WC = 296 * MiB;
constexpr size_t WS_HN = 300 * MiB;
constexpr size_t WS_ACT = 432 * MiB;
constexpr size_t WS_U = WS_ACT, WS_V = WS_ACT + 65 * MiB, WS_GLU = WS_ACT + 130 * MiB, WS_CAT = WS_ACT + 195 * MiB, WS_PC = WS_ACT;
constexpr size_t WS_SLAB = 790 * MiB;
constexpr size_t WS_MODP = 840 * MiB;
constexpr size_t WS_SSP = 870 * MiB;
constexpr size_t WS_VSP = 896 * MiB;
constexpr size_t WS_H = 904 * MiB;
constexpr size_t WS_END = 1036 * MiB;
static_assert(WS_H + (size_t)M * D * 2 <= WS_END, "h map");
static_assert(WS_MODP + (size_t)16 * 2 * MODL * 4 <= WS_SSP && WS_SSP + (size_t)6 * M * 32 * 4 <= WS_VSP && WS_VSP + (size_t)M * 32 * 4 <= WS_END, "partials map");
constexpr size_t WS_DUMMY = 1036 * MiB;
static_assert(WS_SLAB + (size_t)11 * NSR * D * 4 <= WS_END, "slab map");
static_assert(WS_VSTAT + (size_t)M * 8 <= WS_MOD && WS_MOD + (size_t)2 * MODL * 4 <= WS_SS && WS_SS + (size_t)6 * M * 4 <= 4 * MiB && WS_WM + 4 * 128 * 128 * 2 <= WS_SB && WS_SB + (size_t)5 * 12 * 11264 * 4 <= WS_WGU, "ctl map");
static_assert(WS_WGU + 4 * (size_t)11264 * 2048 * 2 <= WS_WD && WS_WD + 4 * (size_t)2048 * 5632 * 2 <= WS_WIN && WS_WIN + (size_t)4096 * 2048 * 2 <= WS_WOUT, "weights map");
static_assert(WS_HN + (size_t)M * D * 2 <= WS_ACT && WS_ACT + (size_t)M * DFF * 2 <= WS_END && WS_CAT + (size_t)M * D * 2 <= WS_END && (size_t)M * AW * 2 <= 65 * MiB, "act map");
constexpr int CW_TMO = 0, CW_BAR = 4096;

constexpr size_t O_Y = 0, O_NCP = (size_t)M * D, O_NCS = O_NCP + 4 * 30 * 1024, O_NPP = O_NCS + 8 * 30 * 1024, O_NPS = O_NPP + 4 * 15 * 2048, O_NAV = O_NPS + 8 * 15 * 2048, O_END = O_NAV + 8 * 64 * 1024;

constexpr int RING_BYTES = 131072, LDSCTL_OFF = RING_BYTES, MISC_OFF = LDSCTL_OFF + 320, EPI_OFF = RING_BYTES + 1024, LDS_BYTES = 147456;
static_assert(MISC_OFF + 128 <= EPI_OFF && EPI_OFF + 8 * 1024 <= LDS_BYTES, "LDS map");
constexpr int NWAVES = 8, NCU = 256;

#define GAS __attribute__((address_space(1)))
#define LAS __attribute__((address_space(3)))
typedef unsigned short bf16;
typedef unsigned v4u __attribute__((ext_vector_type(4)));
typedef unsigned v2u __attribute__((ext_vector_type(2)));
typedef float f32x4 __attribute__((ext_vector_type(4)));
typedef float f32x2 __attribute__((ext_vector_type(2)));
typedef short bf16x8 __attribute__((ext_vector_type(8)));
#define LDS_WAIT() asm volatile("s_waitcnt lgkmcnt(0)" ::: "memory")
#define VM_WAIT() asm volatile("s_waitcnt vmcnt(0)" ::: "memory")

__device__ __forceinline__ unsigned f2bf(float f) { unsigned u = __builtin_bit_cast(unsigned, f); return (u + 0x7fffu + ((u >> 16) & 1u)) >> 16; }
__device__ __forceinline__ unsigned pk2(float lo, float hi) { unsigned r; asm("v_cvt_pk_bf16_f32 %0, %1, %2" : "=v"(r) : "v"(lo), "v"(hi)); return r; }
__device__ __forceinline__ unsigned cvt_pk_bf16(float lo, float hi) { unsigned r; asm volatile("v_cvt_pk_bf16_f32 %0, %1, %2" : "=v"(r) : "v"(lo), "v"(hi)); return r; }
__device__ __forceinline__ float bflo(unsigned w) { return __builtin_bit_cast(float, w << 16); }
__device__ __forceinline__ float bfhi(unsigned w) { return __builtin_bit_cast(float, w & 0xffff0000u); }
__device__ __forceinline__ float sigmoidf_(float x) { return __builtin_amdgcn_rcpf(1.0f + __builtin_amdgcn_exp2f(-1.4426950409f * x)); }
__device__ __forceinline__ float siluf_(float x) { return x * sigmoidf_(x); }
__device__ __forceinline__ float gelu_tanh(float x) { return x * __builtin_amdgcn_rcpf(1.0f + __builtin_amdgcn_exp2f(-2.302208198f * x * (1.0f + 0.044715f * x * x))); }
template <int CTRL, int RMASK> __device__ __forceinline__ float dpp_add(float v) { return v + __builtin_bit_cast(float, __builtin_amdgcn_update_dpp(0, __builtin_bit_cast(int, v), CTRL, RMASK, 0xf, true)); }
__device__ __forceinline__ float wave_sum(float v) {
    v = dpp_add<0xB1, 0xf>(v);
    v = dpp_add<0x4E, 0xf>(v);
    v = dpp_add<0x141, 0xf>(v);
    v = dpp_add<0x140, 0xf>(v);
    v = dpp_add<0x142, 0xa>(v);
    v = dpp_add<0x143, 0xc>(v);
    return __builtin_bit_cast(float, __builtin_amdgcn_readlane(__builtin_bit_cast(int, v), 63));
}
__device__ __forceinline__ int stream_of_row(int r) { return r < NPR ? (r >> 13) : 4 + ((r - NPR) >> 6); }

namespace pg8 {
typedef unsigned short bf16_t;
constexpr int BM = 256, BK = 64, HALF = 128, HTB = HALF * BK * 2, STAGE_BYTES = 8 * HTB, NXCD = 8, WGM = 8;
__host__ __device__ __forceinline__ int lds_byte(int r, int c) { const int st = (r >> 4) * 2 + (c >> 5), rr = r & 15, cc = c & 31, ob = rr * 64 + cc * 2; return st * 1024 + (ob ^ (((ob >> 9) & 1) << 5)); }
__host__ __device__ __forceinline__ void stage_rc(int b, int& R, int& C) { const int st = b / 1024, sb = b % 1024, swz = sb ^ (((sb >> 9) & 1) << 5); R = (st >> 1) * 16 + swz / 64; C = (st & 1) * 32 + (swz % 64) / 2; }
__host__ __device__ __forceinline__ int perm32(int rho) { const int n = rho >> 4, i = rho & 15; return 8 * (i >> 2) + 4 * n + (i & 3); }

struct Unit { int pm, pn, kt0, ktn, slab; };
struct Gemm { const bf16_t* A; const bf16_t* Bt; int M, N, K, lda, tpg; };

struct StaticOrder {
    int nMp, nMt, nN, nwgP, nTail, G, c, ntk, ksplit, ktper, wgm;
    __host__ __device__ void init(int Mp, int Mt, int N_, int K_, int G_, int c_, int ksplit_, int wgm_ = WGM) { wgm = wgm_; nMp = Mp / BM; nMt = Mt / BM; nN = N_ / BM; nwgP = nMp * nN; G = G_; c = c_; ntk = K_ / BK; ksplit = ksplit_; ktper = ntk / ksplit_; nTail = nMt * nN * ksplit_; }
    __host__ __device__ bool next(int i, Unit& u) const {
        const long L = (long)i * G + c;
        if (L < nwgP) {
            int wgid = (int)L; { const int q = nwgP / NXCD, r = nwgP % NXCD, xcd = wgid % NXCD, off = wgid / NXCD; wgid = (xcd < r ? xcd * (q + 1) : r * (q + 1) + (xcd - r) * q) + off; }
            const int nig = wgm * nN, gid = wgid / nig, fm = gid * wgm, gsz = (nMp - fm) < wgm ? (nMp - fm) : wgm;
            u.pm = fm + ((wgid % nig) % gsz); u.pn = (wgid % nig) / gsz; u.kt0 = 0; u.ktn = ntk; u.slab = -1; return true;
        }
        if (L >= (long)nwgP + G) return false;
        const int cc = (int)(L - nwgP);
        const long j = (G % NXCD == 0) ? (long)(cc % NXCD) * (G / NXCD) + cc / NXCD : (long)cc; if (j >= nTail) return false;
        const int kc = (int)j % ksplit, t = (int)j / ksplit;
        u.pm = nMp + t % nMt; u.pn = t / nMt; u.kt0 = kc * ktper;
        u.ktn = ktper; u.slab = ksplit > 1 ? kc : -1; return true;
    }
};


struct EpiSwiGLU {
    static constexpr bool PERM = true; static constexpr int NEPI = 4, NVM = 8;
    bf16_t* O; int ldc; const float* ss; const float* sb;
    __device__ __forceinline__ bool fused() const { return ss != nullptr; }
    __device__ __forceinline__ void stage(const Unit& u, LAS unsigned char* area, int wr, int wc, int lane) const {
        const int rb0 = u.pm * BM + wr * 64, rb1 = rb0 + HALF, wrow = u.pn * BM + wc * 32 + (lane & 31) + (lane >> 5) * HALF;
        __builtin_amdgcn_global_load_lds((const unsigned*)(ss + rb0 + lane), (LAS unsigned*)(area), 4, 0, 0);
        __builtin_amdgcn_global_load_lds((const unsigned*)(ss + rb1 + lane), (LAS unsigned*)(area + 256), 4, 0, 0);
        __builtin_amdgcn_global_load_lds((const unsigned*)(sb + (size_t)stream_of_row(rb0) * 11264 + wrow), (LAS unsigned*)(area + 512), 4, 0, 0);
        __builtin_amdgcn_global_load_lds((const unsigned*)(sb + (size_t)stream_of_row(rb1) * 11264 + wrow), (LAS unsigned*)(area + 768), 4, 0, 0);
    }
    __device__ __forceinline__ void operator()(const f32x4 (&acc)[2][2][4][2], const Unit& u, int wr, int wc, int fr, int fq, const LAS unsigned char* area) const {
        const int row0 = u.pm * BM + wr * 64 + fr, col0 = u.pn * HALF + wc * 32 + 8 * fq;
#pragma unroll
        for (int ai = 0; ai < 2; ++ai) {
            constexpr float KG = -1.4426950409f, KU = -0.6931471806f;
            f32x4 sg0 = (f32x4){0.f, 0.f, 0.f, 0.f}, sg1 = sg0, su0 = sg0, su1 = sg0;
            if (ss) { const LAS float* sp = (const LAS float*)(area + 512 + ai * 256) + 8 * fq; sg0 = *(const LAS f32x4*)sp * KG; sg1 = *(const LAS f32x4*)(sp + 4) * KG; su0 = *(const LAS f32x4*)(sp + 32) * KU; su1 = *(const LAS f32x4*)(sp + 36) * KU; }
#pragma unroll
            for (int m = 0; m < 4; ++m) {
                const int r = row0 + ai * HALF + m * 16;
                const float rstd = ss ? __builtin_amdgcn_rsqf(((const LAS float*)(area + ai * 256))[m * 16 + fr] * (1.0f / D) + EPS) : 1.0f;
                bf16_t* rowp = O + (size_t)r * ldc + col0;
                const float rg = rstd * KG, ru = rstd * KU;
                const f32x4 g0 = acc[ai][0][m][0] * rg + sg0, g1 = acc[ai][0][m][1] * rg + sg1, u0 = acc[ai][1][m][0] * ru + su0, u1 = acc[ai][1][m][1] * ru + su1;
                const f32x4 t0 = g0, t1 = g1;
                const f32x4 e0 = (f32x4){__builtin_amdgcn_exp2f(t0[0]), __builtin_amdgcn_exp2f(t0[1]), __builtin_amdgcn_exp2f(t0[2]), __builtin_amdgcn_exp2f(t0[3])} + 1.0f;
                const f32x4 e1 = (f32x4){__builtin_amdgcn_exp2f(t1[0]), __builtin_amdgcn_exp2f(t1[1]), __builtin_amdgcn_exp2f(t1[2]), __builtin_amdgcn_exp2f(t1[3])} + 1.0f;
                const f32x4 o0 = (g0 * u0) * (f32x4){__builtin_amdgcn_rcpf(e0[0]), __builtin_amdgcn_rcpf(e0[1]), __builtin_amdgcn_rcpf(e0[2]), __builtin_amdgcn_rcpf(e0[3])};
                const f32x4 o1 = (g1 * u1) * (f32x4){__builtin_amdgcn_rcpf(e1[0]), __builtin_amdgcn_rcpf(e1[1]), __builtin_amdgcn_rcpf(e1[2]), __builtin_amdgcn_rcpf(e1[3])};
                v4u w;
                w.x = cvt_pk_bf16(o0[0], o0[1]); w.y = cvt_pk_bf16(o0[2], o0[3]); w.z = cvt_pk_bf16(o1[0], o1[1]); w.w = cvt_pk_bf16(o1[2], o1[3]);
                __builtin_nontemporal_store(w, (v4u*)rowp);
            }
        }
    }
};

struct EpiNull {
    static constexpr bool PERM = true; static constexpr int NEPI = 0, NVM = 0;
    __device__ __forceinline__ bool fused() const { return false; }
    __device__ __forceinline__ void stage(const Unit&, LAS unsigned char*, int, int, int) const {}
    __device__ __forceinline__ void operator()(const f32x4 (&acc)[2][2][4][2], const Unit&, int, int, int, int, const LAS unsigned char*) const {
#pragma unroll
        for (int a = 0; a < 2; ++a)
#pragma unroll
            for (int b = 0; b < 2; ++b)
#pragma unroll
                for (int m = 0; m < 4; ++m)
#pragma unroll
                    for (int n = 0; n < 2; ++n) asm volatile("" :: "v"(acc[a][b][m][n]));
    }
};

template <bool HB> struct EpiRes {
    static constexpr bool PERM = true;
    const void* base_p; const void* base_s; bf16_t* out; const float* gate; const float* bias; const float* cs; float* slab; bf16_t* an; const float* ng_n; const float* sc_n; float* ss; float alpha; int base_f32;
    static constexpr int NEPI = 0, NVM = 0;
    __device__ __forceinline__ bool fused() const { return false; }
    __device__ __forceinline__ void stage(const Unit&, LAS unsigned char*, int, int, int) const {}
    __device__ __forceinline__ void operator()(const f32x4 (&acc)[2][2][4][2], const Unit& u, int wr, int wc, int fr, int fq, const LAS unsigned char*) const {
        const int col0 = u.pn * BM + wc * 32 + 8 * fq;
#pragma unroll
        for (int ai = 0; ai < 2; ++ai) {
            const int rbase = u.pm * BM + ai * HALF + wr * 64;
            const int s = stream_of_row(rbase);
            float q[4] = {0.f, 0.f, 0.f, 0.f};
            v4u bw8[2][4];
            if (u.slab < 0 && !base_f32) {
                const bf16_t* bp = (const bf16_t*)((rbase < NPR) ? base_p : base_s) + ((rbase < NPR) ? (size_t)(rbase + fr) : (size_t)(rbase + fr - NPR)) * D + col0;
#pragma unroll
                for (int bj = 0; bj < 2; ++bj)
#pragma unroll
                    for (int m = 0; m < 4; ++m) bw8[bj][m] = *(const v4u*)(bp + (size_t)m * 16 * D + bj * HALF);
            } else {
#pragma unroll
                for (int bj = 0; bj < 2; ++bj)
#pragma unroll
                    for (int m = 0; m < 4; ++m) bw8[bj][m] = (v4u){0u, 0u, 0u, 0u}; }
#pragma unroll
            for (int bj = 0; bj < 2; ++bj) {
                const int c = col0 + bj * HALF;
                f32x4 gv[2], bv[2], gn[2];
#pragma unroll
                for (int n = 0; n < 2; ++n) { gv[n] = *(const f32x4*)(gate + (size_t)s * MODS + c + 4 * n) * alpha; bv[n] = (f32x4){0.f, 0.f, 0.f, 0.f}; gn[n] = bv[n];
                    if (HB) { gv[n] = gv[n] * *(const f32x4*)(cs + c + 4 * n); bv[n] = *(const f32x4*)(bias + c + 4 * n); }
                    if (an) gn[n] = *(const f32x4*)(ng_n + c + 4 * n) * (*(const f32x4*)(sc_n + (size_t)s * MODS + c + 4 * n) + 1.0f); }
#pragma unroll
                for (int mh = 0; mh < 2; ++mh) {
                f32x4 bf4[2][2];
                if (u.slab < 0 && base_f32) {
                    const float* bp = (const float*)((rbase < NPR) ? base_p : base_s) + ((rbase < NPR) ? (size_t)(rbase + fr) : (size_t)(rbase + fr - NPR)) * D + c;
#pragma unroll
                    for (int mm = 0; mm < 2; ++mm) { bf4[mm][0] = *(const f32x4*)(bp + (size_t)(2 * mh + mm) * 16 * D); bf4[mm][1] = *(const f32x4*)(bp + (size_t)(2 * mh + mm) * 16 * D + 4); }
                } else {
#pragma unroll
                    for (int mm = 0; mm < 2; ++mm) { bf4[mm][0] = (f32x4){0.f, 0.f, 0.f, 0.f}; bf4[mm][1] = bf4[mm][0]; } }
#pragma unroll
                for (int mm = 0; mm < 2; ++mm) { const int m = 2 * mh + mm;
                    const int r = rbase + m * 16 + fr;
                    if (u.slab >= 0) {
                        float* sp = slab + ((size_t)u.slab * NSR + (size_t)(r - NPR)) * D + c;
                        *(f32x4*)sp = gv[0] * (acc[ai][bj][m][0] + bv[0]); *(f32x4*)(sp + 4) = gv[1] * (acc[ai][bj][m][1] + bv[1]);
                    } else {
                        const size_t boff = ((rbase < NPR) ? (size_t)r : (size_t)(r - NPR)) * D + c; const void* bb = (rbase < NPR) ? base_p : base_s;
                        f32x4 b0, b1;
                        if (base_f32) { b0 = bf4[mm][0]; b1 = bf4[mm][1]; }
                        else { const v4u bw = bw8[bj][m]; b0 = (f32x4){bflo(bw.x), bfhi(bw.x), bflo(bw.y), bfhi(bw.y)}; b1 = (f32x4){bflo(bw.z), bfhi(bw.z), bflo(bw.w), bfhi(bw.w)}; }
                        const f32x4 o0 = b0 + gv[0] * (acc[ai][bj][m][0] + bv[0]), o1 = b1 + gv[1] * (acc[ai][bj][m][1] + bv[1]);
                        { v4u ow; ow.x = cvt_pk_bf16(o0[0], o0[1]); ow.y = cvt_pk_bf16(o0[2], o0[3]); ow.z = cvt_pk_bf16(o1[0], o1[1]); ow.w = cvt_pk_bf16(o1[2], o1[3]); *(v4u*)(out + (size_t)r * D + c) = ow; }
                        if (ss) q[m] += ((o0[0] * o0[0] + o0[1] * o0[1]) + (o0[2] * o0[2] + o0[3] * o0[3])) + ((o1[0] * o1[0] + o1[1] * o1[1]) + (o1[2] * o1[2] + o1[3] * o1[3]));
                        if (an) { const f32x4 t0 = o0 * gn[0], t1 = o1 * gn[1]; v4u w; w.x = cvt_pk_bf16(t0[0], t0[1]); w.y = cvt_pk_bf16(t0[2], t0[3]); w.z = cvt_pk_bf16(t1[0], t1[1]); w.w = cvt_pk_bf16(t1[2], t1[3]);
                            *(v4u*)(an + (size_t)r * D + c) = w; }
                    }
                }
                }
            }
            if (ss && u.slab < 0) {
#pragma unroll
                for (int m = 0; m < 4; ++m) { float t = q[m]; t += __shfl_xor(t, 16); t += __shfl_xor(t, 32); if (fq == 0) ss[(size_t)(rbase + m * 16 + fr) * 32 + u.pn * 4 + wc] = t; } }
        }
    }
};

struct EpiInProj {
    static constexpr bool PERM = true;
    bf16_t *U, *V, *GLU; float* vstat; float* ncp; float* ncs; const float* ss; const float* sb;
    static constexpr int NEPI = 4, NVM = 8;
    __device__ __forceinline__ bool fused() const { return true; }
    __device__ __forceinline__ void stage(const Unit& u, LAS unsigned char* area, int wr, int wc, int lane) const {
        const int rb0 = u.pm * BM + wr * 64, rb1 = rb0 + HALF, wrow = u.pn * BM + wc * 32 + (lane & 31) + (lane >> 5) * HALF;
        __builtin_amdgcn_global_load_lds((const unsigned*)(ss + rb0 + lane), (LAS unsigned*)(area), 4, 0, 0);
        __builtin_amdgcn_global_load_lds((const unsigned*)(ss + rb1 + lane), (LAS unsigned*)(area + 256), 4, 0, 0);
        __builtin_amdgcn_global_load_lds((const unsigned*)(sb + (size_t)stream_of_row(rb0) * 4096 + wrow), (LAS unsigned*)(area + 512), 4, 0, 0);
        __builtin_amdgcn_global_load_lds((const unsigned*)(sb + (size_t)stream_of_row(rb1) * 4096 + wrow), (LAS unsigned*)(area + 768), 4, 0, 0);
    }
    __device__ __forceinline__ void operator()(const f32x4 (&acc)[2][2][4][2], const Unit& u, int wr, int wc, int fr, int fq, const LAS unsigned char* area) const {
        const int row0 = u.pm * BM + wr * 64 + fr;
        if (u.pn < 8) {
            const bool isv = u.pn >= 4; bf16_t* O = isv ? V : U; const int col0 = (u.pn & 3) * BM + wc * 32 + 8 * fq;
#pragma unroll
            for (int ai = 0; ai < 2; ++ai) {
                const LAS float* sp = (const LAS float*)(area + 512 + ai * 256) + 8 * fq;
                f32x4 sv[2][2];
#pragma unroll
                for (int bj = 0; bj < 2; ++bj) { sv[bj][0] = *(const LAS f32x4*)(sp + bj * 32); sv[bj][1] = *(const LAS f32x4*)(sp + bj * 32 + 4); }
#pragma unroll
                for (int m = 0; m < 4; ++m) { const int r = row0 + ai * HALF + m * 16; float s1 = 0.f, s2 = 0.f;
                    const float rstd = __builtin_amdgcn_rsqf(((const LAS float*)(area + ai * 256))[m * 16 + fr] * (1.0f / D) + EPS);
#pragma unroll
                    for (int bj = 0; bj < 2; ++bj) { f32x4 v0 = acc[ai][bj][m][0] * rstd + sv[bj][0], v1 = acc[ai][bj][m][1] * rstd + sv[bj][1];
#pragma unroll
                        for (int h2 = 0; h2 < 2; ++h2) { f32x4& x = h2 ? v1 : v0;
                            const f32x4 t = (x * -2.302208198f) * (x * x * 0.044715f + 1.0f);
                            const f32x4 d = (f32x4){__builtin_amdgcn_exp2f(t[0]), __builtin_amdgcn_exp2f(t[1]), __builtin_amdgcn_exp2f(t[2]), __builtin_amdgcn_exp2f(t[3])} + 1.0f;
                            x = x * (f32x4){__builtin_amdgcn_rcpf(d[0]), __builtin_amdgcn_rcpf(d[1]), __builtin_amdgcn_rcpf(d[2]), __builtin_amdgcn_rcpf(d[3])}; }
                        { const f32x4 a1 = v0 + v1, a2 = v0 * v0 + v1 * v1; s1 += (a1[0] + a1[1]) + (a1[2] + a1[3]); s2 += (a2[0] + a2[1]) + (a2[2] + a2[3]); }
                        v4u w; w.x = cvt_pk_bf16(v0[0], v0[1]); w.y = cvt_pk_bf16(v0[2], v0[3]); w.z = cvt_pk_bf16(v1[0], v1[1]); w.w = cvt_pk_bf16(v1[2], v1[3]);
                        *(v4u*)(O + (size_t)r * AW + col0 + bj * HALF) = w; }
                    if (isv) { s1 += __shfl_xor(s1, 16); s1 += __shfl_xor(s1, 32); s2 += __shfl_xor(s2, 16); s2 += __shfl_xor(s2, 32);
                        if (fq == 0) *(f32x2*)(vstat + ((size_t)r * 16 + (u.pn - 4) * 4 + wc) * 2) = (f32x2){s1, s2}; }
                }
            }
        } else {
            const int col0 = (u.pn - 8) * HALF + wc * 32 + 8 * fq;
#pragma unroll
            for (int ai = 0; ai < 2; ++ai) {
                const int rbase = u.pm * BM + ai * HALF + wr * 64;
                const bool tailp = (rbase < NPR) && ((rbase & 8191) == 8128), tails = rbase >= NPR;
                const LAS float* sp = (const LAS float*)(area + 512 + ai * 256) + 8 * fq;
                const f32x4 sa0 = *(const LAS f32x4*)sp, sa1 = *(const LAS f32x4*)(sp + 4), sg0 = *(const LAS f32x4*)(sp + 32), sg1 = *(const LAS f32x4*)(sp + 36);
#pragma unroll
                for (int m = 0; m < 4; ++m) { const int r = rbase + m * 16 + fr;
                    const float rstd = __builtin_amdgcn_rsqf(((const LAS float*)(area + ai * 256))[m * 16 + fr] * (1.0f / D) + EPS);
                    const f32x4 a0 = acc[ai][0][m][0] * rstd + sa0, a1 = acc[ai][0][m][1] * rstd + sa1, g0 = acc[ai][1][m][0] * rstd + sg0, g1 = acc[ai][1][m][1] * rstd + sg1;
                    f32x4 o0, o1;
#pragma unroll
                    for (int h2 = 0; h2 < 2; ++h2) { const f32x4 g = h2 ? g1 : g0, t = g * -1.4426950409f;
                        const f32x4 d = (f32x4){__builtin_amdgcn_exp2f(t[0]), __builtin_amdgcn_exp2f(t[1]), __builtin_amdgcn_exp2f(t[2]), __builtin_amdgcn_exp2f(t[3])} + 1.0f;
                        const f32x4 o = (h2 ? a1 : a0) * (f32x4){__builtin_amdgcn_rcpf(d[0]), __builtin_amdgcn_rcpf(d[1]), __builtin_amdgcn_rcpf(d[2]), __builtin_amdgcn_rcpf(d[3])};
                        if (h2) o1 = o; else o0 = o; }
                    v4u w; w.x = cvt_pk_bf16(o0[0], o0[1]); w.y = cvt_pk_bf16(o0[2], o0[3]); w.z = cvt_pk_bf16(o1[0], o1[1]); w.w = cvt_pk_bf16(o1[2], o1[3]);
                    *(v4u*)(GLU + (size_t)r * AW + col0) = w;
                    if (tailp) { const int t = r & 8191; if (t >= 8162) { float* dst = ncp + ((size_t)((r >> 13) * 30 + (t - 8162)) * 1024 + col0); *(f32x4*)dst = o0; *(f32x4*)(dst + 4) = o1; } }
                    if (tails) { const int rr = r - NPR, t = rr & 63; if (t >= 34) { float* dst = ncs + ((size_t)((rr >> 6) * 30 + (t - 34)) * 1024 + col0); *(f32x4*)dst = o0; *(f32x4*)(dst + 4) = o1; } }
                }
            }
        }
    }
};

template <int NR> __device__ __forceinline__ void wait_vm_sel(int sel) { asm volatile("v_cmp_ne_u32_e32 vcc, 0, %0\n\ts_nop 4\n\ts_cbranch_vccz 1f\n\ts_waitcnt vmcnt(%1)\n\ts_branch 2f\n1:\n\ts_waitcnt vmcnt(8)\n2:" :: "v"(sel), "n"(NR) : "memory", "vcc"); }
template <class Epi, bool ALIGN_EPI>
__device__ __forceinline__ void gemm_phase(LAS unsigned char* lds, const Gemm g, const StaticOrder& S, const Epi& E, unsigned stagger_ticks = 0u) {
    int tid_ = threadIdx.x; asm volatile("" : "+v"(tid_));
    const int tid = tid_, wid = __builtin_amdgcn_readfirstlane(tid >> 6), lane = tid & 63, wr = wid >> 2, wc = wid & 3, fr = lane & 15, fq = lane >> 4;
    const int K = g.K;
    unsigned voffA[2], voffB[2];
#pragma unroll
    for (int i = 0; i < 2; ++i) { int R, C; stage_rc(tid * 16 + i * 8192, R, C); const int Rb = Epi::PERM ? ((R & ~31) + perm32(R & 31)) : R;
        voffA[i] = (unsigned)(R * g.lda + C) * 2u; voffB[i] = (unsigned)(Rb * K + C) * 2u; }
    const size_t kstep = (size_t)(BK * 2);
    const size_t hA = (size_t)HALF * g.lda * 2, hB = (size_t)HALF * K * 2;
    const size_t tA = 2 * hA, tB = 2 * hB;
    const unsigned ldsw = (unsigned)wid * 1024u;
    const int aoff = lds_byte(wr * 64 + fr, fq * 8), boff = lds_byte(wc * 32 + fr, fq * 8);
#define PG8_SA(b, h) (((b) * 2 + (h)) * HTB)
#define PG8_SB(b, h) ((4 + (b) * 2 + (h)) * HTB)
#define PG8_STAGE(bufoff, gbase, voff) do { _Pragma("unroll") for (int _i = 0; _i < 2; ++_i) \
        __builtin_amdgcn_global_load_lds((const unsigned*)((const char*)(gbase) + (voff)[_i]), (LAS unsigned*)(lds + (bufoff) + ldsw + _i * 8192), 16, 0, 0); } while (0)
#define PG8_LDA(dst, b, h) do { _Pragma("unroll") for (int m = 0; m < 4; ++m) _Pragma("unroll") for (int k = 0; k < 2; ++k) dst[m][k] = *(const LAS bf16x8*)(lds + PG8_SA(b, h) + aoff + m * 2048 + k * 1024); } while (0)
#define PG8_LDB(dst, b, h) do { _Pragma("unroll") for (int n = 0; n < 2; ++n) _Pragma("unroll") for (int k = 0; k < 2; ++k) dst[n][k] = *(const LAS bf16x8*)(lds + PG8_SB(b, h) + boff + n * 2048 + k * 1024); } while (0)
#define PG8_MMA(ai, bj, At, Bt) do { __builtin_amdgcn_s_setprio(1); _Pragma("unroll") for (int m = 0; m < 4; ++m) _Pragma("unroll") for (int n = 0; n < 2; ++n) _Pragma("unroll") for (int k = 0; k < 2; ++k) \
        acc[ai][bj][m][n] = __builtin_amdgcn_mfma_f32_16x16x32_bf16(Bt[n][k], At[m][k], acc[ai][bj][m][n], 0, 0, 0); __builtin_amdgcn_s_setprio(0); } while (0)
#define PG8_WAIT_V(n) asm volatile("s_waitcnt vmcnt(" #n ")" ::: "memory")
#define PG8_WAIT_L(n) asm volatile("s_waitcnt lgkmcnt(" #n ")" ::: "memory")
#define PG8_BAR __builtin_amdgcn_s_barrier()
#define PG8_SCHED __builtin_amdgcn_sched_barrier(0)
#define PG8_APTR(u) ((const char*)g.A + (size_t)(u).pm * tA + (g.tpg ? (size_t)((u).pn / g.tpg) * (size_t)K * 2 : (size_t)0) + (size_t)(u).kt0 * kstep)
#define PG8_BPTR(u) ((const char*)g.Bt + (size_t)(u).pn * tB + (size_t)(u).kt0 * kstep)
    Unit cur, nxt; int ui = 0;
    if (!S.next(0, cur)) return;
    if (stagger_ticks) { const unsigned long long t0 = __builtin_amdgcn_s_memrealtime(); while (__builtin_amdgcn_s_memrealtime() - t0 < (unsigned long long)stagger_ticks) __builtin_amdgcn_s_sleep(16); }
    f32x4 acc[2][2][4][2];
#pragma unroll
    for (int a = 0; a < 2; ++a)
#pragma unroll
        for (int b = 0; b < 2; ++b)
#pragma unroll
            for (int m = 0; m < 4; ++m)
#pragma unroll
                for (int n = 0; n < 2; ++n) acc[a][b][m][n] = (f32x4){0.f, 0.f, 0.f, 0.f};
    bf16x8 At[4][2], B0[2][2], B1[2][2];
    const char* cA = PG8_APTR(cur); const char* cB = PG8_BPTR(cur);
    LAS unsigned char* area = lds + EPI_OFF + wid * 1024;
    const bool epi_dma = Epi::NEPI > 0 && E.fused();
    if (epi_dma) E.stage(cur, area, wr, wc, lane);
    PG8_STAGE(PG8_SB(0, 0), cB, voffB); PG8_STAGE(PG8_SB(0, 1), cB + hB, voffB); PG8_STAGE(PG8_SA(0, 0), cA, voffA); PG8_STAGE(PG8_SA(0, 1), cA + hA, voffA);
    if (wr == 1) PG8_BAR;
    PG8_WAIT_V(2); PG8_BAR;
    PG8_STAGE(PG8_SB(1, 0), cB + kstep, voffB); PG8_STAGE(PG8_SA(1, 0), cA + kstep, voffA); PG8_STAGE(PG8_SB(1, 1), cB + hB + kstep, voffB);
    PG8_WAIT_V(6); PG8_BAR;
    for (;;) {
        const bool has_next = S.next(ui + 1, nxt);
        const char* nA = has_next ? PG8_APTR(nxt) : cA; const char* nB = has_next ? PG8_BPTR(nxt) : cB;
        const int nt = cur.ktn;
        for (int t = 0; t < nt; t += 2) {
            const bool last = (t == nt - 2);
            const char* a1 = cA + (size_t)(t + 1) * kstep;
            const char* a2 = last ? nA : cA + (size_t)(t + 2) * kstep; const char* b2 = last ? nB : cB + (size_t)(t + 2) * kstep;
            const char* a3 = a2 + kstep; const char* b3 = b2 + kstep;
            const int first = (t == 0 && ui > 0 && epi_dma) ? 1 : 0;
            PG8_LDB(B0, 0, 0); PG8_LDB(B1, 0, 1); PG8_SCHED; PG8_LDA(At, 0, 0); PG8_STAGE(PG8_SA(1, 1), a1 + hA, voffA);
            wait_vm_sel<8 + Epi::NEPI + Epi::NVM>(first); PG8_WAIT_L(0); PG8_BAR; PG8_MMA(0, 0, At, B0); PG8_MMA(0, 1, At, B1); PG8_BAR; PG8_SCHED;
            PG8_LDA(At, 0, 1); PG8_STAGE(PG8_SB(0, 0), b2, voffB); PG8_STAGE(PG8_SB(0, 1), b2 + hB, voffB); PG8_STAGE(PG8_SA(0, 0), a2, voffA);
            wait_vm_sel<8 + Epi::NEPI + Epi::NVM>(first); PG8_WAIT_L(0); PG8_BAR; PG8_MMA(1, 0, At, B0); PG8_MMA(1, 1, At, B1); PG8_BAR; PG8_SCHED;
            PG8_LDB(B0, 1, 0); PG8_LDB(B1, 1, 1); PG8_SCHED; PG8_LDA(At, 1, 0); PG8_STAGE(PG8_SA(0, 1), a2 + hA, voffA);
            PG8_WAIT_V(8); PG8_WAIT_L(0); PG8_BAR; PG8_MMA(0, 0, At, B0); PG8_MMA(0, 1, At, B1); PG8_BAR; PG8_SCHED;
            PG8_LDA(At, 1, 1); PG8_STAGE(PG8_SB(1, 0), b3, voffB); PG8_STAGE(PG8_SB(1, 1), b3 + hB, voffB); PG8_STAGE(PG8_SA(1, 0), a3, voffA);
            PG8_WAIT_V(8); PG8_WAIT_L(0); PG8_BAR; PG8_MMA(1, 0, At, B0); PG8_MMA(1, 1, At, B1); PG8_BAR; PG8_SCHED;
        }
        if constexpr (ALIGN_EPI) { if (wr == 0) PG8_BAR; }
        E(acc, cur, wr, wc, fr, fq, area);
        if (!has_next) break;
        if (epi_dma) E.stage(nxt, area, wr, wc, lane);
#pragma unroll
        for (int a = 0; a < 2; ++a)
#pragma unroll
            for (int b = 0; b < 2; ++b)
#pragma unroll
                for (int m = 0; m < 4; ++m)
#pragma unroll
                    for (int n = 0; n < 2; ++n) acc[a][b][m][n] = (f32x4){0.f, 0.f, 0.f, 0.f};
        cur = nxt; cA = nA; cB = nB; ++ui;
        if constexpr (ALIGN_EPI) { if (wr == 1) PG8_BAR; }
    }
    PG8_WAIT_V(0);
    if constexpr (!ALIGN_EPI) { if (wr == 0) PG8_BAR; }
    PG8_BAR;
#undef PG8_SA
#undef PG8_SB
#undef PG8_STAGE
#undef PG8_LDA
#undef PG8_LDB
#undef PG8_MMA
#undef PG8_WAIT_V
#undef PG8_WAIT_L
#undef PG8_BAR
#undef PG8_SCHED
#undef PG8_APTR
#undef PG8_BPTR
}
}

#define XB_TMO      128
#define XB_XCNT(j)  (256  + 64 * (j))
#define XB_XSUB(j)  (1280 + 64 * (j))
#define XB_XGEN(j)  (2304 + 64 * (j))
#define XB_TOP      3328
#define XB_TOPGEN   3392
#define XCD_BAR_WORDS 3456
#define XB_SPIN_CAP (1u << 18)
__device__ __forceinline__ unsigned xb_ld(unsigned* p)              { return __hip_atomic_load(p, __ATOMIC_RELAXED, __HIP_MEMORY_SCOPE_AGENT); }
__device__ __forceinline__ unsigned xb_add(unsigned* p, unsigned v) { return __hip_atomic_fetch_add(p, v, __ATOMIC_RELAXED, __HIP_MEMORY_SCOPE_AGENT); }
__device__ __forceinline__ unsigned xb_xcc_id() { return (unsigned)__builtin_amdgcn_s_getreg((3 << 11) | 20) & 0xFu; }
#define XB_SPIN(cond, bar) do { unsigned _sp = 0; while (cond) { __builtin_amdgcn_s_sleep(1); \
    if ((++_sp & 255u) == 0u) { if (xb_ld(&(bar)[XB_TMO])) break; if (_sp > XB_SPIN_CAP) { atomicAdd(&(bar)[XB_TMO], 1u); break; } } } } while (0)
struct XcdBarrier { unsigned* bar; unsigned x; volatile LAS unsigned* st; };
__device__ __forceinline__ XcdBarrier xcd_barrier_post(unsigned* bar, volatile LAS unsigned* st) {
    XcdBarrier b; b.bar = bar; b.x = xb_xcc_id(); b.st = st;
    if (threadIdx.x == 0) (void)xb_add(&bar[XB_XCNT(b.x)], 1u);
    return b;
}
__device__ __forceinline__ void xcd_barrier_complete(unsigned* bar, unsigned x, unsigned& nloc, unsigned& nx) {
    const unsigned G = gridDim.x * gridDim.y * gridDim.z;
    unsigned sum, cnt, mine, sp = 0u;
    for (;;) {
        sum = 0u; cnt = 0u; mine = 0u;
#pragma unroll
        for (unsigned j = 0; j < 16; ++j) { const unsigned c = xb_ld(&bar[XB_XCNT(j)]); sum += c; cnt += (c > 0u) ? 1u : 0u; mine = (j == x) ? c : mine; }
        if (sum == G) break;
        __builtin_amdgcn_s_sleep(1);
        if ((++sp & 255u) == 0u) { if (xb_ld(&bar[XB_TMO])) break; if (sp > XB_SPIN_CAP) { atomicAdd(&bar[XB_TMO], 1u); break; } }
    }
    nloc = mine > 0u ? mine : 1u; nx = cnt > 0u ? cnt : 1u;
}
__device__ __forceinline__ void xcd_barrier(const XcdBarrier& b) {
    asm volatile("s_waitcnt vmcnt(0)" ::: "memory");
    __syncthreads();
    if (threadIdx.x == 0) {
        unsigned* bar = b.bar;
        __builtin_amdgcn_s_waitcnt(0);
        unsigned nloc = b.st[0], nx = b.st[1];
        if (nloc == 0u) { xcd_barrier_complete(bar, b.x, nloc, nx); b.st[0] = nloc; b.st[1] = nx; }
        const unsigned old = xb_add(&bar[XB_XSUB(b.x)], 1u);
        const unsigned gen = old / nloc;
        if (old + 1u == (gen + 1u) * nloc) {
            __builtin_amdgcn_fence(__ATOMIC_RELEASE, "agent");
            asm volatile("s_waitcnt vmcnt(0)" ::: "memory");
            const unsigned og = xb_add(&bar[XB_TOP], 1u);
            const unsigned tg = og / nx;
            if (og + 1u == (tg + 1u) * nx) xb_add(&bar[XB_TOPGEN], 1u);
            else XB_SPIN(xb_ld(&bar[XB_TOPGEN]) == tg, bar);
            __builtin_amdgcn_fence(__ATOMIC_ACQUIRE, "agent");
            xb_add(&bar[XB_XGEN(b.x)], 1u);
            asm volatile("s_waitcnt vmcnt(0)" ::: "memory");
        } else {
            XB_SPIN(xb_ld(&bar[XB_XGEN(b.x)]) == gen, bar);
            __builtin_amdgcn_fence(__ATOMIC_ACQUIRE, "agent");
            asm volatile("s_waitcnt vmcnt(0)" ::: "memory");
        }
    }
    __syncthreads();
}

struct Args { const float* in[25]; float* out; unsigned char* ws; int ph_lo, ph_hi; };
typedef const __attribute__((address_space(4))) Args* CArgsP;
enum { I_XP = 0, I_XS, I_CP, I_CS, I_SCONV, I_SPOOL, I_ADAW, I_ADAB, I_NORMG, I_FNORMG, I_WG, I_WU, I_WD, I_WIN, I_AVG, I_AVB, I_AWS, I_ABS, I_BDW, I_BLNG, I_BLNB, I_WOUT, I_CW, I_CB, I_CSC };

__device__ __forceinline__ void p0_transpose_item(const float* W, int K, int N, bf16* WT, int dest0, LAS float* scr, int k0, int n0, int lane) {
    float v[32];
#pragma unroll
    for (int i = 0; i < 32; ++i) v[i] = __builtin_nontemporal_load(W + (size_t)(k0 + 2 * i + (lane >> 5)) * N + n0 + (lane & 31));
#pragma unroll
    for (int i = 0; i < 32; ++i) scr[(2 * i + (lane >> 5)) * 33 + (lane & 31)] = v[i];
    LDS_WAIT(); asm volatile("" ::: "memory");
    const int c = lane & 7;
#pragma unroll
    for (int j = 0; j < 4; ++j) { const int n = (lane >> 3) + 8 * j; const LAS float* s = scr + (8 * c) * 33 + n;
        v4u o; o.x = pk2(s[0 * 33], s[1 * 33]); o.y = pk2(s[2 * 33], s[3 * 33]); o.z = pk2(s[4 * 33], s[5 * 33]); o.w = pk2(s[6 * 33], s[7 * 33]);
        __builtin_nontemporal_store(o, (v4u*)(WT + (size_t)(dest0 + n) * K + k0 + 8 * c)); }
    LDS_WAIT(); asm volatile("" ::: "memory");
}
__device__ __forceinline__ void p0_ada_item(CArgsP a, float* mod, LAS float* scr, int idx, int lane) {
    const int ks = idx & 15, cb = (idx >> 4) % 72, l = idx / (16 * 72), k0 = ks * 128, n = cb * 256 + 4 * lane;
#pragma unroll
    for (int s = 0; s < NSTREAM; ++s)
#pragma unroll
        for (int h = 0; h < 2; ++h) { const int k = lane + 64 * h; const float cv = (s < 4) ? a->in[I_CP][s * D + k0 + k] : a->in[I_CS][(s - 4) * D + k0 + k]; scr[s * 128 + k] = siluf_(cv); }
    LDS_WAIT(); asm volatile("" ::: "memory");
    f32x4 acc[NSTREAM];
#pragma unroll
    for (int s = 0; s < NSTREAM; ++s) acc[s] = (f32x4){0.f, 0.f, 0.f, 0.f};
    const float* Wp = a->in[I_ADAW] + ((size_t)l * D + k0) * MODS + n;
    f32x4 wb[8], wn[8];
#pragma unroll
    for (int i = 0; i < 8; ++i) { wb[i] = *(const f32x4*)(Wp + (size_t)i * MODS); wn[i] = wb[i]; }
#pragma unroll 1
    for (int kb = 0; kb < 128; kb += 8) {
        if (kb + 8 < 128) {
#pragma unroll
            for (int i = 0; i < 8; ++i) wn[i] = *(const f32x4*)(Wp + (size_t)(kb + 8 + i) * MODS); }
#pragma unroll
        for (int i = 0; i < 8; ++i)
#pragma unroll
            for (int s = 0; s < NSTREAM; ++s) acc[s] += wb[i] * scr[s * 128 + kb + i];
#pragma unroll
        for (int i = 0; i < 8; ++i) wb[i] = wn[i];
    }
    if (ks == 0) { const f32x4 b = *(const f32x4*)(a->in[I_ADAB] + (size_t)l * MODS + n);
#pragma unroll
        for (int s = 0; s < NSTREAM; ++s) acc[s] += b; }
#pragma unroll
    for (int s = 0; s < NSTREAM; ++s) *(f32x4*)(mod + (size_t)ks * (2 * MODL) + (size_t)l * MODL + (size_t)s * MODS + n) = acc[s];
    LDS_WAIT(); asm volatile("" ::: "memory");
}
constexpr int P0_ADA = 2 * 72 * 16, P0_GU = 5632, P0_WD = 5632, P0_WIN = 4096, P0_WOUT = 2048, P0_WC = 128, P0_WM = 16;
constexpr int P0_TR = 2 * P0_GU + P0_WD + P0_WIN + P0_WOUT + 4 * P0_WC, P0_TOTAL = P0_ADA + P0_TR + P0_WM;
__device__ __forceinline__ void conv_gu_item(CArgsP a, unsigned char* ws, LAS float* scr, int f, int r, int lane) {
    const int up = r >= P0_GU, i2 = up ? r - P0_GU : r, kb = i2 / 176, nb = i2 % 176, n0 = 32 * nb;
    p0_transpose_item(a->in[up ? I_WU : I_WG] + (size_t)f * D * DFF, D, DFF, (bf16*)(ws + WS_WGU) + (size_t)f * 11264 * 2048, 256 * (n0 >> 7) + (n0 & 127) + (up ? 128 : 0), scr, 64 * kb, n0, lane);
}
__device__ __forceinline__ void conv_wd_item(CArgsP a, unsigned char* ws, LAS float* scr, int f, int r, int lane) {
    const int kb = r / 64, nb = r % 64;
    p0_transpose_item(a->in[I_WD] + (size_t)f * DFF * D, DFF, D, (bf16*)(ws + WS_WD) + (size_t)f * 2048 * 5632, 32 * nb, scr, 64 * kb, 32 * nb, lane);
}
__device__ __forceinline__ void conv_window(CArgsP a, LAS unsigned char* lds, int fgu, int fwd0, int fwd1, int rank, int nrank, int wave, int lane) {
    __syncthreads();
    LAS float* scr = (LAS float*)(lds + wave * 16384); unsigned char* ws = a->ws;
    const int ngu = fgu >= 0 ? 2 * P0_GU : 0, n1 = fwd0 >= 0 ? P0_WD : 0, n2 = fwd1 >= 0 ? P0_WD : 0;
#pragma unroll 1
    for (int it = rank * NWAVES + wave; it < ngu + n1 + n2; it += nrank * NWAVES) {
        if (it < ngu) conv_gu_item(a, ws, scr, fgu, it, lane);
        else if (it < ngu + n1) conv_wd_item(a, ws, scr, fwd0, it - ngu, lane);
        else conv_wd_item(a, ws, scr, fwd1, it - ngu - n1, lane);
    }
}
__device__ __forceinline__ void p0_prologue(CArgsP a, LAS unsigned char* lds, int gw, int NGW, int wave, int lane) {
    LAS float* scr = (LAS float*)(lds + wave * 16384);
    unsigned char* ws = a->ws;
    const int gwp = wave * (NGW / NWAVES) + gw / NWAVES, heavy = P0_ADA - NGW;
    p0_ada_item(a, (float*)(ws + WS_MODP), scr, gwp, lane);
    if (gwp < heavy) { p0_ada_item(a, (float*)(ws + WS_MODP), scr, NGW + gwp, lane); return; }
    for (int r0 = gwp - heavy; r0 < P0_TR + P0_WM; r0 += NGW - heavy) {
        int r = r0;
        if (r < 2 * P0_GU) { conv_gu_item(a, ws, scr, 0, r, lane); continue; }
        r -= 2 * P0_GU;
        if (r < P0_WD) { conv_wd_item(a, ws, scr, 0, r, lane); continue; }
        r -= P0_WD;
        if (r < P0_WIN) { const int kb = r / 128, nb = r % 128, n0 = 32 * nb; int d0;
            if (n0 < 2048) d0 = n0; else if (n0 < 3072) { const int j = n0 - 2048; d0 = 2048 + 256 * (j >> 7) + (j & 127); } else { const int j = n0 - 3072; d0 = 2048 + 256 * (j >> 7) + 128 + (j & 127); }
            p0_transpose_item(a->in[I_WIN], D, 4096, (bf16*)(ws + WS_WIN), d0, scr, 64 * kb, n0, lane); continue; }
        r -= P0_WIN;
        if (r < P0_WOUT) { const int kb = r / 64, nb = r % 64; p0_transpose_item(a->in[I_WOUT], D, D, (bf16*)(ws + WS_WOUT), 32 * nb, scr, 64 * kb, 32 * nb, lane); continue; }
        r -= P0_WOUT;
        if (r < 4 * P0_WC) { const int g = r / P0_WC, i2 = r % P0_WC, kb = i2 / 16, nb = i2 % 16;
            p0_transpose_item(a->in[I_CW] + (size_t)g * 512 * 512, 512, 512, (bf16*)(ws + WS_WC), g * 512 + 32 * nb, scr, 64 * kb, 32 * nb, lane); continue; }
        r -= 4 * P0_WC;
        { bf16* wm = (bf16*)(ws + WS_WM);
#pragma unroll 4
          for (int i = 0; i < 64; ++i) { const int idx = r * 4096 + i * 64 + lane, ii = (idx >> 7) & 127, jj = idx & 127; const float v = a->in[I_AWS][idx]; wm[idx] = (bf16)(((jj >> 6) <= (ii >> 6)) ? f2bf(v) : 0u); } }
    }
}

__device__ __forceinline__ void thin_norm(const float* hp, const float* hs, const float* ng, const float* shift, const float* scale, bf16* HN, int gw, int NGW, int lane) {
    const int r0 = (int)(((long)gw * M) / NGW), r1 = (int)(((long)(gw + 1) * M) / NGW);
    int cur_s = -1; f32x4 gs[8], sh[8], v[8], vn[8];
#pragma unroll
    for (int j = 0; j < 8; ++j) { gs[j] = (f32x4){0.f, 0.f, 0.f, 0.f}; sh[j] = gs[j]; v[j] = gs[j]; vn[j] = gs[j]; }
    if (r0 < r1) { const float* xr = (r0 < NPR) ? hp + (size_t)r0 * D : hs + (size_t)(r0 - NPR) * D;
#pragma unroll
        for (int j = 0; j < 8; ++j) v[j] = *(const f32x4*)(xr + 4 * lane + 256 * j); }
    for (int r = r0; r < r1; ++r) {
        if (r + 1 < r1) { const int rn = r + 1; const float* xr = (rn < NPR) ? hp + (size_t)rn * D : hs + (size_t)(rn - NPR) * D;
#pragma unroll
            for (int j = 0; j < 8; ++j) vn[j] = *(const f32x4*)(xr + 4 * lane + 256 * j); }
        const int s = stream_of_row(r);
        if (s != cur_s) { cur_s = s;
#pragma unroll
            for (int j = 0; j < 8; ++j) { const int c = 4 * lane + 256 * j; gs[j] = *(const f32x4*)(ng + c) * (*(const f32x4*)(scale + (size_t)s * MODS + c) + 1.0f); sh[j] = *(const f32x4*)(shift + (size_t)s * MODS + c); } }
        float ss = 0.f;
#pragma unroll
        for (int j = 0; j < 8; ++j) ss += (v[j].x * v[j].x + v[j].y * v[j].y) + (v[j].z * v[j].z + v[j].w * v[j].w);
        const float rstd = rsqrtf(wave_sum(ss) * (1.0f / D) + EPS);
        bf16* orow = HN + (size_t)r * D;
#pragma unroll
        for (int j = 0; j < 8; ++j) { const f32x4 o = v[j] * rstd * gs[j] + sh[j]; v2u w; w.x = pk2(o.x, o.y); w.y = pk2(o.z, o.w); *(v2u*)(orow + 4 * lane + 256 * j) = w; }
#pragma unroll
        for (int j = 0; j < 8; ++j) v[j] = vn[j];
    }
}
__device__ __forceinline__ void final_norm(const bf16* h, float* yo, const float* ng, int r0, int r1, int lane) {
    f32x4 gs[8]; v2u w[8], wn[8];
#pragma unroll
    for (int j = 0; j < 8; ++j) { gs[j] = *(const f32x4*)(ng + 4 * lane + 256 * j); w[j] = (v2u){0u, 0u}; wn[j] = w[j]; }
    if (r0 < r1) {
#pragma unroll
        for (int j = 0; j < 8; ++j) w[j] = *(const v2u*)(h + (size_t)r0 * D + 4 * lane + 256 * j); }
    for (int r = r0; r < r1; ++r) {
        if (r + 1 < r1) {
#pragma unroll
            for (int j = 0; j < 8; ++j) wn[j] = *(const v2u*)(h + (size_t)(r + 1) * D + 4 * lane + 256 * j); }
        f32x4 v[8]; float ss = 0.f;
#pragma unroll
        for (int j = 0; j < 8; ++j) { v[j] = (f32x4){bflo(w[j].x), bfhi(w[j].x), bflo(w[j].y), bfhi(w[j].y)}; ss += (v[j].x * v[j].x + v[j].y * v[j].y) + (v[j].z * v[j].z + v[j].w * v[j].w); }
        const float rstd = rsqrtf(wave_sum(ss) * (1.0f / D) + EPS);
#pragma unroll
        for (int j = 0; j < 8; ++j) *(f32x4*)(yo + (size_t)r * D + 4 * lane + 256 * j) = v[j] * rstd * gs[j];
#pragma unroll
        for (int j = 0; j < 8; ++j) w[j] = wn[j];
    }
}

constexpr int VNT_STRIDE_DW = 68;
constexpr int GATE_ST_OFF = 256 * VNT_STRIDE_DW * 4, GATE_WM_OFF = GATE_ST_OFF + 1024, GATE_WM_STRIDE = 272;
__device__ __forceinline__ void gate_stage_wm(CArgsP a, LAS unsigned char* lds, int g, int tid) {
    const bf16* wm = (const bf16*)(a->ws + WS_WM) + (size_t)g * 16384;
    for (int i = tid; i < 128 * 16; i += NWAVES * 64) { const int row = i >> 4, ch16 = i & 15; *(LAS v4u*)(lds + GATE_WM_OFF + row * GATE_WM_STRIDE + ch16 * 16) = *(const v4u*)(wm + row * 128 + ch16 * 8); }
}
__device__ __forceinline__ void mix_gate_unit(CArgsP a, LAS unsigned char* lds, int ch, int g, int tid, int wave, int lane) {
    asm volatile("" : "+v"(tid), "+v"(lane));
    unsigned char* ws = a->ws;
    LAS unsigned* vnT = (LAS unsigned*)lds;
    LAS float* st = (LAS float*)(lds + GATE_ST_OFF);
    const bool smp = ch >= 256; const int r0 = smp ? NPR + 64 * (ch - 256) : 128 * ch, nrows = smp ? 64 : 128;
    const float* vstat = (const float*)(ws + WS_VSP); const bf16* V = (const bf16*)(ws + WS_V); const bf16* U = (const bf16*)(ws + WS_U); bf16* CAT = (bf16*)(ws + WS_CAT);
    if (tid < 128) { float mean = 0.f, rstd = 0.f;
        if (tid < nrows) { float s1 = 0.f, s2 = 0.f;
#pragma unroll
            for (int i = 0; i < 16; ++i) { const f32x2 p = *(const f32x2*)(vstat + ((size_t)(r0 + tid) * 16 + i) * 2); s1 += p.x; s2 += p.y; }
            mean = s1 * (1.0f / AW); const float var = fmaxf(s2 * (1.0f / AW) - mean * mean, 0.f); rstd = rsqrtf(var + EPS); }
        st[2 * tid] = mean; st[2 * tid + 1] = rstd; }
    unsigned vw[4][8];
#pragma unroll
    for (int it = 0; it < 4; ++it) { const int idx = it * 512 + tid, cp = idx & 127, tg = idx >> 7, c = g * 256 + 2 * cp;
        if (8 * tg < nrows) {
#pragma unroll
            for (int j = 0; j < 8; ++j) vw[it][j] = *(const unsigned*)(V + (size_t)(r0 + 8 * tg + j) * AW + c);
        } else {
#pragma unroll
            for (int j = 0; j < 8; ++j) vw[it][j] = 0u; } }
    __syncthreads();
#pragma unroll
    for (int it = 0; it < 4; ++it) {
        const int idx = it * 512 + tid, cp = idx & 127, tg = idx >> 7, c = g * 256 + 2 * cp;
        const f32x2 gg = *(const f32x2*)(a->in[I_AVG] + c), bb = *(const f32x2*)(a->in[I_AVB] + c);
        float v0[8], v1[8];
        if (8 * tg < nrows) {
#pragma unroll
            for (int j = 0; j < 8; ++j) { const int tok = 8 * tg + j; const float mean = st[2 * tok], rstd = st[2 * tok + 1];
                v0[j] = (bflo(vw[it][j]) - mean) * rstd * gg.x + bb.x; v1[j] = (bfhi(vw[it][j]) - mean) * rstd * gg.y + bb.y;
                if (smp) *(f32x2*)(a->out + O_NAV + (size_t)((ch - 256) * 64 + tok) * AW + c) = (f32x2){v0[j], v1[j]}; }
        } else {
#pragma unroll
            for (int j = 0; j < 8; ++j) { v0[j] = 0.f; v1[j] = 0.f; } }
        v4u w0, w1; w0.x = pk2(v0[0], v0[1]); w0.y = pk2(v0[2], v0[3]); w0.z = pk2(v0[4], v0[5]); w0.w = pk2(v0[6], v0[7]); w1.x = pk2(v1[0], v1[1]); w1.y = pk2(v1[2], v1[3]); w1.z = pk2(v1[4], v1[5]); w1.w = pk2(v1[6], v1[7]);
        *(LAS v4u*)(vnT + (2 * cp) * VNT_STRIDE_DW + 4 * tg) = w0; *(LAS v4u*)(vnT + (2 * cp + 1) * VNT_STRIDE_DW + 4 * tg) = w1;
    }
    __syncthreads();
    const int lr = lane & 15, lq = lane >> 4;
    v2u uw[8][2]; float bsv[8];
#pragma unroll
    for (int it = 0; it < 8; ++it) { const int i = 16 * it + lr; bsv[it] = a->in[I_ABS][g * 128 + i];
#pragma unroll
        for (int ct = 0; ct < 2; ++ct) uw[it][ct] = *(const v2u*)(U + (size_t)(r0 + i) * AW + g * 256 + 32 * wave + 16 * ct + 4 * lq); }
    f32x4 acc[2][8];
#pragma unroll
    for (int ct = 0; ct < 2; ++ct)
#pragma unroll
        for (int it = 0; it < 8; ++it) acc[ct][it] = (f32x4){0.f, 0.f, 0.f, 0.f};
#pragma unroll 1
    for (int ks = 0; ks < 4; ++ks) {
        bf16x8 af[2];
#pragma unroll
        for (int ct = 0; ct < 2; ++ct) af[ct] = *(const LAS bf16x8*)((const LAS unsigned char*)vnT + (32 * wave + 16 * ct + lr) * (VNT_STRIDE_DW * 4) + ks * 64 + lq * 16);
#pragma unroll
        for (int it = 0; it < 8; ++it) { const bf16x8 bfrag = *(const LAS bf16x8*)(lds + GATE_WM_OFF + (16 * it + lr) * GATE_WM_STRIDE + ks * 64 + lq * 16);
#pragma unroll
            for (int ct = 0; ct < 2; ++ct) acc[ct][it] = __builtin_amdgcn_mfma_f32_16x16x32_bf16(af[ct], bfrag, acc[ct][it], 0, 0, 0); }
    }
#pragma unroll
    for (int it = 0; it < 8; ++it) { const int i = 16 * it + lr;
        if (i < nrows) {
#pragma unroll
            for (int ct = 0; ct < 2; ++ct) { const int cb = g * 256 + 32 * wave + 16 * ct + 4 * lq; const v2u u2 = uw[it][ct]; const float bs = bsv[it];
                v2u w; w.x = pk2(bflo(u2.x) * (acc[ct][it][0] + bs), bfhi(u2.x) * (acc[ct][it][1] + bs)); w.y = pk2(bflo(u2.y) * (acc[ct][it][2] + bs), bfhi(u2.y) * (acc[ct][it][3] + bs));
                *(v2u*)(CAT + (size_t)(r0 + i) * D + cb) = w; } } }
    __syncthreads();
}
constexpr int CONV_W_BYTES = 31 * 1024 * 4;
__device__ __forceinline__ void conv_stage_weights(CArgsP a, LAS unsigned char* lds, int tid) {
    __syncthreads();
    for (int i = tid; i < 31 * 256; i += NWAVES * 64) *(LAS f32x4*)(lds + 16 * i) = *(const f32x4*)(a->in[I_BDW] + 4 * i);
    __syncthreads();
}
__device__ __forceinline__ f32x2 conv_row(const bf16* GLU, const float* hist, int rowbase, int t, int c) {
    if (t >= 0) { const unsigned w = *(const unsigned*)(GLU + (size_t)(rowbase + t) * AW + c); return (f32x2){bflo(w), bfhi(w)}; }
    if (hist) return *(const f32x2*)(hist + (size_t)(30 + t) * 1024 + c);
    return (f32x2){0.f, 0.f};
}
__device__ __forceinline__ void mix_conv_unit(CArgsP a, LAS unsigned char* lds, int b, int tid, int wave, int lane) {
    unsigned char* ws = a->ws;
    const LAS float* dwl = (const LAS float*)lds;
    LAS float* red = (LAS float*)(lds + CONV_W_BYTES);
    LAS float* stt = red + 128;
    int rowbase, t0; const float* hist = nullptr;
    if (b < 1024) { rowbase = 8192 * (b >> 8); t0 = 32 * (b & 255); } else { const int q = b - 1024; rowbase = NPR + 64 * (q >> 1); t0 = 32 * (q & 1); hist = a->in[I_SCONV] + (size_t)(q >> 1) * 30 * 1024; }
    const bf16* GLU = (const bf16*)(ws + WS_GLU); bf16* CAT = (bf16*)(ws + WS_CAT);
    const int c = 2 * tid;
    const f32x2 lg = *(const f32x2*)(a->in[I_BLNG] + c), lb = *(const f32x2*)(a->in[I_BLNB] + c);
    f32x2 x[62];
    if (t0 >= 30) {
        const bf16* gp = GLU + (size_t)(rowbase + t0 - 30) * AW + c;
        unsigned xw[62];
#pragma unroll
        for (int i = 0; i < 62; ++i) xw[i] = *(const unsigned*)(gp + (size_t)i * AW);
#pragma unroll
        for (int i = 0; i < 62; ++i) x[i] = (f32x2){bflo(xw[i]), bfhi(xw[i])};
    } else {
#pragma unroll
        for (int i = 0; i < 62; ++i) x[i] = conv_row(GLU, hist, rowbase, t0 - 30 + i, c);
    }
#pragma unroll
    for (int sub = 0; sub < 4; ++sub) {
        const int tt0 = t0 + 8 * sub;
        f32x2 acc[8];
#pragma unroll
        for (int t = 0; t < 8; ++t) acc[t] = (f32x2){0.f, 0.f};
#pragma unroll
        for (int k = 0; k < 31; ++k) { const f32x2 wk = *(const LAS f32x2*)(dwl + k * 1024 + c);
#pragma unroll
            for (int t = 0; t < 8; ++t) acc[t] += x[8 * sub + t + k] * wk; }
#pragma unroll
        for (int t = 0; t < 8; ++t) { const float s1 = wave_sum(acc[t].x + acc[t].y), s2 = wave_sum(acc[t].x * acc[t].x + acc[t].y * acc[t].y);
            if (lane == 0) { red[(wave * 8 + t) * 2] = s1; red[(wave * 8 + t) * 2 + 1] = s2; } }
        __syncthreads();
        if (tid < 8) { float s1 = 0.f, s2 = 0.f;
#pragma unroll
            for (int w = 0; w < 8; ++w) { s1 += red[(w * 8 + tid) * 2]; s2 += red[(w * 8 + tid) * 2 + 1]; }
            const float mean = s1 * (1.0f / AW), var = fmaxf(s2 * (1.0f / AW) - mean * mean, 0.f); stt[2 * tid] = mean; stt[2 * tid + 1] = rsqrtf(var + EPS); }
        __syncthreads();
#pragma unroll
        for (int t = 0; t < 8; ++t) { const float mean = stt[2 * t], rstd = stt[2 * t + 1];
            const float y0 = (acc[t].x - mean) * rstd * lg.x + lb.x, y1 = (acc[t].y - mean) * rstd * lg.y + lb.y;
            *(unsigned*)(CAT + (size_t)(rowbase + tt0 + t) * D + AW + c) = pk2(siluf_(y0), siluf_(y1)); }
        asm volatile("" ::: "memory");
    }
}
__device__ __forceinline__ f32x4 tc_hm(const bf16* h, const float* hist, const LAS float* rs, int rowbase, int t0, int t, int c, f32x4 gs, f32x4 sh) {
    if (t >= 0) { const v2u w = *(const v2u*)(h + (size_t)(rowbase + t) * D + c); return (f32x4){bflo(w.x), bfhi(w.x), bflo(w.y), bfhi(w.y)} * rs[t - t0 + 15] * gs + sh; }
    if (hist) return *(const f32x4*)(hist + (size_t)(15 + t) * D + c);
    return (f32x4){0.f, 0.f, 0.f, 0.f};
}
__device__ __forceinline__ f32x4 tc_hm_all(const bf16* h, const LAS float* rs, int rowbase, int t0, int t, int c, f32x4 gs, f32x4 sh) {
    const v2u w = *(const v2u*)(h + (size_t)(rowbase + t) * D + c); return (f32x4){bflo(w.x), bfhi(w.x), bflo(w.y), bfhi(w.y)} * rs[t - t0 + 15] * gs + sh;
}
template <int W, bool ALLV> __device__ __forceinline__ void tc_body(const bf16* h, const float* hist, const LAS float* rs, int rowbase, int t0, int T, int pos0, int c, f32x4 gs, f32x4 sh, bf16* PC, float* np) {
    f32x4 ring[16]; f32x4 S = (f32x4){0.f, 0.f, 0.f, 0.f};
#pragma unroll
    for (int k = 1; k < W; ++k) { ring[(16 - k) & 15] = ALLV ? tc_hm_all(h, rs, rowbase, t0, t0 - k, c, gs, sh) : tc_hm(h, hist, rs, rowbase, t0, t0 - k, c, gs, sh); S += ring[(16 - k) & 15]; }
#pragma unroll
    for (int tt = 0; tt < 32; ++tt) { const int t = t0 + tt;
        const f32x4 cur = ALLV ? tc_hm_all(h, rs, rowbase, t0, t, c, gs, sh) : tc_hm(h, hist, rs, rowbase, t0, t, c, gs, sh);
        S += cur;
        const int pos = pos0 + t; const float inv = 1.0f / (float)(pos + 1 < W ? pos + 1 : W);
        const f32x4 p = S * inv - cur;
        v2u o; o.x = pk2(p.x, p.y); o.y = pk2(p.z, p.w); *(v2u*)(PC + (size_t)(rowbase + t) * D + c) = o;
        if (t >= T - 15) *(f32x4*)(np + (size_t)(t - (T - 15)) * D + c) = cur;
        if (W > 1) { if (W == 2) S -= (tt == 0 ? ring[15] : ring[(tt - 1) & 15]); else S -= ring[(tt - W + 1 + 32) & 15]; }
        ring[tt & 15] = cur;
    }
}
__device__ __forceinline__ void tc_unit(CArgsP a, LAS unsigned char* lds, const bf16* h, const float* ssq, const float* ng, const float* shift, const float* scale, int b, int tid, int wave, int lane) {
    unsigned char* ws = a->ws;
    LAS float* rs = (LAS float*)lds;
    int rowbase, t0, s, T, pos0; const float* hist = nullptr; float* np;
    if (b < 1024) { s = b >> 8; rowbase = 8192 * s; t0 = 32 * (b & 255); T = 8192; pos0 = 0; np = a->out + O_NPP + (size_t)s * 15 * D; }
    else { const int q = b - 1024; s = 4 + (q >> 1); rowbase = NPR + 64 * (q >> 1); t0 = 32 * (q & 1); T = 64; pos0 = 1024; hist = a->in[I_SPOOL] + (size_t)(q >> 1) * 15 * D; np = a->out + O_NPS + (size_t)(q >> 1) * 15 * D; }
    if (tid < 47) { const int t = t0 - 15 + tid; if (t >= 0) rs[tid] = rsqrtf(ssq[rowbase + t] * (1.0f / D) + EPS); }
    __syncthreads();
    const int c = 4 * tid, grp = __builtin_amdgcn_readfirstlane(tid >> 7);
    const f32x4 gs = *(const f32x4*)(ng + c) * (*(const f32x4*)(scale + (size_t)s * MODS + c) + 1.0f), sh = *(const f32x4*)(shift + (size_t)s * MODS + c);
    bf16* PC = (bf16*)(ws + WS_PC);
    if (t0 >= 15) {
        if (grp == 0) tc_body<2, true>(h, hist, rs, rowbase, t0, T, pos0, c, gs, sh, PC, np);
        else if (grp == 1) tc_body<4, true>(h, hist, rs, rowbase, t0, T, pos0, c, gs, sh, PC, np);
        else if (grp == 2) tc_body<8, true>(h, hist, rs, rowbase, t0, T, pos0, c, gs, sh, PC, np);
        else tc_body<16, true>(h, hist, rs, rowbase, t0, T, pos0, c, gs, sh, PC, np);
    } else {
        if (grp == 0) tc_body<2, false>(h, hist, rs, rowbase, t0, T, pos0, c, gs, sh, PC, np);
        else if (grp == 1) tc_body<4, false>(h, hist, rs, rowbase, t0, T, pos0, c, gs, sh, PC, np);
        else if (grp == 2) tc_body<8, false>(h, hist, rs, rowbase, t0, T, pos0, c, gs, sh, PC, np);
        else tc_body<16, false>(h, hist, rs, rowbase, t0, T, pos0, c, gs, sh, PC, np);
    }
    __syncthreads();
}

__device__ __forceinline__ void slab_reduce(const void* base_s, int base_f32, bf16* hS, const float* slab, int ks, bf16* an, const float* ng_n, const float* sc_n, float* ss, int gw, int NGW, int lane) {
    for (int r = gw; r < NSR; r += NGW) {
        const int s = 4 + (r >> 6);
        f32x4 v[8]; float q = 0.f;
#pragma unroll
        for (int j = 0; j < 8; ++j) { const size_t o = (size_t)r * D + 4 * lane + 256 * j;
            if (base_f32) v[j] = *(const f32x4*)((const float*)base_s + o); else { const v2u w = *(const v2u*)((const bf16*)base_s + o); v[j] = (f32x4){bflo(w.x), bfhi(w.x), bflo(w.y), bfhi(w.y)}; } }
#pragma unroll 4
        for (int k = 0; k < ks; ++k) {
#pragma unroll
            for (int j = 0; j < 8; ++j) v[j] += *(const f32x4*)(slab + ((size_t)k * NSR + r) * D + 4 * lane + 256 * j); }
#pragma unroll
        for (int j = 0; j < 8; ++j) { const int c = 4 * lane + 256 * j; { v2u w; w.x = pk2(v[j].x, v[j].y); w.y = pk2(v[j].z, v[j].w); *(v2u*)(hS + (size_t)r * D + c) = w; } q += (v[j].x * v[j].x + v[j].y * v[j].y) + (v[j].z * v[j].z + v[j].w * v[j].w);
            if (an) { const f32x4 t = v[j] * (*(const f32x4*)(ng_n + c) * (*(const f32x4*)(sc_n + (size_t)s * MODS + c) + 1.0f)); v2u w; w.x = pk2(t.x, t.y); w.y = pk2(t.z, t.w); *(v2u*)(an + (size_t)(NPR + r) * D + c) = w; } }
        if (ss) { q = wave_sum(q); if (lane == 0) ss[NPR + r] = q; }
    }
}
__device__ __forceinline__ void slab_reduce_final(const bf16* base_s, const float* slab, int ks, float* yo, const float* ng, int r, int lane) {
    f32x4 v[8]; float q = 0.f;
#pragma unroll
    for (int j = 0; j < 8; ++j) { const v2u w = *(const v2u*)(base_s + (size_t)r * D + 4 * lane + 256 * j); v[j] = (f32x4){bflo(w.x), bfhi(w.x), bflo(w.y), bfhi(w.y)}; }
#pragma unroll 4
    for (int k = 0; k < ks; ++k) {
#pragma unroll
        for (int j = 0; j < 8; ++j) v[j] += *(const f32x4*)(slab + ((size_t)k * NSR + r) * D + 4 * lane + 256 * j); }
#pragma unroll
    for (int j = 0; j < 8; ++j) q += (v[j].x * v[j].x + v[j].y * v[j].y) + (v[j].z * v[j].z + v[j].w * v[j].w);
    const float rstd = rsqrtf(wave_sum(q) * (1.0f / D) + EPS);
#pragma unroll
    for (int j = 0; j < 8; ++j) *(f32x4*)(yo + (size_t)(NPR + r) * D + 4 * lane + 256 * j) = v[j] * rstd * (*(const f32x4*)(ng + 4 * lane + 256 * j));
}
__device__ __forceinline__ void mod_reduce(const float* modp, float* mod, int gtid, int NT) {
    for (int i = gtid; i < 2 * MODL / 4; i += NT) { f32x4 v = ((const f32x4*)modp)[i];
#pragma unroll
        for (int k = 1; k < 16; ++k) v += ((const f32x4*)modp)[(size_t)k * (2 * MODL / 4) + i];
        ((f32x4*)mod)[i] = v; }
}
__device__ __forceinline__ void ss_finalize(const float* ssp, float* ss, int nrows, int gtid, int NT) {
    for (int r = gtid; r < nrows; r += NT) { const f32x4* p = (const f32x4*)(ssp + (size_t)r * 32); f32x4 v = p[0];
#pragma unroll
        for (int k = 1; k < 8; ++k) v += p[k];
        ss[r] = (v.x + v.y) + (v.z + v.w); }
}
constexpr int SHL_STRIDE = D + 8;
__device__ __forceinline__ void sb_gemv(LAS unsigned char* lds, const bf16* Wt, int nrows, const float* shift, float* sb, int gw, int NGW, int tid, int lane) {
    LAS bf16* shl = (LAS bf16*)lds;
    __syncthreads();
    for (int i = tid; i < 16 * (D / 8); i += NWAVES * 64) { const int s = i / (D / 8), c8 = i % (D / 8); v4u w = (v4u){0u, 0u, 0u, 0u};
        if (s < NSTREAM) { const float* p = shift + (size_t)s * MODS + 8 * c8; const f32x4 a = *(const f32x4*)p, b = *(const f32x4*)(p + 4); w.x = pk2(a.x, a.y); w.y = pk2(a.z, a.w); w.z = pk2(b.x, b.y); w.w = pk2(b.z, b.w); }
        *(LAS v4u*)(shl + s * SHL_STRIDE + 8 * c8) = w; }
    __syncthreads();
    const int lr = lane & 15, lq = lane >> 4;
    for (int tile = gw; tile < nrows / 16; tile += NGW) {
        const int n0 = 16 * tile;
        f32x4 acc = (f32x4){0.f, 0.f, 0.f, 0.f};
        const bf16* wp = Wt + (size_t)(n0 + lr) * D + 8 * lq; const LAS bf16* ap = shl + lr * SHL_STRIDE + 8 * lq;
        bf16x8 wf[32];
#pragma unroll 1
        for (int kh = 0; kh < 2; ++kh) {
#pragma unroll
            for (int ks = 0; ks < 32; ++ks) wf[ks] = *(const bf16x8*)(wp + 32 * (32 * kh + ks));
#pragma unroll
            for (int ks = 0; ks < 32; ++ks) acc = __builtin_amdgcn_mfma_f32_16x16x32_bf16(*(const LAS bf16x8*)(ap + 32 * (32 * kh + ks)), wf[ks], acc, 0, 0, 0);
        }
#pragma unroll
        for (int j = 0; j < 4; ++j) { const int s = 4 * lq + j; if (s < NSTREAM) sb[(size_t)s * nrows + n0 + lr] = acc[j]; }
    }
}

constexpr int NPL = 13, NPH = 3 + 2 * NPL;
constexpr int KS_G2 = 11, KS_G4 = 8;
__global__ void __launch_bounds__(NWAVES * 64, 2) mk_fwd(Args args) {
    extern __shared__ __attribute__((aligned(16))) unsigned char lds_raw[];
    LAS unsigned char* lds = (LAS unsigned char*)lds_raw;
    volatile LAS unsigned* MISC = (volatile LAS unsigned*)(lds + MISC_OFF);
    constexpr int G = NCU;
    const int bx = blockIdx.x, vcu = (bx % 8) * (G / 8) + bx / 8; constexpr int NGW = G * NWAVES;
    for (int u = threadIdx.x; u < (LDS_BYTES - LDSCTL_OFF) / 4; u += NWAVES * 64) ((LAS unsigned*)(lds + LDSCTL_OFF))[u] = 0u;
    __syncthreads();
    const int lo = args.ph_lo, hi = args.ph_hi;
    XcdBarrier bar; bar.bar = (unsigned*)(args.ws + WS_CTL) + CW_BAR; bar.x = 0; bar.st = nullptr;
    if (hi - lo > 1) bar = xcd_barrier_post((unsigned*)(args.ws + WS_CTL) + CW_BAR, MISC + 8);
#ifndef PH_MASK
#define PH_MASK 0xFFFFFFFFu
#endif
#define SITE(i) ((PH_MASK >> (i)) & 1u)
#define REP(i) for (int rep_ = 0; rep_ < 1 + (int)((DUP_MASK >> (i)) & 1u); ++rep_)
#define IN(k) (lo <= (k) && (k) < hi)
#define STAGGER(x0, span) ((G % 8 == 0 && (bx % 8) >= (x0)) ? (unsigned)((span) * ((bx % 8) - (x0) + 1) / (9 - (x0))) : 0u)
#define SEAM(k) do { if ((k) + 1 < hi) { xcd_barrier(bar); if ((DUP_MASK >> 7) & 1u) xcd_barrier(bar); } } while (0)
#define SITE_IDS int tid = threadIdx.x; asm volatile("" : "+v"(tid)); const int lane = tid & 63, wave = __builtin_amdgcn_readfirstlane(tid >> 6), gw = vcu * NWAVES + wave; (void)lane; (void)gw; \
    CArgsP ap = (CArgsP)__builtin_amdgcn_kernarg_segment_ptr(); asm volatile("" : "+s"(ap)); unsigned char* ws = ap->ws; bf16* h = (bf16*)(ws + WS_H); bf16* hS = h + (size_t)NPR * D; (void)hS; (void)h; \
    const float* modl = (const float*)(ws + WS_MOD) + (size_t)l * MODL; const float* ngl = ap->in[I_NORMG] + (size_t)l * 3 * D; (void)modl; (void)ngl; \
    bf16* HN = (bf16*)(ws + WS_HN); bf16* ACT = (bf16*)(ws + WS_ACT); float* SLAB = (float*)(ws + WS_SLAB); float* SSQ = (float*)(ws + WS_SS); float* SSP = (float*)(ws + WS_SSP); const int gtid = (int)blockIdx.x * (NWAVES * 64) + tid; (void)HN; (void)ACT; (void)SLAB; (void)SSQ; (void)SSP; (void)gtid

    { const int l = 0; if (SITE(0) && IN(0)) { SITE_IDS; p0_prologue(ap, lds, gw, NGW, wave, lane); SEAM(0); }
      if (SITE(0) && IN(1)) { SITE_IDS; mod_reduce((const float*)(ws + WS_MODP), (float*)(ws + WS_MOD), gtid, G * NWAVES * 64); SEAM(1); } }

#pragma unroll 1
    for (int l = 0; l < 2; ++l) {
        const int pb = 2 + NPL * l;
        if (l == 0 && SITE(1) && IN(pb + 0)) { SITE_IDS; const float* mod0 = (const float*)(ws + WS_MOD); float* SB = (float*)(ws + WS_SB);
            REP(1) thin_norm(ap->in[I_XP], ap->in[I_XS], ngl, modl + 0 * D, modl + 1 * D, HN, gw, NGW, lane);
            sb_gemv(lds, (const bf16*)(ws + WS_WIN), 4096, mod0 + 3 * D, SB + (size_t)4 * 12 * 11264, gw, NGW, tid, lane);
            SEAM(pb + 0); }
        if (SITE(2) && IN(pb + 1)) { SITE_IDS; pg8::Gemm g{HN, (const bf16*)(ws + WS_WGU) + (size_t)(2 * l) * 11264 * 2048, M, 11264, D, D, 0}; pg8::StaticOrder S; S.init(NPR, NSR, 11264, D, G, bx, 1);
            pg8::EpiSwiGLU E{ACT, DFF, l == 0 ? nullptr : SSQ + (size_t)2 * M, (const float*)(ws + WS_SB) + (size_t)2 * 12 * 11264}; REP(0) pg8::gemm_phase<pg8::EpiSwiGLU, true>(lds, g, S, E, 0u);
            { const int c0 = (S.nTail + 31) / 32 * 32;
              if (vcu >= c0) conv_window(ap, lds, 2 * l + 1, -1, -1, vcu - c0, G - c0, wave, lane); } SEAM(pb + 1); }
        if (SITE(3) && IN(pb + 2)) { SITE_IDS; pg8::Gemm g{ACT, (const bf16*)(ws + WS_WD) + (size_t)(2 * l) * 2048 * 5632, M, D, DFF, DFF, 0}; pg8::StaticOrder S; S.init(NPR, NSR, D, DFF, G, bx, KS_G2, 4);
            pg8::EpiRes<false> E{l == 0 ? (const void*)ap->in[I_XP] : (const void*)h, l == 0 ? (const void*)ap->in[I_XS] : (const void*)hS, h, modl + 2 * D, nullptr, nullptr, SLAB, l == 0 ? HN : nullptr, ngl + D, modl + 4 * D, SSP + (size_t)(l == 0 ? 0 : 3) * M * 32, 0.5f, l == 0 ? 1 : 0};
            if ((DUP_MASK >> 5) & 1u) { pg8::EpiRes<false> E2 = E; E2.out = (bf16*)(ws + WS_DUMMY); E2.an = nullptr; E2.ss = nullptr; pg8::gemm_phase<pg8::EpiRes<false>, true>(lds, g, S, E2); }
            pg8::gemm_phase<pg8::EpiRes<false>, true>(lds, g, S, E); SEAM(pb + 2); }
        if (SITE(3) && IN(pb + 3)) { SITE_IDS; slab_reduce(l == 0 ? (const void*)ap->in[I_XS] : (const void*)hS, l == 0 ? 1 : 0, hS, SLAB, KS_G2, l == 0 ? HN : nullptr, ngl + D, modl + 4 * D, SSQ + (size_t)(l == 0 ? 0 : 3) * M, gw, NGW, lane);
            ss_finalize(SSP + (size_t)(l == 0 ? 0 : 3) * M * 32, SSQ + (size_t)(l == 0 ? 0 : 3) * M, NPR, gtid, G * NWAVES * 64);
            SEAM(pb + 3); }
        if (l == 0) {
            if (SITE(5) && IN(pb + 5)) { SITE_IDS; pg8::Gemm g{HN, (const bf16*)(ws + WS_WIN), M, 4096, D, D, 0}; pg8::StaticOrder S; S.init(NPR, NSR, 4096, D, G, bx, 1);
                pg8::EpiInProj E{(bf16*)(ws + WS_U), (bf16*)(ws + WS_V), (bf16*)(ws + WS_GLU), (float*)(ws + WS_VSP), ap->out + O_NCP, ap->out + O_NCS, SSQ, (const float*)(ws + WS_SB) + (size_t)4 * 12 * 11264};
                if ((DUP_MASK >> 6) & 1u) { pg8::EpiInProj E2 = E; E2.vstat = (float*)(ws + WS_DUMMY); pg8::gemm_phase<pg8::EpiInProj, true>(lds, g, S, E2); }
                pg8::gemm_phase<pg8::EpiInProj, true>(lds, g, S, E, 0u);
                if (vcu >= S.nTail) { const int rank = vcu - S.nTail, nrank = G - S.nTail; conv_window(ap, lds, -1, 1, 2, rank, nrank, wave, lane);
                    sb_gemv(lds, (const bf16*)(ws + WS_WGU) + (size_t)1 * 11264 * 2048, 11264, (const float*)(ws + WS_MOD) + 6 * D, (float*)(ws + WS_SB) + (size_t)1 * 12 * 11264, rank * NWAVES + wave, nrank * NWAVES, tid, lane); }
                SEAM(pb + 5); }
            if (SITE(6) && IN(pb + 6)) { SITE_IDS;
                REP(2) { bool staged = false; gate_stage_wm(ap, lds, vcu & 3, tid);
                  for (int u = vcu; u < 1056 + 1040; u += G) { if (u < 1056) { if (SITE(20)) mix_gate_unit(ap, lds, u >> 2, u & 3, tid, wave, lane); } else { if (!staged) { conv_stage_weights(ap, lds, tid); staged = true; } if (SITE(21)) mix_conv_unit(ap, lds, u - 1056, tid, wave, lane); } } __syncthreads(); }
                SEAM(pb + 6); }
            if (SITE(7) && IN(pb + 7)) { SITE_IDS; pg8::Gemm g{(const bf16*)(ws + WS_CAT), (const bf16*)(ws + WS_WOUT), M, D, D, D, 0}; pg8::StaticOrder S; S.init(NPR, NSR, D, D, G, bx, KS_G4);
                pg8::EpiRes<false> E{h, hS, h, modl + 5 * D, nullptr, nullptr, SLAB, HN, ngl + 2 * D, modl + 7 * D, SSP + (size_t)1 * M * 32, 1.0f, 0};
                if ((DUP_MASK >> 6) & 1u) { pg8::EpiRes<false> E2 = E; E2.out = (bf16*)(ws + WS_DUMMY); E2.an = nullptr; E2.ss = nullptr; pg8::gemm_phase<pg8::EpiRes<false>, true>(lds, g, S, E2); }
                pg8::gemm_phase<pg8::EpiRes<false>, true>(lds, g, S, E); SEAM(pb + 7); }
            if (SITE(7) && IN(pb + 8)) { SITE_IDS; slab_reduce(hS, 0, hS, SLAB, KS_G4, HN, ngl + 2 * D, modl + 7 * D, SSQ + (size_t)1 * M, gw, NGW, lane); ss_finalize(SSP + (size_t)1 * M * 32, SSQ + (size_t)1 * M, NPR, gtid, G * NWAVES * 64); SEAM(pb + 8); }
        } else {
            if (SITE(8) && IN(pb + 4)) { SITE_IDS; REP(3) for (int u = vcu; u < 1040; u += G) tc_unit(ap, lds, h, SSQ + (size_t)3 * M, ngl + D, modl + 3 * D, modl + 4 * D, u, tid, wave, lane); SEAM(pb + 4); }
            if (SITE(9) && IN(pb + 7)) { SITE_IDS; pg8::Gemm g{(const bf16*)(ws + WS_PC), (const bf16*)(ws + WS_WC), M, D, 512, D, 2}; pg8::StaticOrder S; S.init(NPR, NSR, D, 512, G, bx, 1);
                pg8::EpiRes<true> E{h, hS, h, modl + 5 * D, ap->in[I_CB], ap->in[I_CSC], SLAB, HN, ngl + 2 * D, modl + 7 * D, SSP + (size_t)4 * M * 32, 1.0f, 0};
                if ((DUP_MASK >> 6) & 1u) { pg8::EpiRes<true> E2 = E; E2.out = (bf16*)(ws + WS_DUMMY); E2.an = nullptr; E2.ss = nullptr; pg8::gemm_phase<pg8::EpiRes<true>, true>(lds, g, S, E2); }
                pg8::gemm_phase<pg8::EpiRes<true>, true>(lds, g, S, E);
                if (vcu >= S.nTail) sb_gemv(lds, (const bf16*)(ws + WS_WGU) + (size_t)3 * 11264 * 2048, 11264, (const float*)(ws + WS_MOD) + MODL + 6 * D, (float*)(ws + WS_SB) + (size_t)3 * 12 * 11264, (vcu - S.nTail) * NWAVES + wave, (G - S.nTail) * NWAVES, tid, lane);
                SEAM(pb + 7); }
            if (SITE(9) && IN(pb + 8)) { SITE_IDS; ss_finalize(SSP + (size_t)4 * M * 32, SSQ + (size_t)4 * M, M, gtid, G * NWAVES * 64); SEAM(pb + 8); }
        }
        if (SITE(11) && IN(pb + 10)) { SITE_IDS; pg8::Gemm g{HN, (const bf16*)(ws + WS_WGU) + (size_t)(2 * l + 1) * 11264 * 2048, M, 11264, D, D, 0}; pg8::StaticOrder S; S.init(NPR, NSR, 11264, D, G, bx, 1);
            pg8::EpiSwiGLU E{ACT, DFF, SSQ + (size_t)(l == 0 ? 1 : 4) * M, (const float*)(ws + WS_SB) + (size_t)(2 * l + 1) * 12 * 11264}; REP(0) pg8::gemm_phase<pg8::EpiSwiGLU, true>(lds, g, S, E, 0u);
            { const int c0 = (S.nTail + 31) / 32 * 32; if (vcu >= c0) conv_window(ap, lds, l == 0 ? 2 : -1, l == 0 ? -1 : 3, -1, vcu - c0, G - c0, wave, lane); } SEAM(pb + 10); }
        if (SITE(12) && IN(pb + 11)) { SITE_IDS; pg8::Gemm g{ACT, (const bf16*)(ws + WS_WD) + (size_t)(2 * l + 1) * 2048 * 5632, M, D, DFF, DFF, 0}; pg8::StaticOrder S; S.init(NPR, NSR, D, DFF, G, bx, KS_G2, 4);
            const float* ng1 = ap->in[I_NORMG] + (size_t)3 * D; const float* mod1 = (const float*)(ws + WS_MOD) + MODL;
            pg8::EpiRes<false> E{h, hS, h, modl + 8 * D, nullptr, nullptr, SLAB, l == 0 ? HN : nullptr, ng1, mod1 + 1 * D, l == 0 ? SSP + (size_t)2 * M * 32 : nullptr, 0.5f, 0};
            if ((DUP_MASK >> 5) & 1u) { pg8::EpiRes<false> E2 = E; E2.out = (bf16*)(ws + WS_DUMMY); E2.an = nullptr; E2.ss = nullptr; pg8::gemm_phase<pg8::EpiRes<false>, true>(lds, g, S, E2); }
            pg8::gemm_phase<pg8::EpiRes<false>, true>(lds, g, S, E);
            if (l == 0 && vcu >= S.nTail) sb_gemv(lds, (const bf16*)(ws + WS_WGU) + (size_t)2 * 11264 * 2048, 11264, mod1 + 0 * D, (float*)(ws + WS_SB) + (size_t)2 * 12 * 11264, (vcu - S.nTail) * NWAVES + wave, (G - S.nTail) * NWAVES, tid, lane);
            SEAM(pb + 11); }
        if (SITE(12) && IN(pb + 12)) { SITE_IDS; const float* ng1 = ap->in[I_NORMG] + (size_t)3 * D; const float* mod1 = (const float*)(ws + WS_MOD) + MODL;
            if (l == 0) slab_reduce(hS, 0, hS, SLAB, KS_G2, HN, ng1, mod1 + 1 * D, SSQ + (size_t)2 * M, gw, NGW, lane);
            if (l == 0) ss_finalize(SSP + (size_t)2 * M * 32, SSQ + (size_t)2 * M, NPR, gtid, G * NWAVES * 64);
            if (l == 0) SEAM(pb + 12); }
    }
    { const int l = 0; if (SITE(13) && IN(NPH - 1)) { SITE_IDS;
        static_assert(NGW == 2048 && NSR * 4 == NGW && NPR == 512 * 64, "row dealing of the final phase");
        const int q4 = gw & 3, r0 = (gw >> 2) * 64 + (q4 == 0 ? 0 : 10 + 18 * (q4 - 1)), r1 = r0 + (q4 == 0 ? 10 : 18);
        if (q4 == 0) slab_reduce_final(hS, SLAB, KS_G2, ap->out, ap->in[I_FNORMG], gw >> 2, lane);
        final_norm(h, ap->out, ap->in[I_FNORMG], r0, r1, lane); } }
#undef IN
#undef SEAM
#undef SITE
#undef SITE_IDS
}

extern "C" void kernel_launch(void* const* d_in, const int* in_sizes, int n_in, void* d_out, int out_size, void* d_ws, size_t ws_size, hipStream_t stream) {
    static int grid = 0;
    if (grid == 0) {
        if (n_in != 25 || in_sizes[0] != NPR * D || (size_t)out_size != O_END || ws_size < WS_END) { fprintf(stderr, "kernel_launch: unexpected shapes (n_in %d, in0 %d, out %d, ws %zu); nothing launched\n", n_in, n_in > 0 ? in_sizes[0] : -1, out_size, ws_size); grid = -1; return; }
        int dev = 0, cus = 0, per_cu = 0;
        if (hipGetDevice(&dev) != hipSuccess || hipDeviceGetAttribute(&cus, hipDeviceAttributeMultiprocessorCount, dev) != hipSuccess) { fprintf(stderr, "kernel_launch: device query failed\n"); grid = -1; return; }
        if (hipFuncSetAttribute((const void*)mk_fwd, hipFuncAttributeMaxDynamicSharedMemorySize, LDS_BYTES) != hipSuccess) { fprintf(stderr, "kernel_launch: hipFuncSetAttribute failed\n"); grid = -1; return; }
        if (hipOccupancyMaxActiveBlocksPerMultiprocessor(&per_cu, (const void*)mk_fwd, NWAVES * 64, LDS_BYTES) != hipSuccess || per_cu < 1) fprintf(stderr, "kernel_launch: note: occupancy query reports %d workgroups per CU\n", per_cu);
        (void)hipGetLastError();
        if (cus != NCU) fprintf(stderr, "kernel_launch: built for a %d-CU device (one workgroup per CU), this one reports %d\n", NCU, cus);
        grid = NCU;
    }
    if (grid < 0) return;
    if (hipMemsetAsync((char*)d_ws + WS_CTL, 0, CTL_ZERO_BYTES, stream) != hipSuccess) { fprintf(stderr, "kernel_launch: memset failed\n"); return; }
    Args a{};
    for (int i = 0; i < 25; ++i) a.in[i] = (const float*)d_in[i];
    a.out = (float*)d_out; a.ws = (unsigned char*)d_ws;
#if MK_N_LAUNCHES == 1
    a.ph_lo = 0; a.ph_hi = NPH;
    hipLaunchKernelGGL(mk_fwd, dim3(grid), dim3(NWAVES * 64), LDS_BYTES, stream, a);
#else
    for (int p = 0; p < NPH; ++p) { if (p == 2 + 4 || p == 2 + 9 || p == 2 + NPL + 0 || p == 2 + NPL + 5 || p == 2 + NPL + 6 || p == 2 + NPL + 9) continue; a.ph_lo = p; a.ph_hi = p + 1; hipLaunchKernelGGL(mk_fwd, dim3(grid), dim3(NWAVES * 64), LDS_BYTES, stream, a); }
#endif
    const hipError_t le = hipPeekAtLastError();
    if (le != hipSuccess) fprintf(stderr, "kernel_launch: launch failed: %s\n", hipGetErrorName(le));
}
```

```cpp
#include <hip/hip_runtime.h>
#include <cstdio>
#include <cstdint>

#ifndef MK_N_LAUNCHES
#define MK_N_LAUNCHES 1
#endif

#ifndef DUP_MASK
#define DUP_MASK 0u
#endif

constexpr int D = 2048, DFF = 5632, NPR = 4 * 8192, NSR = 8 * 64, M = NPR + NSR;
constexpr int NSTREAM = 12, MODS = 9 * D, MODL = NSTREAM * MODS;
constexpr int AW = 1024;
constexpr float EPS = 1e-6f;

constexpr size_t MiB = 1u << 20;
constexpr size_t WS_CTL = 0, CTL_ZERO_BYTES = 64 * 1024;
constexpr size_t WS_VSTAT = 64 * 1024;
constexpr size_t WS_MOD = 1 * MiB;
constexpr size_t WS_SS = 3 * MiB;
constexpr size_t WS_SB = 4 * MiB + 512 * 1024;
constexpr size_t WS_WM = 4 * MiB;
constexpr size_t WS_WGU = 8 * MiB;
constexpr size_t WS_WD = 184 * MiB;
constexpr size_t WS_WIN = 272 * MiB;
constexpr size_t WS_WOUT = 288 * MiB;
constexpr size_t WS_WC = 296 * MiB;
constexpr size_t WS_HN = 300 * MiB;
constexpr size_t WS_ACT = 432 * MiB;
constexpr size_t WS_U = WS_ACT, WS_V = WS_ACT + 65 * MiB, WS_GLU = WS_ACT + 130 * MiB, WS_CAT = WS_ACT + 195 * MiB, WS_PC = WS_ACT;
constexpr size_t WS_SLAB = 790 * MiB;
constexpr size_t WS_MODP = 840 * MiB;
constexpr size_t WS_SSP = 870 * MiB;
constexpr size_t WS_VSP = 896 * MiB;
constexpr size_t WS_H = 904 * MiB;
constexpr size_t WS_END = 1036 * MiB;
static_assert(WS_H + (size_t)M * D * 2 <= WS_END, "h map");
static_assert(WS_MODP + (size_t)16 * 2 * MODL * 4 <= WS_SSP && WS_SSP + (size_t)6 * M * 32 * 4 <= WS_VSP && WS_VSP + (size_t)M * 32 * 4 <= WS_END, "partials map");
constexpr size_t WS_DUMMY = 1036 * MiB;
static_assert(WS_SLAB + (size_t)11 * NSR * D * 4 <= WS_END, "slab map");
static_assert(WS_VSTAT + (size_t)M * 8 <= WS_MOD && WS_MOD + (size_t)2 * MODL * 4 <= WS_SS && WS_SS + (size_t)6 * M * 4 <= 4 * MiB && WS_WM + 4 * 128 * 128 * 2 <= WS_SB && WS_SB + (size_t)5 * 12 * 11264 * 4 <= WS_WGU, "ctl map");
static_assert(WS_WGU + 4 * (size_t)11264 * 2048 * 2 <= WS_WD && WS_WD + 4 * (size_t)2048 * 5632 * 2 <= WS_WIN && WS_WIN + (size_t)4096 * 2048 * 2 <= WS_WOUT, "weights map");
static_assert(WS_HN + (size_t)M * D * 2 <= WS_ACT && WS_ACT + (size_t)M * DFF * 2 <= WS_END && WS_CAT + (size_t)M * D * 2 <= WS_END && (size_t)M * AW * 2 <= 65 * MiB, "act map");
constexpr int CW_TMO = 0, CW_BAR = 4096;

constexpr size_t O_Y = 0, O_NCP = (size_t)M * D, O_NCS = O_NCP + 4 * 30 * 1024, O_NPP = O_NCS + 8 * 30 * 1024, O_NPS = O_NPP + 4 * 15 * 2048, O_NAV = O_NPS + 8 * 15 * 2048, O_END = O_NAV + 8 * 64 * 1024;

constexpr int RING_BYTES = 131072, LDSCTL_OFF = RING_BYTES, MISC_OFF = LDSCTL_OFF + 320, EPI_OFF = RING_BYTES + 1024, LDS_BYTES = 147456;
static_assert(MISC_OFF + 128 <= EPI_OFF && EPI_OFF + 8 * 1024 <= LDS_BYTES, "LDS map");
constexpr int NWAVES = 8, NCU = 256;

#define GAS __attribute__((address_space(1)))
#define LAS __attribute__((address_space(3)))
typedef unsigned short bf16;
typedef unsigned v4u __attribute__((ext_vector_type(4)));
typedef unsigned v2u __attribute__((ext_vector_type(2)));
typedef float f32x4 __attribute__((ext_vector_type(4)));
typedef float f32x2 __attribute__((ext_vector_type(2)));
typedef short bf16x8 __attribute__((ext_vector_type(8)));
#define LDS_WAIT() asm volatile("s_waitcnt lgkmcnt(0)" ::: "memory")
#define VM_WAIT() asm volatile("s_waitcnt vmcnt(0)" ::: "memory")

__device__ __forceinline__ unsigned f2bf(float f) { unsigned u = __builtin_bit_cast(unsigned, f); return (u + 0x7fffu + ((u >> 16) & 1u)) >> 16; }
__device__ __forceinline__ unsigned pk2(float lo, float hi) { unsigned r; asm("v_cvt_pk_bf16_f32 %0, %1, %2" : "=v"(r) : "v"(lo), "v"(hi)); return r; }
__device__ __forceinline__ unsigned cvt_pk_bf16(float lo, float hi) { unsigned r; asm volatile("v_cvt_pk_bf16_f32 %0, %1, %2" : "=v"(r) : "v"(lo), "v"(hi)); return r; }
__device__ __forceinline__ float bflo(unsigned w) { return __builtin_bit_cast(float, w << 16); }
__device__ __forceinline__ float bfhi(unsigned w) { return __builtin_bit_cast(float, w & 0xffff0000u); }
__device__ __forceinline__ float sigmoidf_(float x) { return __builtin_amdgcn_rcpf(1.0f + __builtin_amdgcn_exp2f(-1.4426950409f * x)); }
__device__ __forceinline__ float siluf_(float x) { return x * sigmoidf_(x); }
__device__ __forceinline__ float gelu_tanh(float x) { return x * __builtin_amdgcn_rcpf(1.0f + __builtin_amdgcn_exp2f(-2.302208198f * x * (1.0f + 0.044715f * x * x))); }
template <int CTRL, int RMASK> __device__ __forceinline__ float dpp_add(float v) { return v + __builtin_bit_cast(float, __builtin_amdgcn_update_dpp(0, __builtin_bit_cast(int, v), CTRL, RMASK, 0xf, true)); }
__device__ __forceinline__ float wave_sum(float v) {
    v = dpp_add<0xB1, 0xf>(v);
    v = dpp_add<0x4E, 0xf>(v);
    v = dpp_add<0x141, 0xf>(v);
    v = dpp_add<0x140, 0xf>(v);
    v = dpp_add<0x142, 0xa>(v);
    v = dpp_add<0x143, 0xc>(v);
    return __builtin_bit_cast(float, __builtin_amdgcn_readlane(__builtin_bit_cast(int, v), 63));
}
__device__ __forceinline__ int stream_of_row(int r) { return r < NPR ? (r >> 13) : 4 + ((r - NPR) >> 6); }

namespace pg8 {
typedef unsigned short bf16_t;
constexpr int BM = 256, BK = 64, HALF = 128, HTB = HALF * BK * 2, STAGE_BYTES = 8 * HTB, NXCD = 8, WGM = 8;
__host__ __device__ __forceinline__ int lds_byte(int r, int c) { const int st = (r >> 4) * 2 + (c >> 5), rr = r & 15, cc = c & 31, ob = rr * 64 + cc * 2; return st * 1024 + (ob ^ (((ob >> 9) & 1) << 5)); }
__host__ __device__ __forceinline__ void stage_rc(int b, int& R, int& C) { const int st = b / 1024, sb = b % 1024, swz = sb ^ (((sb >> 9) & 1) << 5); R = (st >> 1) * 16 + swz / 64; C = (st & 1) * 32 + (swz % 64) / 2; }
__host__ __device__ __forceinline__ int perm32(int rho) { const int n = rho >> 4, i = rho & 15; return 8 * (i >> 2) + 4 * n + (i & 3); }

struct Unit { int pm, pn, kt0, ktn, slab; };
struct Gemm { const bf16_t* A; const bf16_t* Bt; int M, N, K, lda, tpg; };

struct StaticOrder {
    int nMp, nMt, nN, nwgP, nTail, G, c, ntk, ksplit, ktper, wgm;
    __host__ __device__ void init(int Mp, int Mt, int N_, int K_, int G_, int c_, int ksplit_, int wgm_ = WGM) { wgm = wgm_; nMp = Mp / BM; nMt = Mt / BM; nN = N_ / BM; nwgP = nMp * nN; G = G_; c = c_; ntk = K_ / BK; ksplit = ksplit_; ktper = ntk / ksplit_; nTail = nMt * nN * ksplit_; }
    __host__ __device__ bool next(int i, Unit& u) const {
        const long L = (long)i * G + c;
        if (L < nwgP) {
            int wgid = (int)L; { const int q = nwgP / NXCD, r = nwgP % NXCD, xcd = wgid % NXCD, off = wgid / NXCD; wgid = (xcd < r ? xcd * (q + 1) : r * (q + 1) + (xcd - r) * q) + off; }
            const int nig = wgm * nN, gid = wgid / nig, fm = gid * wgm, gsz = (nMp - fm) < wgm ? (nMp - fm) : wgm;
            u.pm = fm + ((wgid % nig) % gsz); u.pn = (wgid % nig) / gsz; u.kt0 = 0; u.ktn = ntk; u.slab = -1; return true;
        }
        if (L >= (long)nwgP + G) return false;
        const int cc = (int)(L - nwgP);
        const long j = (G % NXCD == 0) ? (long)(cc % NXCD) * (G / NXCD) + cc / NXCD : (long)cc; if (j >= nTail) return false;
        const int kc = (int)j % ksplit, t = (int)j / ksplit;
        u.pm = nMp + t % nMt; u.pn = t / nMt; u.kt0 = kc * ktper;
        u.ktn = ktper; u.slab = ksplit > 1 ? kc : -1; return true;
    }
};


struct EpiSwiGLU {
    static constexpr bool PERM = true; static constexpr int NEPI = 4, NVM = 8;
    bf16_t* O; int ldc; const float* ss; const float* sb;
    __device__ __forceinline__ bool fused() const { return ss != nullptr; }
    __device__ __forceinline__ void stage(const Unit& u, LAS unsigned char* area, int wr, int wc, int lane) const {
        const int rb0 = u.pm * BM + wr * 64, rb1 = rb0 + HALF, wrow = u.pn * BM + wc * 32 + (lane & 31) + (lane >> 5) * HALF;
        __builtin_amdgcn_global_load_lds((const unsigned*)(ss + rb0 + lane), (LAS unsigned*)(area), 4, 0, 0);
        __builtin_amdgcn_global_load_lds((const unsigned*)(ss + rb1 + lane), (LAS unsigned*)(area + 256), 4, 0, 0);
        __builtin_amdgcn_global_load_lds((const unsigned*)(sb + (size_t)stream_of_row(rb0) * 11264 + wrow), (LAS unsigned*)(area + 512), 4, 0, 0);
        __builtin_amdgcn_global_load_lds((const unsigned*)(sb + (size_t)stream_of_row(rb1) * 11264 + wrow), (LAS unsigned*)(area + 768), 4, 0, 0);
    }
    __device__ __forceinline__ void operator()(const f32x4 (&acc)[2][2][4][2], const Unit& u, int wr, int wc, int fr, int fq, const LAS unsigned char* area) const {
        const int row0 = u.pm * BM + wr * 64 + fr, col0 = u.pn * HALF + wc * 32 + 8 * fq;
#pragma unroll
        for (int ai = 0; ai < 2; ++ai) {
            f32x4 sg0 = (f32x4){0.f, 0.f, 0.f, 0.f}, sg1 = sg0, su0 = sg0, su1 = sg0;
            if (ss) { const LAS float* sp = (const LAS float*)(area + 512 + ai * 256) + 8 * fq; sg0 = *(const LAS f32x4*)sp; sg1 = *(const LAS f32x4*)(sp + 4); su0 = *(const LAS f32x4*)(sp + 32); su1 = *(const LAS f32x4*)(sp + 36); }
#pragma unroll
            for (int m = 0; m < 4; ++m) {
                const int r = row0 + ai * HALF + m * 16;
                const float rstd = ss ? __builtin_amdgcn_rsqf(((const LAS float*)(area + ai * 256))[m * 16 + fr] * (1.0f / D) + EPS) : 1.0f;
                bf16_t* rowp = O + (size_t)r * ldc + col0;
                const f32x4 g0 = acc[ai][0][m][0] * rstd + sg0, g1 = acc[ai][0][m][1] * rstd + sg1, u0 = acc[ai][1][m][0] * rstd + su0, u1 = acc[ai][1][m][1] * rstd + su1;
                const f32x4 t0 = g0 * -1.4426950409f, t1 = g1 * -1.4426950409f;
                const f32x4 e0 = (f32x4){__builtin_amdgcn_exp2f(t0[0]), __builtin_amdgcn_exp2f(t0[1]), __builtin_amdgcn_exp2f(t0[2]), __builtin_amdgcn_exp2f(t0[3])} + 1.0f;
                const f32x4 e1 = (f32x4){__builtin_amdgcn_exp2f(t1[0]), __builtin_amdgcn_exp2f(t1[1]), __builtin_amdgcn_exp2f(t1[2]), __builtin_amdgcn_exp2f(t1[3])} + 1.0f;
                const f32x4 o0 = (g0 * u0) * (f32x4){__builtin_amdgcn_rcpf(e0[0]), __builtin_amdgcn_rcpf(e0[1]), __builtin_amdgcn_rcpf(e0[2]), __builtin_amdgcn_rcpf(e0[3])};
                const f32x4 o1 = (g1 * u1) * (f32x4){__builtin_amdgcn_rcpf(e1[0]), __builtin_amdgcn_rcpf(e1[1]), __builtin_amdgcn_rcpf(e1[2]), __builtin_amdgcn_rcpf(e1[3])};
                v4u w;
                w.x = cvt_pk_bf16(o0[0], o0[1]); w.y = cvt_pk_bf16(o0[2], o0[3]); w.z = cvt_pk_bf16(o1[0], o1[1]); w.w = cvt_pk_bf16(o1[2], o1[3]);
                __builtin_nontemporal_store(w, (v4u*)rowp);
            }
        }
    }
};

struct EpiNull {
    static constexpr bool PERM = true; static constexpr int NEPI = 0, NVM = 0;
    __device__ __forceinline__ bool fused() const { return false; }
    __device__ __forceinline__ void stage(const Unit&, LAS unsigned char*, int, int, int) const {}
    __device__ __forceinline__ void operator()(const f32x4 (&acc)[2][2][4][2], const Unit&, int, int, int, int, const LAS unsigned char*) const {
#pragma unroll
        for (int a = 0; a < 2; ++a)
#pragma unroll
            for (int b = 0; b < 2; ++b)
#pragma unroll
                for (int m = 0; m < 4; ++m)
#pragma unroll
                    for (int n = 0; n < 2; ++n) asm volatile("" :: "v"(acc[a][b][m][n]));
    }
};

template <bool HB> struct EpiRes {
    static constexpr bool PERM = true;
    const void* base_p; const void* base_s; bf16_t* out; const float* gate; const float* bias; const float* cs; float* slab; bf16_t* an; const float* ng_n; const float* sc_n; float* ss; float alpha; int base_f32;
    static constexpr int NEPI = 0, NVM = 0;
    __device__ __forceinline__ bool fused() const { return false; }
    __device__ __forceinline__ void stage(const Unit&, LAS unsigned char*, int, int, int) const {}
    __device__ __forceinline__ void operator()(const f32x4 (&acc)[2][2][4][2], const Unit& u, int wr, int wc, int fr, int fq, const LAS unsigned char*) const {
        const int col0 = u.pn * BM + wc * 32 + 8 * fq;
#pragma unroll
        for (int ai = 0; ai < 2; ++ai) {
            const int rbase = u.pm * BM + ai * HALF + wr * 64;
            const int s = stream_of_row(rbase);
            float q[4] = {0.f, 0.f, 0.f, 0.f};
            v4u bw8[2][4];
            if (u.slab < 0 && !base_f32) {
                const bf16_t* bp = (const bf16_t*)((rbase < NPR) ? base_p : base_s) + ((rbase < NPR) ? (size_t)(rbase + fr) : (size_t)(rbase + fr - NPR)) * D + col0;
#pragma unroll
                for (int bj = 0; bj < 2; ++bj)
#pragma unroll
                    for (int m = 0; m < 4; ++m) bw8[bj][m] = *(const v4u*)(bp + (size_t)m * 16 * D + bj * HALF);
            } else {
#pragma unroll
                for (int bj = 0; bj < 2; ++bj)
#pragma unroll
                    for (int m = 0; m < 4; ++m) bw8[bj][m] = (v4u){0u, 0u, 0u, 0u}; }
#pragma unroll
            for (int bj = 0; bj < 2; ++bj) {
                const int c = col0 + bj * HALF;
                f32x4 gv[2], bv[2], gn[2];
#pragma unroll
                for (int n = 0; n < 2; ++n) { gv[n] = *(const f32x4*)(gate + (size_t)s * MODS + c + 4 * n) * alpha; bv[n] = (f32x4){0.f, 0.f, 0.f, 0.f}; gn[n] = bv[n];
                    if (HB) { gv[n] = gv[n] * *(const f32x4*)(cs + c + 4 * n); bv[n] = *(const f32x4*)(bias + c + 4 * n); }
                    if (an) gn[n] = *(const f32x4*)(ng_n + c + 4 * n) * (*(const f32x4*)(sc_n + (size_t)s * MODS + c + 4 * n) + 1.0f); }
#pragma unroll
                for (int mh = 0; mh < 2; ++mh) {
                f32x4 bf4[2][2];
                if (u.slab < 0 && base_f32) {
                    const float* bp = (const float*)((rbase < NPR) ? base_p : base_s) + ((rbase < NPR) ? (size_t)(rbase + fr) : (size_t)(rbase + fr - NPR)) * D + c;
#pragma unroll
                    for (int mm = 0; mm < 2; ++mm) { bf4[mm][0] = *(const f32x4*)(bp + (size_t)(2 * mh + mm) * 16 * D); bf4[mm][1] = *(const f32x4*)(bp + (size_t)(2 * mh + mm) * 16 * D + 4); }
                } else {
#pragma unroll
                    for (int mm = 0; mm < 2; ++mm) { bf4[mm][0] = (f32x4){0.f, 0.f, 0.f, 0.f}; bf4[mm][1] = bf4[mm][0]; } }
#pragma unroll
                for (int mm = 0; mm < 2; ++mm) { const int m = 2 * mh + mm;
                    const int r = rbase + m * 16 + fr;
                    if (u.slab >= 0) {
                        float* sp = slab + ((size_t)u.slab * NSR + (size_t)(r - NPR)) * D + c;
                        *(f32x4*)sp = gv[0] * (HB ? acc[ai][bj][m][0] + bv[0] : acc[ai][bj][m][0]); *(f32x4*)(sp + 4) = gv[1] * (HB ? acc[ai][bj][m][1] + bv[1] : acc[ai][bj][m][1]);
                    } else {
                        const size_t boff = ((rbase < NPR) ? (size_t)r : (size_t)(r - NPR)) * D + c; const void* bb = (rbase < NPR) ? base_p : base_s;
                        f32x4 b0, b1;
                        if (base_f32) { b0 = bf4[mm][0]; b1 = bf4[mm][1]; }
                        else { const v4u bw = bw8[bj][m]; b0 = (f32x4){bflo(bw.x), bfhi(bw.x), bflo(bw.y), bfhi(bw.y)}; b1 = (f32x4){bflo(bw.z), bfhi(bw.z), bflo(bw.w), bfhi(bw.w)}; }
                        const f32x4 o0 = b0 + gv[0] * (HB ? acc[ai][bj][m][0] + bv[0] : acc[ai][bj][m][0]), o1 = b1 + gv[1] * (HB ? acc[ai][bj][m][1] + bv[1] : acc[ai][bj][m][1]);
                        { v4u ow; ow.x = cvt_pk_bf16(o0[0], o0[1]); ow.y = cvt_pk_bf16(o0[2], o0[3]); ow.z = cvt_pk_bf16(o1[0], o1[1]); ow.w = cvt_pk_bf16(o1[2], o1[3]); *(v4u*)(out + (size_t)r * D + c) = ow; }
                        if (ss) { const f32x4 sq = o0 * o0 + o1 * o1; q[m] += (sq[0] + sq[1]) + (sq[2] + sq[3]); }
                        if (an) { const f32x4 t0 = o0 * gn[0], t1 = o1 * gn[1]; v4u w; w.x = cvt_pk_bf16(t0[0], t0[1]); w.y = cvt_pk_bf16(t0[2], t0[3]); w.z = cvt_pk_bf16(t1[0], t1[1]); w.w = cvt_pk_bf16(t1[2], t1[3]);
                            *(v4u*)(an + (size_t)r * D + c) = w; }
                    }
                }
                }
            }
            if (ss && u.slab < 0) {
#pragma unroll
                for (int m = 0; m < 4; ++m) { float t = q[m]; t += __shfl_xor(t, 16); t += __shfl_xor(t, 32); if (fq == 0) ss[(size_t)(rbase + m * 16 + fr) * 32 + u.pn * 4 + wc] = t; } }
        }
    }
};

struct EpiInProj {
    static constexpr bool PERM = true;
    bf16_t *U, *V, *GLU; float* vstat; float* ncp; float* ncs; const float* ss; const float* sb;
    static constexpr int NEPI = 4, NVM = 8;
    __device__ __forceinline__ bool fused() const { return true; }
    __device__ __forceinline__ void stage(const Unit& u, LAS unsigned char* area, int wr, int wc, int lane) const {
        const int rb0 = u.pm * BM + wr * 64, rb1 = rb0 + HALF, wrow = u.pn * BM + wc * 32 + (lane & 31) + (lane >> 5) * HALF;
        __builtin_amdgcn_global_load_lds((const unsigned*)(ss + rb0 + lane), (LAS unsigned*)(area), 4, 0, 0);
        __builtin_amdgcn_global_load_lds((const unsigned*)(ss + rb1 + lane), (LAS unsigned*)(area + 256), 4, 0, 0);
        __builtin_amdgcn_global_load_lds((const unsigned*)(sb + (size_t)stream_of_row(rb0) * 4096 + wrow), (LAS unsigned*)(area + 512), 4, 0, 0);
        __builtin_amdgcn_global_load_lds((const unsigned*)(sb + (size_t)stream_of_row(rb1) * 4096 + wrow), (LAS unsigned*)(area + 768), 4, 0, 0);
    }
    __device__ __forceinline__ void operator()(const f32x4 (&acc)[2][2][4][2], const Unit& u, int wr, int wc, int fr, int fq, const LAS unsigned char* area) const {
        const int row0 = u.pm * BM + wr * 64 + fr;
        if (u.pn < 8) {
            const bool isv = u.pn >= 4; bf16_t* O = isv ? V : U; const int col0 = (u.pn & 3) * BM + wc * 32 + 8 * fq;
#pragma unroll
            for (int ai = 0; ai < 2; ++ai) {
                const LAS float* sp = (const LAS float*)(area + 512 + ai * 256) + 8 * fq;
                f32x4 sv[2][2];
#pragma unroll
                for (int bj = 0; bj < 2; ++bj) { sv[bj][0] = *(const LAS f32x4*)(sp + bj * 32); sv[bj][1] = *(const LAS f32x4*)(sp + bj * 32 + 4); }
#pragma unroll
                for (int m = 0; m < 4; ++m) { const int r = row0 + ai * HALF + m * 16; float s1 = 0.f, s2 = 0.f;
                    const float rstd = __builtin_amdgcn_rsqf(((const LAS float*)(area + ai * 256))[m * 16 + fr] * (1.0f / D) + EPS);
#pragma unroll
                    for (int bj = 0; bj < 2; ++bj) { f32x4 v0 = acc[ai][bj][m][0] * rstd + sv[bj][0], v1 = acc[ai][bj][m][1] * rstd + sv[bj][1];
#pragma unroll
                        for (int j = 0; j < 4; ++j) { v0[j] = gelu_tanh(v0[j]); v1[j] = gelu_tanh(v1[j]); s1 += v0[j] + v1[j]; s2 += v0[j] * v0[j] + v1[j] * v1[j]; }
                        v4u w; w.x = cvt_pk_bf16(v0[0], v0[1]); w.y = cvt_pk_bf16(v0[2], v0[3]); w.z = cvt_pk_bf16(v1[0], v1[1]); w.w = cvt_pk_bf16(v1[2], v1[3]);
                        *(v4u*)(O + (size_t)r * AW + col0 + bj * HALF) = w; }
                    if (isv) { s1 += __shfl_xor(s1, 16); s1 += __shfl_xor(s1, 32); s2 += __shfl_xor(s2, 16); s2 += __shfl_xor(s2, 32);
                        if (fq == 0) *(f32x2*)(vstat + ((size_t)r * 16 + (u.pn - 4) * 4 + wc) * 2) = (f32x2){s1, s2}; }
                }
            }
        } else {
            const int col0 = (u.pn - 8) * HALF + wc * 32 + 8 * fq;
#pragma unroll
            for (int ai = 0; ai < 2; ++ai) {
                const int rbase = u.pm * BM + ai * HALF + wr * 64;
                const bool tailp = (rbase < NPR) && ((rbase & 8191) == 8128), tails = rbase >= NPR;
                const LAS float* sp = (const LAS float*)(area + 512 + ai * 256) + 8 * fq;
                const f32x4 sa0 = *(const LAS f32x4*)sp, sa1 = *(const LAS f32x4*)(sp + 4), sg0 = *(const LAS f32x4*)(sp + 32), sg1 = *(const LAS f32x4*)(sp + 36);
#pragma unroll
                for (int m = 0; m < 4; ++m) { const int r = rbase + m * 16 + fr;
                    const float rstd = __builtin_amdgcn_rsqf(((const LAS float*)(area + ai * 256))[m * 16 + fr] * (1.0f / D) + EPS);
                    const f32x4 a0 = acc[ai][0][m][0] * rstd + sa0, a1 = acc[ai][0][m][1] * rstd + sa1, g0 = acc[ai][1][m][0] * rstd + sg0, g1 = acc[ai][1][m][1] * rstd + sg1;
                    f32x4 o0, o1;
#pragma unroll
                    for (int j = 0; j < 4; ++j) { o0[j] = a0[j] * sigmoidf_(g0[j]); o1[j] = a1[j] * sigmoidf_(g1[j]); }
                    v4u w; w.x = cvt_pk_bf16(o0[0], o0[1]); w.y = cvt_pk_bf16(o0[2], o0[3]); w.z = cvt_pk_bf16(o1[0], o1[1]); w.w = cvt_pk_bf16(o1[2], o1[3]);
                    *(v4u*)(GLU + (size_t)r * AW + col0) = w;
                    if (tailp) { const int t = r & 8191; if (t >= 8162) { float* dst = ncp + ((size_t)((r >> 13) * 30 + (t - 8162)) * 1024 + col0); *(f32x4*)dst = o0; *(f32x4*)(dst + 4) = o1; } }
                    if (tails) { const int rr = r - NPR, t = rr & 63; if (t >= 34) { float* dst = ncs + ((size_t)((rr >> 6) * 30 + (t - 34)) * 1024 + col0); *(f32x4*)dst = o0; *(f32x4*)(dst + 4) = o1; } }
                }
            }
        }
    }
};

template <int NR> __device__ __forceinline__ void wait_vm_sel(int sel) { asm volatile("v_cmp_ne_u32_e32 vcc, 0, %0\n\ts_nop 4\n\ts_cbranch_vccz 1f\n\ts_waitcnt vmcnt(%1)\n\ts_branch 2f\n1:\n\ts_waitcnt vmcnt(8)\n2:" :: "v"(sel), "n"(NR) : "memory", "vcc"); }
template <class Epi, bool ALIGN_EPI>
__device__ __forceinline__ void gemm_phase(LAS unsigned char* lds, const Gemm g, const StaticOrder& S, const Epi& E, unsigned stagger_ticks = 0u) {
    int tid_ = threadIdx.x; asm volatile("" : "+v"(tid_));
    const int tid = tid_, wid = __builtin_amdgcn_readfirstlane(tid >> 6), lane = tid & 63, wr = wid >> 2, wc = wid & 3, fr = lane & 15, fq = lane >> 4;
    const int K = g.K;
    unsigned voffA[2], voffB[2];
#pragma unroll
    for (int i = 0; i < 2; ++i) { int R, C; stage_rc(tid * 16 + i * 8192, R, C); const int Rb = Epi::PERM ? ((R & ~31) + perm32(R & 31)) : R;
        voffA[i] = (unsigned)(R * g.lda + C) * 2u; voffB[i] = (unsigned)(Rb * K + C) * 2u; }
    const size_t kstep = (size_t)(BK * 2);
    const size_t hA = (size_t)HALF * g.lda * 2, hB = (size_t)HALF * K * 2;
    const size_t tA = 2 * hA, tB = 2 * hB;
    const unsigned ldsw = (unsigned)wid * 1024u;
    const int aoff = lds_byte(wr * 64 + fr, fq * 8), boff = lds_byte(wc * 32 + fr, fq * 8);
#define PG8_SA(b, h) (((b) * 2 + (h)) * HTB)
#define PG8_SB(b, h) ((4 + (b) * 2 + (h)) * HTB)
#define PG8_STAGE(bufoff, gbase, voff) do { _Pragma("unroll") for (int _i = 0; _i < 2; ++_i) \
        __builtin_amdgcn_global_load_lds((const unsigned*)((const char*)(gbase) + (voff)[_i]), (LAS unsigned*)(lds + (bufoff) + ldsw + _i * 8192), 16, 0, 0); } while (0)
#define PG8_LDA(dst, b, h) do { _Pragma("unroll") for (int m = 0; m < 4; ++m) _Pragma("unroll") for (int k = 0; k < 2; ++k) dst[m][k] = *(const LAS bf16x8*)(lds + PG8_SA(b, h) + aoff + m * 2048 + k * 1024); } while (0)
#define PG8_LDB(dst, b, h) do { _Pragma("unroll") for (int n = 0; n < 2; ++n) _Pragma("unroll") for (int k = 0; k < 2; ++k) dst[n][k] = *(const LAS bf16x8*)(lds + PG8_SB(b, h) + boff + n * 2048 + k * 1024); } while (0)
#define PG8_MMA(ai, bj, At, Bt) do { __builtin_amdgcn_s_setprio(1); _Pragma("unroll") for (int m = 0; m < 4; ++m) _Pragma("unroll") for (int n = 0; n < 2; ++n) _Pragma("unroll") for (int k = 0; k < 2; ++k) \
        acc[ai][bj][m][n] = __builtin_amdgcn_mfma_f32_16x16x32_bf16(Bt[n][k], At[m][k], acc[ai][bj][m][n], 0, 0, 0); __builtin_amdgcn_s_setprio(0); } while (0)
#define PG8_WAIT_V(n) asm volatile("s_waitcnt vmcnt(" #n ")" ::: "memory")
#define PG8_WAIT_L(n) asm volatile("s_waitcnt lgkmcnt(" #n ")" ::: "memory")
#define PG8_BAR __builtin_amdgcn_s_barrier()
#define PG8_SCHED __builtin_amdgcn_sched_barrier(0)
#define PG8_APTR(u) ((const char*)g.A + (size_t)(u).pm * tA + (g.tpg ? (size_t)((u).pn / g.tpg) * (size_t)K * 2 : (size_t)0) + (size_t)(u).kt0 * kstep)
#define PG8_BPTR(u) ((const char*)g.Bt + (size_t)(u).pn * tB + (size_t)(u).kt0 * kstep)
    Unit cur, nxt; int ui = 0;
    if (!S.next(0, cur)) return;
    if (stagger_ticks) { const unsigned long long t0 = __builtin_amdgcn_s_memrealtime(); while (__builtin_amdgcn_s_memrealtime() - t0 < (unsigned long long)stagger_ticks) __builtin_amdgcn_s_sleep(16); }
    f32x4 acc[2][2][4][2];
#pragma unroll
    for (int a = 0; a < 2; ++a)
#pragma unroll
        for (int b = 0; b < 2; ++b)
#pragma unroll
            for (int m = 0; m < 4; ++m)
#pragma unroll
                for (int n = 0; n < 2; ++n) acc[a][b][m][n] = (f32x4){0.f, 0.f, 0.f, 0.f};
    bf16x8 At[4][2], B0[2][2], B1[2][2];
    const char* cA = PG8_APTR(cur); const char* cB = PG8_BPTR(cur);
    LAS unsigned char* area = lds + EPI_OFF + wid * 1024;
    const bool epi_dma = Epi::NEPI > 0 && E.fused();
    if (epi_dma) E.stage(cur, area, wr, wc, lane);
    PG8_STAGE(PG8_SB(0, 0), cB, voffB); PG8_STAGE(PG8_SB(0, 1), cB + hB, voffB); PG8_STAGE(PG8_SA(0, 0), cA, voffA); PG8_STAGE(PG8_SA(0, 1), cA + hA, voffA);
    if (wr == 1) PG8_BAR;
    PG8_WAIT_V(2); PG8_BAR;
    PG8_STAGE(PG8_SB(1, 0), cB + kstep, voffB); PG8_STAGE(PG8_SA(1, 0), cA + kstep, voffA); PG8_STAGE(PG8_SB(1, 1), cB + hB + kstep, voffB);
    PG8_WAIT_V(6); PG8_BAR;
    for (;;) {
        const bool has_next = S.next(ui + 1, nxt);
        const char* nA = has_next ? PG8_APTR(nxt) : cA; const char* nB = has_next ? PG8_BPTR(nxt) : cB;
        const int nt = cur.ktn;
        for (int t = 0; t < nt; t += 2) {
            const bool last = (t == nt - 2);
            const char* a1 = cA + (size_t)(t + 1) * kstep;
            const char* a2 = last ? nA : cA + (size_t)(t + 2) * kstep; const char* b2 = last ? nB : cB + (size_t)(t + 2) * kstep;
            const char* a3 = a2 + kstep; const char* b3 = b2 + kstep;
            const int first = (t == 0 && ui > 0 && epi_dma) ? 1 : 0;
            PG8_LDB(B0, 0, 0); PG8_LDB(B1, 0, 1); PG8_SCHED; PG8_LDA(At, 0, 0); PG8_STAGE(PG8_SA(1, 1), a1 + hA, voffA);
            wait_vm_sel<8 + Epi::NEPI + Epi::NVM>(first); PG8_WAIT_L(0); PG8_BAR; PG8_MMA(0, 0, At, B0); PG8_MMA(0, 1, At, B1); PG8_BAR; PG8_SCHED;
            PG8_LDA(At, 0, 1); PG8_STAGE(PG8_SB(0, 0), b2, voffB); PG8_STAGE(PG8_SB(0, 1), b2 + hB, voffB); PG8_STAGE(PG8_SA(0, 0), a2, voffA);
            wait_vm_sel<8 + Epi::NEPI + Epi::NVM>(first); PG8_WAIT_L(0); PG8_BAR; PG8_MMA(1, 0, At, B0); PG8_MMA(1, 1, At, B1); PG8_BAR; PG8_SCHED;
            PG8_LDB(B0, 1, 0); PG8_LDB(B1, 1, 1); PG8_SCHED; PG8_LDA(At, 1, 0); PG8_STAGE(PG8_SA(0, 1), a2 + hA, voffA);
            PG8_WAIT_V(8); PG8_WAIT_L(0); PG8_BAR; PG8_MMA(0, 0, At, B0); PG8_MMA(0, 1, At, B1); PG8_BAR; PG8_SCHED;
            PG8_LDA(At, 1, 1); PG8_STAGE(PG8_SB(1, 0), b3, voffB); PG8_STAGE(PG8_SB(1, 1), b3 + hB, voffB); PG8_STAGE(PG8_SA(1, 0), a3, voffA);
            PG8_WAIT_V(8); PG8_WAIT_L(0); PG8_BAR; PG8_MMA(1, 0, At, B0); PG8_MMA(1, 1, At, B1); PG8_BAR; PG8_SCHED;
        }
        if constexpr (ALIGN_EPI) { if (wr == 0) PG8_BAR; }
        E(acc, cur, wr, wc, fr, fq, area);
        if (!has_next) break;
        if (epi_dma) E.stage(nxt, area, wr, wc, lane);
#pragma unroll
        for (int a = 0; a < 2; ++a)
#pragma unroll
            for (int b = 0; b < 2; ++b)
#pragma unroll
                for (int m = 0; m < 4; ++m)
#pragma unroll
                    for (int n = 0; n < 2; ++n) acc[a][b][m][n] = (f32x4){0.f, 0.f, 0.f, 0.f};
        cur = nxt; cA = nA; cB = nB; ++ui;
        if constexpr (ALIGN_EPI) { if (wr == 1) PG8_BAR; }
    }
    PG8_WAIT_V(0);
    if constexpr (!ALIGN_EPI) { if (wr == 0) PG8_BAR; }
    PG8_BAR;
#undef PG8_SA
#undef PG8_SB
#undef PG8_STAGE
#undef PG8_LDA
#undef PG8_LDB
#undef PG8_MMA
#undef PG8_WAIT_V
#undef PG8_WAIT_L
#undef PG8_BAR
#undef PG8_SCHED
#undef PG8_APTR
#undef PG8_BPTR
}
}

#define XB_TMO      128
#define XB_XCNT(j)  (256  + 64 * (j))
#define XB_XSUB(j)  (1280 + 64 * (j))
#define XB_XGEN(j)  (2304 + 64 * (j))
#define XB_TOP      3328
#define XB_TOPGEN   3392
#define XCD_BAR_WORDS 3456
#define XB_SPIN_CAP (1u << 18)
__device__ __forceinline__ unsigned xb_ld(unsigned* p)              { return __hip_atomic_load(p, __ATOMIC_RELAXED, __HIP_MEMORY_SCOPE_AGENT); }
__device__ __forceinline__ unsigned xb_add(unsigned* p, unsigned v) { return __hip_atomic_fetch_add(p, v, __ATOMIC_RELAXED, __HIP_MEMORY_SCOPE_AGENT); }
__device__ __forceinline__ unsigned xb_xcc_id() { return (unsigned)__builtin_amdgcn_s_getreg((3 << 11) | 20) & 0xFu; }
#define XB_SPIN(cond, bar) do { unsigned _sp = 0; while (cond) { __builtin_amdgcn_s_sleep(1); \
    if ((++_sp & 255u) == 0u) { if (xb_ld(&(bar)[XB_TMO])) break; if (_sp > XB_SPIN_CAP) { atomicAdd(&(bar)[XB_TMO], 1u); break; } } } } while (0)
struct XcdBarrier { unsigned* bar; unsigned x; volatile LAS unsigned* st; };
__device__ __forceinline__ XcdBarrier xcd_barrier_post(unsigned* bar, volatile LAS unsigned* st) {
    XcdBarrier b; b.bar = bar; b.x = xb_xcc_id(); b.st = st;
    if (threadIdx.x == 0) (void)xb_add(&bar[XB_XCNT(b.x)], 1u);
    return b;
}
__device__ __forceinline__ void xcd_barrier_complete(unsigned* bar, unsigned x, unsigned& nloc, unsigned& nx) {
    const unsigned G = gridDim.x * gridDim.y * gridDim.z;
    unsigned sum, cnt, mine, sp = 0u;
    for (;;) {
        sum = 0u; cnt = 0u; mine = 0u;
#pragma unroll
        for (unsigned j = 0; j < 16; ++j) { const unsigned c = xb_ld(&bar[XB_XCNT(j)]); sum += c; cnt += (c > 0u) ? 1u : 0u; mine = (j == x) ? c : mine; }
        if (sum == G) break;
        __builtin_amdgcn_s_sleep(1);
        if ((++sp & 255u) == 0u) { if (xb_ld(&bar[XB_TMO])) break; if (sp > XB_SPIN_CAP) { atomicAdd(&bar[XB_TMO], 1u); break; } }
    }
    nloc = mine > 0u ? mine : 1u; nx = cnt > 0u ? cnt : 1u;
}
__device__ __forceinline__ void xcd_barrier(const XcdBarrier& b) {
    asm volatile("s_waitcnt vmcnt(0)" ::: "memory");
    __syncthreads();
    if (threadIdx.x == 0) {
        unsigned* bar = b.bar;
        __builtin_amdgcn_s_waitcnt(0);
        unsigned nloc = b.st[0], nx = b.st[1];
        if (nloc == 0u) { xcd_barrier_complete(bar, b.x, nloc, nx); b.st[0] = nloc; b.st[1] = nx; }
        const unsigned old = xb_add(&bar[XB_XSUB(b.x)], 1u);
        const unsigned gen = old / nloc;
        if (old + 1u == (gen + 1u) * nloc) {
            __builtin_amdgcn_fence(__ATOMIC_RELEASE, "agent");
            asm volatile("s_waitcnt vmcnt(0)" ::: "memory");
            const unsigned og = xb_add(&bar[XB_TOP], 1u);
            const unsigned tg = og / nx;
            if (og + 1u == (tg + 1u) * nx) xb_add(&bar[XB_TOPGEN], 1u);
            else XB_SPIN(xb_ld(&bar[XB_TOPGEN]) == tg, bar);
            __builtin_amdgcn_fence(__ATOMIC_ACQUIRE, "agent");
            xb_add(&bar[XB_XGEN(b.x)], 1u);
            asm volatile("s_waitcnt vmcnt(0)" ::: "memory");
        } else {
            XB_SPIN(xb_ld(&bar[XB_XGEN(b.x)]) == gen, bar);
            __builtin_amdgcn_fence(__ATOMIC_ACQUIRE, "agent");
            asm volatile("s_waitcnt vmcnt(0)" ::: "memory");
        }
    }
    __syncthreads();
}

struct Args { const float* in[25]; float* out; unsigned char* ws; int ph_lo, ph_hi; };
typedef const __attribute__((address_space(4))) Args* CArgsP;
enum { I_XP = 0, I_XS, I_CP, I_CS, I_SCONV, I_SPOOL, I_ADAW, I_ADAB, I_NORMG, I_FNORMG, I_WG, I_WU, I_WD, I_WIN, I_AVG, I_AVB, I_AWS, I_ABS, I_BDW, I_BLNG, I_BLNB, I_WOUT, I_CW, I_CB, I_CSC };

__device__ __forceinline__ void p0_transpose_item(const float* W, int K, int N, bf16* WT, int dest0, LAS float* scr, int k0, int n0, int lane) {
    float v[32];
#pragma unroll
    for (int i = 0; i < 32; ++i) v[i] = __builtin_nontemporal_load(W + (size_t)(k0 + 2 * i + (lane >> 5)) * N + n0 + (lane & 31));
#pragma unroll
    for (int i = 0; i < 32; ++i) scr[(2 * i + (lane >> 5)) * 33 + (lane & 31)] = v[i];
    LDS_WAIT(); asm volatile("" ::: "memory");
    const int c = lane & 7;
#pragma unroll
    for (int j = 0; j < 4; ++j) { const int n = (lane >> 3) + 8 * j; const LAS float* s = scr + (8 * c) * 33 + n;
        v4u o; o.x = pk2(s[0 * 33], s[1 * 33]); o.y = pk2(s[2 * 33], s[3 * 33]); o.z = pk2(s[4 * 33], s[5 * 33]); o.w = pk2(s[6 * 33], s[7 * 33]);
        __builtin_nontemporal_store(o, (v4u*)(WT + (size_t)(dest0 + n) * K + k0 + 8 * c)); }
    LDS_WAIT(); asm volatile("" ::: "memory");
}
__device__ __forceinline__ void p0_ada_item(CArgsP a, float* mod, LAS float* scr, int idx, int lane) {
    const int ks = idx & 15, cb = (idx >> 4) % 72, l = idx / (16 * 72), k0 = ks * 128, n = cb * 256 + 4 * lane;
#pragma unroll
    for (int s = 0; s < NSTREAM; ++s)
#pragma unroll
        for (int h = 0; h < 2; ++h) { const int k = lane + 64 * h; const float cv = (s < 4) ? a->in[I_CP][s * D + k0 + k] : a->in[I_CS][(s - 4) * D + k0 + k]; scr[s * 128 + k] = siluf_(cv); }
    LDS_WAIT(); asm volatile("" ::: "memory");
    f32x4 acc[NSTREAM];
#pragma unroll
    for (int s = 0; s < NSTREAM; ++s) acc[s] = (f32x4){0.f, 0.f, 0.f, 0.f};
    const float* Wp = a->in[I_ADAW] + ((size_t)l * D + k0) * MODS + n;
    f32x4 wb[8], wn[8];
#pragma unroll
    for (int i = 0; i < 8; ++i) { wb[i] = *(const f32x4*)(Wp + (size_t)i * MODS); wn[i] = wb[i]; }
#pragma unroll 1
    for (int kb = 0; kb < 128; kb += 8) {
        if (kb + 8 < 128) {
#pragma unroll
            for (int i = 0; i < 8; ++i) wn[i] = *(const f32x4*)(Wp + (size_t)(kb + 8 + i) * MODS); }
#pragma unroll
        for (int i = 0; i < 8; ++i)
#pragma unroll
            for (int s = 0; s < NSTREAM; ++s) acc[s] += wb[i] * scr[s * 128 + kb + i];
#pragma unroll
        for (int i = 0; i < 8; ++i) wb[i] = wn[i];
    }
    if (ks == 0) { const f32x4 b = *(const f32x4*)(a->in[I_ADAB] + (size_t)l * MODS + n);
#pragma unroll
        for (int s = 0; s < NSTREAM; ++s) acc[s] += b; }
#pragma unroll
    for (int s = 0; s < NSTREAM; ++s) *(f32x4*)(mod + (size_t)ks * (2 * MODL) + (size_t)l * MODL + (size_t)s * MODS + n) = acc[s];
    LDS_WAIT(); asm volatile("" ::: "memory");
}
constexpr int P0_ADA = 2 * 72 * 16, P0_GU = 5632, P0_WD = 5632, P0_WIN = 4096, P0_WOUT = 2048, P0_WC = 128, P0_WM = 16;
constexpr int P0_TR = 2 * P0_GU + P0_WD + P0_WIN + P0_WOUT + 4 * P0_WC, P0_TOTAL = P0_ADA + P0_TR + P0_WM;
__device__ __forceinline__ void conv_gu_item(CArgsP a, unsigned char* ws, LAS float* scr, int f, int r, int lane) {
    const int up = r >= P0_GU, i2 = up ? r - P0_GU : r, kb = i2 / 176, nb = i2 % 176, n0 = 32 * nb;
    p0_transpose_item(a->in[up ? I_WU : I_WG] + (size_t)f * D * DFF, D, DFF, (bf16*)(ws + WS_WGU) + (size_t)f * 11264 * 2048, 256 * (n0 >> 7) + (n0 & 127) + (up ? 128 : 0), scr, 64 * kb, n0, lane);
}
__device__ __forceinline__ void conv_wd_item(CArgsP a, unsigned char* ws, LAS float* scr, int f, int r, int lane) {
    const int kb = r / 64, nb = r % 64;
    p0_transpose_item(a->in[I_WD] + (size_t)f * DFF * D, DFF, D, (bf16*)(ws + WS_WD) + (size_t)f * 2048 * 5632, 32 * nb, scr, 64 * kb, 32 * nb, lane);
}
__device__ __forceinline__ void conv_window(CArgsP a, LAS unsigned char* lds, int fgu, int fwd0, int fwd1, int rank, int nrank, int wave, int lane) {
    __syncthreads();
    LAS float* scr = (LAS float*)(lds + wave * 16384); unsigned char* ws = a->ws;
    const int ngu = fgu >= 0 ? 2 * P0_GU : 0, n1 = fwd0 >= 0 ? P0_WD : 0, n2 = fwd1 >= 0 ? P0_WD : 0;
#pragma unroll 1
    for (int it = rank * NWAVES + wave; it < ngu + n1 + n2; it += nrank * NWAVES) {
        if (it < ngu) conv_gu_item(a, ws, scr, fgu, it, lane);
        else if (it < ngu + n1) conv_wd_item(a, ws, scr, fwd0, it - ngu, lane);
        else conv_wd_item(a, ws, scr, fwd1, it - ngu - n1, lane);
    }
}
__device__ __forceinline__ void p0_prologue(CArgsP a, LAS unsigned char* lds, int gw, int NGW, int wave, int lane) {
    LAS float* scr = (LAS float*)(lds + wave * 16384);
    unsigned char* ws = a->ws;
    const int gwp = wave * (NGW / NWAVES) + gw / NWAVES, heavy = P0_ADA - NGW;
    p0_ada_item(a, (float*)(ws + WS_MODP), scr, gwp, lane);
    if (gwp < heavy) { p0_ada_item(a, (float*)(ws + WS_MODP), scr, NGW + gwp, lane); return; }
    for (int r0 = gwp - heavy; r0 < P0_TR + P0_WM; r0 += NGW - heavy) {
        int r = r0;
        if (r < 2 * P0_GU) { conv_gu_item(a, ws, scr, 0, r, lane); continue; }
        r -= 2 * P0_GU;
        if (r < P0_WD) { conv_wd_item(a, ws, scr, 0, r, lane); continue; }
        r -= P0_WD;
        if (r < P0_WIN) { const int kb = r / 128, nb = r % 128, n0 = 32 * nb; int d0;
            if (n0 < 2048) d0 = n0; else if (n0 < 3072) { const int j = n0 - 2048; d0 = 2048 + 256 * (j >> 7) + (j & 127); } else { const int j = n0 - 3072; d0 = 2048 + 256 * (j >> 7) + 128 + (j & 127); }
            p0_transpose_item(a->in[I_WIN], D, 4096, (bf16*)(ws + WS_WIN), d0, scr, 64 * kb, n0, lane); continue; }
        r -= P0_WIN;
        if (r < P0_WOUT) { const int kb = r / 64, nb = r % 64; p0_transpose_item(a->in[I_WOUT], D, D, (bf16*)(ws + WS_WOUT), 32 * nb, scr, 64 * kb, 32 * nb, lane); continue; }
        r -= P0_WOUT;
        if (r < 4 * P0_WC) { const int g = r / P0_WC, i2 = r % P0_WC, kb = i2 / 16, nb = i2 % 16;
            p0_transpose_item(a->in[I_CW] + (size_t)g * 512 * 512, 512, 512, (bf16*)(ws + WS_WC), g * 512 + 32 * nb, scr, 64 * kb, 32 * nb, lane); continue; }
        r -= 4 * P0_WC;
        { bf16* wm = (bf16*)(ws + WS_WM);
#pragma unroll 4
          for (int i = 0; i < 64; ++i) { const int idx = r * 4096 + i * 64 + lane, ii = (idx >> 7) & 127, jj = idx & 127; const float v = a->in[I_AWS][idx]; wm[idx] = (bf16)(((jj >> 6) <= (ii >> 6)) ? f2bf(v) : 0u); } }
    }
}

__device__ __forceinline__ void thin_norm(const float* hp, const float* hs, const float* ng, const float* shift, const float* scale, bf16* HN, int gw, int NGW, int lane) {
    const int r0 = (int)(((long)gw * M) / NGW), r1 = (int)(((long)(gw + 1) * M) / NGW);
    int cur_s = -1; f32x4 gs[8], sh[8], v[8], vn[8];
#pragma unroll
    for (int j = 0; j < 8; ++j) { gs[j] = (f32x4){0.f, 0.f, 0.f, 0.f}; sh[j] = gs[j]; v[j] = gs[j]; vn[j] = gs[j]; }
    if (r0 < r1) { const float* xr = (r0 < NPR) ? hp + (size_t)r0 * D : hs + (size_t)(r0 - NPR) * D;
#pragma unroll
        for (int j = 0; j < 8; ++j) v[j] = *(const f32x4*)(xr + 4 * lane + 256 * j); }
    for (int r = r0; r < r1; ++r) {
        if (r + 1 < r1) { const int rn = r + 1; const float* xr = (rn < NPR) ? hp + (size_t)rn * D : hs + (size_t)(rn - NPR) * D;
#pragma unroll
            for (int j = 0; j < 8; ++j) vn[j] = *(const f32x4*)(xr + 4 * lane + 256 * j); }
        const int s = stream_of_row(r);
        if (s != cur_s) { cur_s = s;
#pragma unroll
            for (int j = 0; j < 8; ++j) { const int c = 4 * lane + 256 * j; gs[j] = *(const f32x4*)(ng + c) * (*(const f32x4*)(scale + (size_t)s * MODS + c) + 1.0f); sh[j] = *(const f32x4*)(shift + (size_t)s * MODS + c); } }
        float ss = 0.f;
#pragma unroll
        for (int j = 0; j < 8; ++j) ss += (v[j].x * v[j].x + v[j].y * v[j].y) + (v[j].z * v[j].z + v[j].w * v[j].w);
        const float rstd = rsqrtf(wave_sum(ss) * (1.0f / D) + EPS);
        bf16* orow = HN + (size_t)r * D;
#pragma unroll
        for (int j = 0; j < 8; ++j) { const f32x4 o = v[j] * rstd * gs[j] + sh[j]; v2u w; w.x = pk2(o.x, o.y); w.y = pk2(o.z, o.w); *(v2u*)(orow + 4 * lane + 256 * j) = w; }
#pragma unroll
        for (int j = 0; j < 8; ++j) v[j] = vn[j];
    }
}
__device__ __forceinline__ void final_norm(const bf16* h, float* yo, const float* ng, int r0, int r1, int lane) {
    f32x4 gs[8]; v2u w[8], wn[8];
#pragma unroll
    for (int j = 0; j < 8; ++j) { gs[j] = *(const f32x4*)(ng + 4 * lane + 256 * j); w[j] = (v2u){0u, 0u}; wn[j] = w[j]; }
    if (r0 < r1) {
#pragma unroll
        for (int j = 0; j < 8; ++j) w[j] = *(const v2u*)(h + (size_t)r0 * D + 4 * lane + 256 * j); }
    for (int r = r0; r < r1; ++r) {
        if (r + 1 < r1) {
#pragma unroll
            for (int j = 0; j < 8; ++j) wn[j] = *(const v2u*)(h + (size_t)(r + 1) * D + 4 * lane + 256 * j); }
        f32x4 v[8]; float ss = 0.f;
#pragma unroll
        for (int j = 0; j < 8; ++j) { v[j] = (f32x4){bflo(w[j].x), bfhi(w[j].x), bflo(w[j].y), bfhi(w[j].y)}; ss += (v[j].x * v[j].x + v[j].y * v[j].y) + (v[j].z * v[j].z + v[j].w * v[j].w); }
        const float rstd = rsqrtf(wave_sum(ss) * (1.0f / D) + EPS);
#pragma unroll
        for (int j = 0; j < 8; ++j) *(f32x4*)(yo + (size_t)r * D + 4 * lane + 256 * j) = v[j] * rstd * gs[j];
#pragma unroll
        for (int j = 0; j < 8; ++j) w[j] = wn[j];
    }
}

constexpr int VNT_STRIDE_DW = 68;
constexpr int GATE_ST_OFF = 256 * VNT_STRIDE_DW * 4, GATE_WM_OFF = GATE_ST_OFF + 1024, GATE_WM_STRIDE = 272;
__device__ __forceinline__ void gate_stage_wm(CArgsP a, LAS unsigned char* lds, int g, int tid) {
    const bf16* wm = (const bf16*)(a->ws + WS_WM) + (size_t)g * 16384;
    for (int i = tid; i < 128 * 16; i += NWAVES * 64) { const int row = i >> 4, ch16 = i & 15; *(LAS v4u*)(lds + GATE_WM_OFF + row * GATE_WM_STRIDE + ch16 * 16) = *(const v4u*)(wm + row * 128 + ch16 * 8); }
}
__device__ __forceinline__ void mix_gate_unit(CArgsP a, LAS unsigned char* lds, int ch, int g, int tid, int wave, int lane) {
    asm volatile("" : "+v"(tid), "+v"(lane));
    unsigned char* ws = a->ws;
    LAS unsigned* vnT = (LAS unsigned*)lds;
    LAS float* st = (LAS float*)(lds + GATE_ST_OFF);
    const bool smp = ch >= 256; const int r0 = smp ? NPR + 64 * (ch - 256) : 128 * ch, nrows = smp ? 64 : 128;
    const float* vstat = (const float*)(ws + WS_VSP); const bf16* V = (const bf16*)(ws + WS_V); const bf16* U = (const bf16*)(ws + WS_U); bf16* CAT = (bf16*)(ws + WS_CAT);
    if (tid < 128) { float mean = 0.f, rstd = 0.f;
        if (tid < nrows) { float s1 = 0.f, s2 = 0.f;
#pragma unroll
            for (int i = 0; i < 16; ++i) { const f32x2 p = *(const f32x2*)(vstat + ((size_t)(r0 + tid) * 16 + i) * 2); s1 += p.x; s2 += p.y; }
            mean = s1 * (1.0f / AW); const float var = fmaxf(s2 * (1.0f / AW) - mean * mean, 0.f); rstd = rsqrtf(var + EPS); }
        st[2 * tid] = mean; st[2 * tid + 1] = rstd; }
    unsigned vw[4][8];
#pragma unroll
    for (int it = 0; it < 4; ++it) { const int idx = it * 512 + tid, cp = idx & 127, tg = idx >> 7, c = g * 256 + 2 * cp;
        if (8 * tg < nrows) {
#pragma unroll
            for (int j = 0; j < 8; ++j) vw[it][j] = *(const unsigned*)(V + (size_t)(r0 + 8 * tg + j) * AW + c);
        } else {
#pragma unroll
            for (int j = 0; j < 8; ++j) vw[it][j] = 0u; } }
    __syncthreads();
#pragma unroll
    for (int it = 0; it < 4; ++it) {
        const int idx = it * 512 + tid, cp = idx & 127, tg = idx >> 7, c = g * 256 + 2 * cp;
        const f32x2 gg = *(const f32x2*)(a->in[I_AVG] + c), bb = *(const f32x2*)(a->in[I_AVB] + c);
        float v0[8], v1[8];
        if (8 * tg < nrows) {
#pragma unroll
            for (int j = 0; j < 8; ++j) { const int tok = 8 * tg + j; const float mean = st[2 * tok], rstd = st[2 * tok + 1];
                v0[j] = (bflo(vw[it][j]) - mean) * rstd * gg.x + bb.x; v1[j] = (bfhi(vw[it][j]) - mean) * rstd * gg.y + bb.y;
                if (smp) *(f32x2*)(a->out + O_NAV + (size_t)((ch - 256) * 64 + tok) * AW + c) = (f32x2){v0[j], v1[j]}; }
        } else {
#pragma unroll
            for (int j = 0; j < 8; ++j) { v0[j] = 0.f; v1[j] = 0.f; } }
        v4u w0, w1; w0.x = pk2(v0[0], v0[1]); w0.y = pk2(v0[2], v0[3]); w0.z = pk2(v0[4], v0[5]); w0.w = pk2(v0[6], v0[7]); w1.x = pk2(v1[0], v1[1]); w1.y = pk2(v1[2], v1[3]); w1.z = pk2(v1[4], v1[5]); w1.w = pk2(v1[6], v1[7]);
        *(LAS v4u*)(vnT + (2 * cp) * VNT_STRIDE_DW + 4 * tg) = w0; *(LAS v4u*)(vnT + (2 * cp + 1) * VNT_STRIDE_DW + 4 * tg) = w1;
    }
    __syncthreads();
    const int lr = lane & 15, lq = lane >> 4;
    v2u uw[8][2]; float bsv[8];
#pragma unroll
    for (int it = 0; it < 8; ++it) { const int i = 16 * it + lr; bsv[it] = a->in[I_ABS][g * 128 + i];
#pragma unroll
        for (int ct = 0; ct < 2; ++ct) uw[it][ct] = *(const v2u*)(U + (size_t)(r0 + i) * AW + g * 256 + 32 * wave + 16 * ct + 4 * lq); }
    f32x4 acc[2][8];
#pragma unroll
    for (int ct = 0; ct < 2; ++ct)
#pragma unroll
        for (int it = 0; it < 8; ++it) acc[ct][it] = (f32x4){0.f, 0.f, 0.f, 0.f};
#pragma unroll 1
    for (int ks = 0; ks < 4; ++ks) {
        bf16x8 af[2];
#pragma unroll
        for (int ct = 0; ct < 2; ++ct) af[ct] = *(const LAS bf16x8*)((const LAS unsigned char*)vnT + (32 * wave + 16 * ct + lr) * (VNT_STRIDE_DW * 4) + ks * 64 + lq * 16);
#pragma unroll
        for (int it = 0; it < 8; ++it) { const bf16x8 bfrag = *(const LAS bf16x8*)(lds + GATE_WM_OFF + (16 * it + lr) * GATE_WM_STRIDE + ks * 64 + lq * 16);
#pragma unroll
            for (int ct = 0; ct < 2; ++ct) acc[ct][it] = __builtin_amdgcn_mfma_f32_16x16x32_bf16(af[ct], bfrag, acc[ct][it], 0, 0, 0); }
    }
#pragma unroll
    for (int it = 0; it < 8; ++it) { const int i = 16 * it + lr;
        if (i < nrows) {
#pragma unroll
            for (int ct = 0; ct < 2; ++ct) { const int cb = g * 256 + 32 * wave + 16 * ct + 4 * lq; const v2u u2 = uw[it][ct]; const float bs = bsv[it];
                v2u w; w.x = pk2(bflo(u2.x) * (acc[ct][it][0] + bs), bfhi(u2.x) * (acc[ct][it][1] + bs)); w.y = pk2(bflo(u2.y) * (acc[ct][it][2] + bs), bfhi(u2.y) * (acc[ct][it][3] + bs));
                *(v2u*)(CAT + (size_t)(r0 + i) * D + cb) = w; } } }
    __syncthreads();
}
constexpr int CONV_W_BYTES = 31 * 1024 * 4;
__device__ __forceinline__ void conv_stage_weights(CArgsP a, LAS unsigned char* lds, int tid) {
    __syncthreads();
    for (int i = tid; i < 31 * 256; i += NWAVES * 64) *(LAS f32x4*)(lds + 16 * i) = *(const f32x4*)(a->in[I_BDW] + 4 * i);
    __syncthreads();
}
__device__ __forceinline__ f32x2 conv_row(const bf16* GLU, const float* hist, int rowbase, int t, int c) {
    if (t >= 0) { const unsigned w = *(const unsigned*)(GLU + (size_t)(rowbase + t) * AW + c); return (f32x2){bflo(w), bfhi(w)}; }
    if (hist) return *(const f32x2*)(hist + (size_t)(30 + t) * 1024 + c);
    return (f32x2){0.f, 0.f};
}
__device__ __forceinline__ void mix_conv_unit(CArgsP a, LAS unsigned char* lds, int b, int tid, int wave, int lane) {
    unsigned char* ws = a->ws;
    const LAS float* dwl = (const LAS float*)lds;
    LAS float* red = (LAS float*)(lds + CONV_W_BYTES);
    LAS float* stt = red + 128;
    int rowbase, t0; const float* hist = nullptr;
    if (b < 1024) { rowbase = 8192 * (b >> 8); t0 = 32 * (b & 255); } else { const int q = b - 1024; rowbase = NPR + 64 * (q >> 1); t0 = 32 * (q & 1); hist = a->in[I_SCONV] + (size_t)(q >> 1) * 30 * 1024; }
    const bf16* GLU = (const bf16*)(ws + WS_GLU); bf16* CAT = (bf16*)(ws + WS_CAT);
    const int c = 2 * tid;
    const f32x2 lg = *(const f32x2*)(a->in[I_BLNG] + c), lb = *(const f32x2*)(a->in[I_BLNB] + c);
    f32x2 x[62];
    if (t0 >= 30) {
        const bf16* gp = GLU + (size_t)(rowbase + t0 - 30) * AW + c;
        unsigned xw[62];
#pragma unroll
        for (int i = 0; i < 62; ++i) xw[i] = *(const unsigned*)(gp + (size_t)i * AW);
#pragma unroll
        for (int i = 0; i < 62; ++i) x[i] = (f32x2){bflo(xw[i]), bfhi(xw[i])};
    } else {
#pragma unroll
        for (int i = 0; i < 62; ++i) x[i] = conv_row(GLU, hist, rowbase, t0 - 30 + i, c);
    }
#pragma unroll
    for (int sub = 0; sub < 4; ++sub) {
        const int tt0 = t0 + 8 * sub;
        f32x2 acc[8];
#pragma unroll
        for (int t = 0; t < 8; ++t) acc[t] = (f32x2){0.f, 0.f};
#pragma unroll
        for (int k = 0; k < 31; ++k) { const f32x2 wk = *(const LAS f32x2*)(dwl + k * 1024 + c);
#pragma unroll
            for (int t = 0; t < 8; ++t) acc[t] += x[8 * sub + t + k] * wk; }
#pragma unroll
        for (int t = 0; t < 8; ++t) { const float s1 = wave_sum(acc[t].x + acc[t].y), s2 = wave_sum(acc[t].x * acc[t].x + acc[t].y * acc[t].y);
            if (lane == 0) { red[(wave * 8 + t) * 2] = s1; red[(wave * 8 + t) * 2 + 1] = s2; } }
        __syncthreads();
        if (tid < 8) { float s1 = 0.f, s2 = 0.f;
#pragma unroll
            for (int w = 0; w < 8; ++w) { s1 += red[(w * 8 + tid) * 2]; s2 += red[(w * 8 + tid) * 2 + 1]; }
            const float mean = s1 * (1.0f / AW), var = fmaxf(s2 * (1.0f / AW) - mean * mean, 0.f); stt[2 * tid] = mean; stt[2 * tid + 1] = rsqrtf(var + EPS); }
        __syncthreads();
#pragma unroll
        for (int t = 0; t < 8; ++t) { const float mean = stt[2 * t], rstd = stt[2 * t + 1];
            const float y0 = (acc[t].x - mean) * rstd * lg.x + lb.x, y1 = (acc[t].y - mean) * rstd * lg.y + lb.y;
            *(unsigned*)(CAT + (size_t)(rowbase + tt0 + t) * D + AW + c) = pk2(siluf_(y0), siluf_(y1)); }
        asm volatile("" ::: "memory");
    }
}
__device__ __forceinline__ f32x4 tc_hm(const bf16* h, const float* hist, const LAS float* rs, int rowbase, int t0, int t, int c, f32x4 gs, f32x4 sh) {
    if (t >= 0) { const v2u w = *(const v2u*)(h + (size_t)(rowbase + t) * D + c); return (f32x4){bflo(w.x), bfhi(w.x), bflo(w.y), bfhi(w.y)} * rs[t - t0 + 15] * gs + sh; }
    if (hist) return *(const f32x4*)(hist + (size_t)(15 + t) * D + c);
    return (f32x4){0.f, 0.f, 0.f, 0.f};
}
__device__ __forceinline__ f32x4 tc_hm_all(const bf16* h, const LAS float* rs, int rowbase, int t0, int t, int c, f32x4 gs, f32x4 sh) {
    const v2u w = *(const v2u*)(h + (size_t)(rowbase + t) * D + c); return (f32x4){bflo(w.x), bfhi(w.x), bflo(w.y), bfhi(w.y)} * rs[t - t0 + 15] * gs + sh;
}
template <int W, bool ALLV> __device__ __forceinline__ void tc_body(const bf16* h, const float* hist, const LAS float* rs, int rowbase, int t0, int T, int pos0, int c, f32x4 gs, f32x4 sh, bf16* PC, float* np) {
    f32x4 ring[16]; f32x4 S = (f32x4){0.f, 0.f, 0.f, 0.f};
#pragma unroll
    for (int k = 1; k < W; ++k) { ring[(16 - k) & 15] = ALLV ? tc_hm_all(h, rs, rowbase, t0, t0 - k, c, gs, sh) : tc_hm(h, hist, rs, rowbase, t0, t0 - k, c, gs, sh); S += ring[(16 - k) & 15]; }
#pragma unroll
    for (int tt = 0; tt < 32; ++tt) { const int t = t0 + tt;
        const f32x4 cur = ALLV ? tc_hm_all(h, rs, rowbase, t0, t, c, gs, sh) : tc_hm(h, hist, rs, rowbase, t0, t, c, gs, sh);
        S += cur;
        const int pos = pos0 + t; const float inv = 1.0f / (float)(pos + 1 < W ? pos + 1 : W);
        const f32x4 p = S * inv - cur;
        v2u o; o.x = pk2(p.x, p.y); o.y = pk2(p.z, p.w); *(v2u*)(PC + (size_t)(rowbase + t) * D + c) = o;
        if (t >= T - 15) *(f32x4*)(np + (size_t)(t - (T - 15)) * D + c) = cur;
        if (W > 1) { if (W == 2) S -= (tt == 0 ? ring[15] : ring[(tt - 1) & 15]); else S -= ring[(tt - W + 1 + 32) & 15]; }
        ring[tt & 15] = cur;
    }
}
__device__ __forceinline__ void tc_unit(CArgsP a, LAS unsigned char* lds, const bf16* h, const float* ssq, const float* ng, const float* shift, const float* scale, int b, int tid, int wave, int lane) {
    unsigned char* ws = a->ws;
    LAS float* rs = (LAS float*)lds;
    int rowbase, t0, s, T, pos0; const float* hist = nullptr; float* np;
    if (b < 1024) { s = b >> 8; rowbase = 8192 * s; t0 = 32 * (b & 255); T = 8192; pos0 = 0; np = a->out + O_NPP + (size_t)s * 15 * D; }
    else { const int q = b - 1024; s = 4 + (q >> 1); rowbase = NPR + 64 * (q >> 1); t0 = 32 * (q & 1); T = 64; pos0 = 1024; hist = a->in[I_SPOOL] + (size_t)(q >> 1) * 15 * D; np = a->out + O_NPS + (size_t)(q >> 1) * 15 * D; }
    if (tid < 47) { const int t = t0 - 15 + tid; if (t >= 0) rs[tid] = rsqrtf(ssq[rowbase + t] * (1.0f / D) + EPS); }
    __syncthreads();
    const int c = 4 * tid, grp = __builtin_amdgcn_readfirstlane(tid >> 7);
    const f32x4 gs = *(const f32x4*)(ng + c) * (*(const f32x4*)(scale + (size_t)s * MODS + c) + 1.0f), sh = *(const f32x4*)(shift + (size_t)s * MODS + c);
    bf16* PC = (bf16*)(ws + WS_PC);
    if (t0 >= 15) {
        if (grp == 0) tc_body<2, true>(h, hist, rs, rowbase, t0, T, pos0, c, gs, sh, PC, np);
        else if (grp == 1) tc_body<4, true>(h, hist, rs, rowbase, t0, T, pos0, c, gs, sh, PC, np);
        else if (grp == 2) tc_body<8, true>(h, hist, rs, rowbase, t0, T, pos0, c, gs, sh, PC, np);
        else tc_body<16, true>(h, hist, rs, rowbase, t0, T, pos0, c, gs, sh, PC, np);
    } else {
        if (grp == 0) tc_body<2, false>(h, hist, rs, rowbase, t0, T, pos0, c, gs, sh, PC, np);
        else if (grp == 1) tc_body<4, false>(h, hist, rs, rowbase, t0, T, pos0, c, gs, sh, PC, np);
        else if (grp == 2) tc_body<8, false>(h, hist, rs, rowbase, t0, T, pos0, c, gs, sh, PC, np);
        else tc_body<16, false>(h, hist, rs, rowbase, t0, T, pos0, c, gs, sh, PC, np);
    }
    __syncthreads();
}

__device__ __forceinline__ void slab_reduce(const void* base_s, int base_f32, bf16* hS, const float* slab, int ks, bf16* an, const float* ng_n, const float* sc_n, float* ss, int gw, int NGW, int lane) {
    for (int r = gw; r < NSR; r += NGW) {
        const int s = 4 + (r >> 6);
        f32x4 v[8]; float q = 0.f;
#pragma unroll
        for (int j = 0; j < 8; ++j) { const size_t o = (size_t)r * D + 4 * lane + 256 * j;
            if (base_f32) v[j] = *(const f32x4*)((const float*)base_s + o); else { const v2u w = *(const v2u*)((const bf16*)base_s + o); v[j] = (f32x4){bflo(w.x), bfhi(w.x), bflo(w.y), bfhi(w.y)}; } }
#pragma unroll 4
        for (int k = 0; k < ks; ++k) {
#pragma unroll
            for (int j = 0; j < 8; ++j) v[j] += *(const f32x4*)(slab + ((size_t)k * NSR + r) * D + 4 * lane + 256 * j); }
#pragma unroll
        for (int j = 0; j < 8; ++j) { const int c = 4 * lane + 256 * j; { v2u w; w.x = pk2(v[j].x, v[j].y); w.y = pk2(v[j].z, v[j].w); *(v2u*)(hS + (size_t)r * D + c) = w; } q += (v[j].x * v[j].x + v[j].y * v[j].y) + (v[j].z * v[j].z + v[j].w * v[j].w);
            if (an) { const f32x4 t = v[j] * (*(const f32x4*)(ng_n + c) * (*(const f32x4*)(sc_n + (size_t)s * MODS + c) + 1.0f)); v2u w; w.x = pk2(t.x, t.y); w.y = pk2(t.z, t.w); *(v2u*)(an + (size_t)(NPR + r) * D + c) = w; } }
        if (ss) { q = wave_sum(q); if (lane == 0) ss[NPR + r] = q; }
    }
}
__device__ __forceinline__ void slab_reduce_final(const bf16* base_s, const float* slab, int ks, float* yo, const float* ng, int r, int lane) {
    f32x4 v[8]; float q = 0.f;
#pragma unroll
    for (int j = 0; j < 8; ++j) { const v2u w = *(const v2u*)(base_s + (size_t)r * D + 4 * lane + 256 * j); v[j] = (f32x4){bflo(w.x), bfhi(w.x), bflo(w.y), bfhi(w.y)}; }
#pragma unroll 4
    for (int k = 0; k < ks; ++k) {
#pragma unroll
        for (int j = 0; j < 8; ++j) v[j] += *(const f32x4*)(slab + ((size_t)k * NSR + r) * D + 4 * lane + 256 * j); }
#pragma unroll
    for (int j = 0; j < 8; ++j) q += (v[j].x * v[j].x + v[j].y * v[j].y) + (v[j].z * v[j].z + v[j].w * v[j].w);
    const float rstd = rsqrtf(wave_sum(q) * (1.0f / D) + EPS);
#pragma unroll
    for (int j = 0; j < 8; ++j) *(f32x4*)(yo + (size_t)(NPR + r) * D + 4 * lane + 256 * j) = v[j] * rstd * (*(const f32x4*)(ng + 4 * lane + 256 * j));
}
__device__ __forceinline__ void mod_reduce(const float* modp, float* mod, int gtid, int NT) {
    for (int i = gtid; i < 2 * MODL / 4; i += NT) { f32x4 v = ((const f32x4*)modp)[i];
#pragma unroll
        for (int k = 1; k < 16; ++k) v += ((const f32x4*)modp)[(size_t)k * (2 * MODL / 4) + i];
        ((f32x4*)mod)[i] = v; }
}
__device__ __forceinline__ void ss_finalize(const float* ssp, float* ss, int nrows, int gtid, int NT) {
    for (int r = gtid; r < nrows; r += NT) { const f32x4* p = (const f32x4*)(ssp + (size_t)r * 32); f32x4 v = p[0];
#pragma unroll
        for (int k = 1; k < 8; ++k) v += p[k];
        ss[r] = (v.x + v.y) + (v.z + v.w); }
}
constexpr int SHL_STRIDE = D + 8;
__device__ __forceinline__ void sb_gemv(LAS unsigned char* lds, const bf16* Wt, int nrows, const float* shift, float* sb, int gw, int NGW, int tid, int lane) {
    LAS bf16* shl = (LAS bf16*)lds;
    __syncthreads();
    for (int i = tid; i < 16 * (D / 8); i += NWAVES * 64) { const int s = i / (D / 8), c8 = i % (D / 8); v4u w = (v4u){0u, 0u, 0u, 0u};
        if (s < NSTREAM) { const float* p = shift + (size_t)s * MODS + 8 * c8; const f32x4 a = *(const f32x4*)p, b = *(const f32x4*)(p + 4); w.x = pk2(a.x, a.y); w.y = pk2(a.z, a.w); w.z = pk2(b.x, b.y); w.w = pk2(b.z, b.w); }
        *(LAS v4u*)(shl + s * SHL_STRIDE + 8 * c8) = w; }
    __syncthreads();
    const int lr = lane & 15, lq = lane >> 4;
    for (int tile = gw; tile < nrows / 16; tile += NGW) {
        const int n0 = 16 * tile;
        f32x4 acc = (f32x4){0.f, 0.f, 0.f, 0.f};
        const bf16* wp = Wt + (size_t)(n0 + lr) * D + 8 * lq; const LAS bf16* ap = shl + lr * SHL_STRIDE + 8 * lq;
        bf16x8 wf[32];
#pragma unroll 1
        for (int kh = 0; kh < 2; ++kh) {
#pragma unroll
            for (int ks = 0; ks < 32; ++ks) wf[ks] = *(const bf16x8*)(wp + 32 * (32 * kh + ks));
#pragma unroll
            for (int ks = 0; ks < 32; ++ks) acc = __builtin_amdgcn_mfma_f32_16x16x32_bf16(*(const LAS bf16x8*)(ap + 32 * (32 * kh + ks)), wf[ks], acc, 0, 0, 0);
        }
#pragma unroll
        for (int j = 0; j < 4; ++j) { const int s = 4 * lq + j; if (s < NSTREAM) sb[(size_t)s * nrows + n0 + lr] = acc[j]; }
    }
}

constexpr int NPL = 13, NPH = 3 + 2 * NPL;
constexpr int KS_G2 = 11, KS_G4 = 8;
__global__ void __launch_bounds__(NWAVES * 64, 2) mk_fwd(Args args) {
    extern __shared__ __attribute__((aligned(16))) unsigned char lds_raw[];
    LAS unsigned char* lds = (LAS unsigned char*)lds_raw;
    volatile LAS unsigned* MISC = (volatile LAS unsigned*)(lds + MISC_OFF);
    constexpr int G = NCU;
    const int bx = blockIdx.x, vcu = (bx % 8) * (G / 8) + bx / 8; constexpr int NGW = G * NWAVES;
    for (int u = threadIdx.x; u < (LDS_BYTES - LDSCTL_OFF) / 4; u += NWAVES * 64) ((LAS unsigned*)(lds + LDSCTL_OFF))[u] = 0u;
    __syncthreads();
    const int lo = args.ph_lo, hi = args.ph_hi;
    XcdBarrier bar; bar.bar = (unsigned*)(args.ws + WS_CTL) + CW_BAR; bar.x = 0; bar.st = nullptr;
    if (hi - lo > 1) bar = xcd_barrier_post((unsigned*)(args.ws + WS_CTL) + CW_BAR, MISC + 8);
#ifndef PH_MASK
#define PH_MASK 0xFFFFFFFFu
#endif
#define SITE(i) ((PH_MASK >> (i)) & 1u)
#define REP(i) for (int rep_ = 0; rep_ < 1 + (int)((DUP_MASK >> (i)) & 1u); ++rep_)
#define IN(k) (lo <= (k) && (k) < hi)
#define STAGGER(x0, span) ((G % 8 == 0 && (bx % 8) >= (x0)) ? (unsigned)((span) * ((bx % 8) - (x0) + 1) / (9 - (x0))) : 0u)
#define SEAM(k) do { if ((k) + 1 < hi) { xcd_barrier(bar); if ((DUP_MASK >> 7) & 1u) xcd_barrier(bar); } } while (0)
#define SITE_IDS int tid = threadIdx.x; asm volatile("" : "+v"(tid)); const int lane = tid & 63, wave = __builtin_amdgcn_readfirstlane(tid >> 6), gw = vcu * NWAVES + wave; (void)lane; (void)gw; \
    CArgsP ap = (CArgsP)__builtin_amdgcn_kernarg_segment_ptr(); asm volatile("" : "+s"(ap)); unsigned char* ws = ap->ws; bf16* h = (bf16*)(ws + WS_H); bf16* hS = h + (size_t)NPR * D; (void)hS; (void)h; \
    const float* modl = (const float*)(ws + WS_MOD) + (size_t)l * MODL; const float* ngl = ap->in[I_NORMG] + (size_t)l * 3 * D; (void)modl; (void)ngl; \
    bf16* HN = (bf16*)(ws + WS_HN); bf16* ACT = (bf16*)(ws + WS_ACT); float* SLAB = (float*)(ws + WS_SLAB); float* SSQ = (float*)(ws + WS_SS); float* SSP = (float*)(ws + WS_SSP); const int gtid = (int)blockIdx.x * (NWAVES * 64) + tid; (void)HN; (void)ACT; (void)SLAB; (void)SSQ; (void)SSP; (void)gtid

    { const int l = 0; if (SITE(0) && IN(0)) { SITE_IDS; p0_prologue(ap, lds, gw, NGW, wave, lane); SEAM(0); }
      if (SITE(0) && IN(1)) { SITE_IDS; mod_reduce((const float*)(ws + WS_MODP), (float*)(ws + WS_MOD), gtid, G * NWAVES * 64); SEAM(1); } }

#pragma unroll 1
    for (int l = 0; l < 2; ++l) {
        const int pb = 2 + NPL * l;
        if (l == 0 && SITE(1) && IN(pb + 0)) { SITE_IDS; const float* mod0 = (const float*)(ws + WS_MOD); float* SB = (float*)(ws + WS_SB);
            REP(1) thin_norm(ap->in[I_XP], ap->in[I_XS], ngl, modl + 0 * D, modl + 1 * D, HN, gw, NGW, lane);
            sb_gemv(lds, (const bf16*)(ws + WS_WIN), 4096, mod0 + 3 * D, SB + (size_t)4 * 12 * 11264, gw, NGW, tid, lane);
            SEAM(pb + 0); }
        if (SITE(2) && IN(pb + 1)) { SITE_IDS; pg8::Gemm g{HN, (const bf16*)(ws + WS_WGU) + (size_t)(2 * l) * 11264 * 2048, M, 11264, D, D, 0}; pg8::StaticOrder S; S.init(NPR, NSR, 11264, D, G, bx, 1);
            pg8::EpiSwiGLU E{ACT, DFF, l == 0 ? nullptr : SSQ + (size_t)2 * M, (const float*)(ws + WS_SB) + (size_t)2 * 12 * 11264}; REP(0) pg8::gemm_phase<pg8::EpiSwiGLU, true>(lds, g, S, E, 0u);
            { const int c0 = (S.nTail + 31) / 32 * 32;
              if (vcu >= c0) conv_window(ap, lds, 2 * l + 1, -1, -1, vcu - c0, G - c0, wave, lane); } SEAM(pb + 1); }
        if (SITE(3) && IN(pb + 2)) { SITE_IDS; pg8::Gemm g{ACT, (const bf16*)(ws + WS_WD) + (size_t)(2 * l) * 2048 * 5632, M, D, DFF, DFF, 0}; pg8::StaticOrder S; S.init(NPR, NSR, D, DFF, G, bx, KS_G2, 4);
            pg8::EpiRes<false> E{l == 0 ? (const void*)ap->in[I_XP] : (const void*)h, l == 0 ? (const void*)ap->in[I_XS] : (const void*)hS, h, modl + 2 * D, nullptr, nullptr, SLAB, l == 0 ? HN : nullptr, ngl + D, modl + 4 * D, SSP + (size_t)(l == 0 ? 0 : 3) * M * 32, 0.5f, l == 0 ? 1 : 0};
            if ((DUP_MASK >> 5) & 1u) { pg8::EpiRes<false> E2 = E; E2.out = (bf16*)(ws + WS_DUMMY); E2.an = nullptr; E2.ss = nullptr; pg8::gemm_phase<pg8::EpiRes<false>, true>(lds, g, S, E2); }
            pg8::gemm_phase<pg8::EpiRes<false>, true>(lds, g, S, E); SEAM(pb + 2); }
        if (SITE(3) && IN(pb + 3)) { SITE_IDS; slab_reduce(l == 0 ? (const void*)ap->in[I_XS] : (const void*)hS, l == 0 ? 1 : 0, hS, SLAB, KS_G2, l == 0 ? HN : nullptr, ngl + D, modl + 4 * D, SSQ + (size_t)(l == 0 ? 0 : 3) * M, gw, NGW, lane);
            ss_finalize(SSP + (size_t)(l == 0 ? 0 : 3) * M * 32, SSQ + (size_t)(l == 0 ? 0 : 3) * M, NPR, gtid, G * NWAVES * 64);
            SEAM(pb + 3); }
        if (l == 0) {
            if (SITE(5) && IN(pb + 5)) { SITE_IDS; pg8::Gemm g{HN, (const bf16*)(ws + WS_WIN), M, 4096, D, D, 0}; pg8::StaticOrder S; S.init(NPR, NSR, 4096, D, G, bx, 1);
                pg8::EpiInProj E{(bf16*)(ws + WS_U), (bf16*)(ws + WS_V), (bf16*)(ws + WS_GLU), (float*)(ws + WS_VSP), ap->out + O_NCP, ap->out + O_NCS, SSQ, (const float*)(ws + WS_SB) + (size_t)4 * 12 * 11264};
                if ((DUP_MASK >> 6) & 1u) { pg8::EpiInProj E2 = E; E2.vstat = (float*)(ws + WS_DUMMY); pg8::gemm_phase<pg8::EpiInProj, true>(lds, g, S, E2); }
                pg8::gemm_phase<pg8::EpiInProj, true>(lds, g, S, E, 0u);
                if (vcu >= S.nTail) { const int rank = vcu - S.nTail, nrank = G - S.nTail; conv_window(ap, lds, -1, 1, 2, rank, nrank, wave, lane);
                    sb_gemv(lds, (const bf16*)(ws + WS_WGU) + (size_t)1 * 11264 * 2048, 11264, (const float*)(ws + WS_MOD) + 6 * D, (float*)(ws + WS_SB) + (size_t)1 * 12 * 11264, rank * NWAVES + wave, nrank * NWAVES, tid, lane); }
                SEAM(pb + 5); }
            if (SITE(6) && IN(pb + 6)) { SITE_IDS;
                REP(2) { bool staged = false; gate_stage_wm(ap, lds, vcu & 3, tid);
                  for (int u = vcu; u < 1056 + 1040; u += G) { if (u < 1056) { if (SITE(20)) mix_gate_unit(ap, lds, u >> 2, u & 3, tid, wave, lane); } else { if (!staged) { conv_stage_weights(ap, lds, tid); staged = true; } if (SITE(21)) mix_conv_unit(ap, lds, u - 1056, tid, wave, lane); } } __syncthreads(); }
                SEAM(pb + 6); }
            if (SITE(7) && IN(pb + 7)) { SITE_IDS; pg8::Gemm g{(const bf16*)(ws + WS_CAT), (const bf16*)(ws + WS_WOUT), M, D, D, D, 0}; pg8::StaticOrder S; S.init(NPR, NSR, D, D, G, bx, KS_G4);
                pg8::EpiRes<false> E{h, hS, h, modl + 5 * D, nullptr, nullptr, SLAB, HN, ngl + 2 * D, modl + 7 * D, SSP + (size_t)1 * M * 32, 1.0f, 0};
                if ((DUP_MASK >> 6) & 1u) { pg8::EpiRes<false> E2 = E; E2.out = (bf16*)(ws + WS_DUMMY); E2.an = nullptr; E2.ss = nullptr; pg8::gemm_phase<pg8::EpiRes<false>, true>(lds, g, S, E2); }
                pg8::gemm_phase<pg8::EpiRes<false>, true>(lds, g, S, E); SEAM(pb + 7); }
            if (SITE(7) && IN(pb + 8)) { SITE_IDS; slab_reduce(hS, 0, hS, SLAB, KS_G4, HN, ngl + 2 * D, modl + 7 * D, SSQ + (size_t)1 * M, gw, NGW, lane); ss_finalize(SSP + (size_t)1 * M * 32, SSQ + (size_t)1 * M, NPR, gtid, G * NWAVES * 64); SEAM(pb + 8); }
        } else {
            if (SITE(8) && IN(pb + 4)) { SITE_IDS; REP(3) for (int u = vcu; u < 1040; u += G) tc_unit(ap, lds, h, SSQ + (size_t)3 * M, ngl + D, modl + 3 * D, modl + 4 * D, u, tid, wave, lane); SEAM(pb + 4); }
            if (SITE(9) && IN(pb + 7)) { SITE_IDS; pg8::Gemm g{(const bf16*)(ws + WS_PC), (const bf16*)(ws + WS_WC), M, D, 512, D, 2}; pg8::StaticOrder S; S.init(NPR, NSR, D, 512, G, bx, 1);
                pg8::EpiRes<true> E{h, hS, h, modl + 5 * D, ap->in[I_CB], ap->in[I_CSC], SLAB, HN, ngl + 2 * D, modl + 7 * D, SSP + (size_t)4 * M * 32, 1.0f, 0};
                if ((DUP_MASK >> 6) & 1u) { pg8::EpiRes<true> E2 = E; E2.out = (bf16*)(ws + WS_DUMMY); E2.an = nullptr; E2.ss = nullptr; pg8::gemm_phase<pg8::EpiRes<true>, true>(lds, g, S, E2); }
                pg8::gemm_phase<pg8::EpiRes<true>, true>(lds, g, S, E);
                if (vcu >= S.nTail) sb_gemv(lds, (const bf16*)(ws + WS_WGU) + (size_t)3 * 11264 * 2048, 11264, (const float*)(ws + WS_MOD) + MODL + 6 * D, (float*)(ws + WS_SB) + (size_t)3 * 12 * 11264, (vcu - S.nTail) * NWAVES + wave, (G - S.nTail) * NWAVES, tid, lane);
                SEAM(pb + 7); }
            if (SITE(9) && IN(pb + 8)) { SITE_IDS; ss_finalize(SSP + (size_t)4 * M * 32, SSQ + (size_t)4 * M, M, gtid, G * NWAVES * 64); SEAM(pb + 8); }
        }
        if (SITE(11) && IN(pb + 10)) { SITE_IDS; pg8::Gemm g{HN, (const bf16*)(ws + WS_WGU) + (size_t)(2 * l + 1) * 11264 * 2048, M, 11264, D, D, 0}; pg8::StaticOrder S; S.init(NPR, NSR, 11264, D, G, bx, 1);
            pg8::EpiSwiGLU E{ACT, DFF, SSQ + (size_t)(l == 0 ? 1 : 4) * M, (const float*)(ws + WS_SB) + (size_t)(2 * l + 1) * 12 * 11264}; REP(0) pg8::gemm_phase<pg8::EpiSwiGLU, true>(lds, g, S, E, 0u);
            { const int c0 = (S.nTail + 31) / 32 * 32; if (vcu >= c0) conv_window(ap, lds, l == 0 ? 2 : -1, l == 0 ? -1 : 3, -1, vcu - c0, G - c0, wave, lane); } SEAM(pb + 10); }
        if (SITE(12) && IN(pb + 11)) { SITE_IDS; pg8::Gemm g{ACT, (const bf16*)(ws + WS_WD) + (size_t)(2 * l + 1) * 2048 * 5632, M, D, DFF, DFF, 0}; pg8::StaticOrder S; S.init(NPR, NSR, D, DFF, G, bx, KS_G2, 4);
            const float* ng1 = ap->in[I_NORMG] + (size_t)3 * D; const float* mod1 = (const float*)(ws + WS_MOD) + MODL;
            pg8::EpiRes<false> E{h, hS, h, modl + 8 * D, nullptr, nullptr, SLAB, l == 0 ? HN : nullptr, ng1, mod1 + 1 * D, l == 0 ? SSP + (size_t)2 * M * 32 : nullptr, 0.5f, 0};
            if ((DUP_MASK >> 5) & 1u) { pg8::EpiRes<false> E2 = E; E2.out = (bf16*)(ws + WS_DUMMY); E2.an = nullptr; E2.ss = nullptr; pg8::gemm_phase<pg8::EpiRes<false>, true>(lds, g, S, E2); }
            pg8::gemm_phase<pg8::EpiRes<false>, true>(lds, g, S, E);
            if (l == 0 && vcu >= S.nTail) sb_gemv(lds, (const bf16*)(ws + WS_WGU) + (size_t)2 * 11264 * 2048, 11264, mod1 + 0 * D, (float*)(ws + WS_SB) + (size_t)2 * 12 * 11264, (vcu - S.nTail) * NWAVES + wave, (G - S.nTail) * NWAVES, tid, lane);
            SEAM(pb + 11); }
        if (SITE(12) && IN(pb + 12)) { SITE_IDS; const float* ng1 = ap->in[I_NORMG] + (size_t)3 * D; const float* mod1 = (const float*)(ws + WS_MOD) + MODL;
            if (l == 0) slab_reduce(hS, 0, hS, SLAB, KS_G2, HN, ng1, mod1 + 1 * D, SSQ + (size_t)2 * M, gw, NGW, lane);
            if (l == 0) ss_finalize(SSP + (size_t)2 * M * 32, SSQ + (size_t)2 * M, NPR, gtid, G * NWAVES * 64);
            if (l == 0) SEAM(pb + 12); }
    }
    { const int l = 0; if (SITE(13) && IN(NPH - 1)) { SITE_IDS;
        static_assert(NGW == 2048 && NSR * 4 == NGW && NPR == 512 * 64, "row dealing of the final phase");
        const int q4 = gw & 3, r0 = (gw >> 2) * 64 + (q4 == 0 ? 0 : 10 + 18 * (q4 - 1)), r1 = r0 + (q4 == 0 ? 10 : 18);
        if (q4 == 0) slab_reduce_final(hS, SLAB, KS_G2, ap->out, ap->in[I_FNORMG], gw >> 2, lane);
        final_norm(h, ap->out, ap->in[I_FNORMG], r0, r1, lane); } }
#undef IN
#undef SEAM
#undef SITE
#undef SITE_IDS
}

extern "C" void kernel_launch(void* const* d_in, const int* in_sizes, int n_in, void* d_out, int out_size, void* d_ws, size_t ws_size, hipStream_t stream) {
    static int grid = 0;
    if (grid == 0) {
        if (n_in != 25 || in_sizes[0] != NPR * D || (size_t)out_size != O_END || ws_size < WS_END) { fprintf(stderr, "kernel_launch: unexpected shapes (n_in %d, in0 %d, out %d, ws %zu); nothing launched\n", n_in, n_in > 0 ? in_sizes[0] : -1, out_size, ws_size); grid = -1; return; }
        int dev = 0, cus = 0, per_cu = 0;
        if (hipGetDevice(&dev) != hipSuccess || hipDeviceGetAttribute(&cus, hipDeviceAttributeMultiprocessorCount, dev) != hipSuccess) { fprintf(stderr, "kernel_launch: device query failed\n"); grid = -1; return; }
        if (hipFuncSetAttribute((const void*)mk_fwd, hipFuncAttributeMaxDynamicSharedMemorySize, LDS_BYTES) != hipSuccess) { fprintf(stderr, "kernel_launch: hipFuncSetAttribute failed\n"); grid = -1; return; }
        if (hipOccupancyMaxActiveBlocksPerMultiprocessor(&per_cu, (const void*)mk_fwd, NWAVES * 64, LDS_BYTES) != hipSuccess || per_cu < 1) fprintf(stderr, "kernel_launch: note: occupancy query reports %d workgroups per CU\n", per_cu);
        (void)hipGetLastError();
        if (cus != NCU) fprintf(stderr, "kernel_launch: built for a %d-CU device (one workgroup per CU), this one reports %d\n", NCU, cus);
        grid = NCU;
    }
    if (grid < 0) return;
    if (hipMemsetAsync((char*)d_ws + WS_CTL, 0, CTL_ZERO_BYTES, stream) != hipSuccess) { fprintf(stderr, "kernel_launch: memset failed\n"); return; }
    Args a{};
    for (int i = 0; i < 25; ++i) a.in[i] = (const float*)d_in[i];
    a.out = (float*)d_out; a.ws = (unsigned char*)d_ws;
#if MK_N_LAUNCHES == 1
    a.ph_lo = 0; a.ph_hi = NPH;
    hipLaunchKernelGGL(mk_fwd, dim3(grid), dim3(NWAVES * 64), LDS_BYTES, stream, a);
#else
    for (int p = 0; p < NPH; ++p) { if (p == 2 + 4 || p == 2 + 9 || p == 2 + NPL + 0 || p == 2 + NPL + 5 || p == 2 + NPL + 6 || p == 2 + NPL + 9) continue; a.ph_lo = p; a.ph_hi = p + 1; hipLaunchKernelGGL(mk_fwd, dim3(grid), dim3(NWAVES * 64), LDS_BYTES, stream, a); }
#endif
    const hipError_t le = hipPeekAtLastError();
    if (le != hipSuccess) fprintf(stderr, "kernel_launch: launch failed: %s\n", hipGetErrorName(le));
}
```

```cpp
#include <hip/hip_runtime.h>
#include <cstdio>
#include <cstdint>

#ifndef MK_N_LAUNCHES
#define MK_N_LAUNCHES 1
#endif

#ifndef DUP_MASK
#define DUP_MASK 0u
#endif

constexpr int D = 2048, DFF = 5632, NPR = 4 * 8192, NSR = 8 * 64, M = NPR + NSR;
constexpr int NSTREAM = 12, MODS = 9 * D, MODL = NSTREAM * MODS;
constexpr int AW = 1024;
constexpr float EPS = 1e-6f;

constexpr size_t MiB = 1u << 20;
constexpr size_t WS_CTL = 0, CTL_ZERO_BYTES = 64 * 1024;
constexpr size_t WS_VSTAT = 64 * 1024;
constexpr size_t WS_MOD = 1 * MiB;
constexpr size_t WS_SS = 3 * MiB;
constexpr size_t WS_SB = 4 * MiB + 512 * 1024;
constexpr size_t WS_WM = 4 * MiB;
constexpr size_t WS_WGU = 8 * MiB;
constexpr size_t WS_WD = 184 * MiB;
constexpr size_t WS_WIN = 272 * MiB;
constexpr size_t WS_WOUT = 288 * MiB;
constexpr size_t WS_WC = 296 * MiB;
constexpr size_t WS_HN = 300 * MiB;
constexpr size_t WS_ACT = 432 * MiB;
constexpr size_t WS_U = WS_ACT, WS_V = WS_ACT + 65 * MiB, WS_GLU = WS_ACT + 130 * MiB, WS_CAT = WS_ACT + 195 * MiB, WS_PC = WS_ACT;
constexpr size_t WS_SLAB = 790 * MiB;
constexpr size_t WS_MODP = 840 * MiB;
constexpr size_t WS_SSP = 870 * MiB;
constexpr size_t WS_VSP = 896 * MiB;
constexpr size_t WS_H = 904 * MiB;
constexpr size_t WS_END = 1036 * MiB;
static_assert(WS_H + (size_t)M * D * 2 <= WS_END, "h map");
static_assert(WS_MODP + (size_t)16 * 2 * MODL * 4 <= WS_SSP && WS_SSP + (size_t)6 * M * 32 * 4 <= WS_VSP && WS_VSP + (size_t)M * 32 * 4 <= WS_END, "partials map");
constexpr size_t WS_DUMMY = 1036 * MiB;
static_assert(WS_SLAB + (size_t)11 * NSR * D * 4 <= WS_END, "slab map");
static_assert(WS_VSTAT + (size_t)M * 8 <= WS_MOD && WS_MOD + (size_t)2 * MODL * 4 <= WS_SS && WS_SS + (size_t)6 * M * 4 <= 4 * MiB && WS_WM + 4 * 128 * 128 * 2 <= WS_SB && WS_SB + (size_t)5 * 12 * 11264 * 4 <= WS_WGU, "ctl map");
static_assert(WS_WGU + 4 * (size_t)11264 * 2048 * 2 <= WS_WD && WS_WD + 4 * (size_t)2048 * 5632 * 2 <= WS_WIN && WS_WIN + (size_t)4096 * 2048 * 2 <= WS_WOUT, "weights map");
static_assert(WS_HN + (size_t)M * D * 2 <= WS_ACT && WS_ACT + (size_t)M * DFF * 2 <= WS_END && WS_CAT + (size_t)M * D * 2 <= WS_END && (size_t)M * AW * 2 <= 65 * MiB, "act map");
constexpr int CW_TMO = 0, CW_BAR = 4096;

constexpr size_t O_Y = 0, O_NCP = (size_t)M * D, O_NCS = O_NCP + 4 * 30 * 1024, O_NPP = O_NCS + 8 * 30 * 1024, O_NPS = O_NPP + 4 * 15 * 2048, O_NAV = O_NPS + 8 * 15 * 2048, O_END = O_NAV + 8 * 64 * 1024;

constexpr int RING_BYTES = 131072, LDSCTL_OFF = RING_BYTES, MISC_OFF = LDSCTL_OFF + 320, EPI_OFF = RING_BYTES + 1024, LDS_BYTES = 147456;
static_assert(MISC_OFF + 128 <= EPI_OFF && EPI_OFF + 8 * 1024 <= LDS_BYTES, "LDS map");
constexpr int NWAVES = 8, NCU = 256;

#define GAS __attribute__((address_space(1)))
#define LAS __attribute__((address_space(3)))
typedef unsigned short bf16;
typedef unsigned v4u __attribute__((ext_vector_type(4)));
typedef unsigned v2u __attribute__((ext_vector_type(2)));
typedef float f32x4 __attribute__((ext_vector_type(4)));
typedef float f32x2 __attribute__((ext_vector_type(2)));
typedef short bf16x8 __attribute__((ext_vector_type(8)));
#define LDS_WAIT() asm volatile("s_waitcnt lgkmcnt(0)" ::: "memory")
#define VM_WAIT() asm volatile("s_waitcnt vmcnt(0)" ::: "memory")

__device__ __forceinline__ unsigned f2bf(float f) { unsigned u = __builtin_bit_cast(unsigned, f); return (u + 0x7fffu + ((u >> 16) & 1u)) >> 16; }
__device__ __forceinline__ unsigned pk2(float lo, float hi) { unsigned r; asm("v_cvt_pk_bf16_f32 %0, %1, %2" : "=v"(r) : "v"(lo), "v"(hi)); return r; }
__device__ __forceinline__ unsigned cvt_pk_bf16(float lo, float hi) { unsigned r; asm volatile("v_cvt_pk_bf16_f32 %0, %1, %2" : "=v"(r) : "v"(lo), "v"(hi)); return r; }
__device__ __forceinline__ float bflo(unsigned w) { return __builtin_bit_cast(float, w << 16); }
__device__ __forceinline__ float bfhi(unsigned w) { return __builtin_bit_cast(float, w & 0xffff0000u); }
__device__ __forceinline__ float sigmoidf_(float x) { return __builtin_amdgcn_rcpf(1.0f + __builtin_amdgcn_exp2f(-1.4426950409f * x)); }
__device__ __forceinline__ float siluf_(float x) { return x * sigmoidf_(x); }
__device__ __forceinline__ float gelu_tanh(float x) { return x * __builtin_amdgcn_rcpf(1.0f + __builtin_amdgcn_exp2f(-2.302208198f * x * (1.0f + 0.044715f * x * x))); }
template <int CTRL, int RMASK> __device__ __forceinline__ float dpp_add(float v) { return v + __builtin_bit_cast(float, __builtin_amdgcn_update_dpp(0, __builtin_bit_cast(int, v), CTRL, RMASK, 0xf, true)); }
__device__ __forceinline__ float wave_sum(float v) {
    v = dpp_add<0xB1, 0xf>(v);
    v = dpp_add<0x4E, 0xf>(v);
    v = dpp_add<0x141, 0xf>(v);
    v = dpp_add<0x140, 0xf>(v);
    v = dpp_add<0x142, 0xa>(v);
    v = dpp_add<0x143, 0xc>(v);
    return __builtin_bit_cast(float, __builtin_amdgcn_readlane(__builtin_bit_cast(int, v), 63));
}
__device__ __forceinline__ int stream_of_row(int r) { return r < NPR ? (r >> 13) : 4 + ((r - NPR) >> 6); }

namespace pg8 {
typedef unsigned short bf16_t;
constexpr int BM = 256, BK = 64, HALF = 128, HTB = HALF * BK * 2, STAGE_BYTES = 8 * HTB, NXCD = 8, WGM = 8;
__host__ __device__ __forceinline__ int lds_byte(int r, int c) { const int st = (r >> 4) * 2 + (c >> 5), rr = r & 15, cc = c & 31, ob = rr * 64 + cc * 2; return st * 1024 + (ob ^ (((ob >> 9) & 1) << 5)); }
__host__ __device__ __forceinline__ void stage_rc(int b, int& R, int& C) { const int st = b / 1024, sb = b % 1024, swz = sb ^ (((sb >> 9) & 1) << 5); R = (st >> 1) * 16 + swz / 64; C = (st & 1) * 32 + (swz % 64) / 2; }
__host__ __device__ __forceinline__ int perm32(int rho) { const int n = rho >> 4, i = rho & 15; return 8 * (i >> 2) + 4 * n + (i & 3); }

struct Unit { int pm, pn, kt0, ktn, slab; };
struct Gemm { const bf16_t* A; const bf16_t* Bt; int M, N, K, lda, tpg; };

struct StaticOrder {
    int nMp, nMt, nN, nwgP, nTail, G, c, ntk, ksplit, ktper, wgm;
    __host__ __device__ void init(int Mp, int Mt, int N_, int K_, int G_, int c_, int ksplit_, int wgm_ = WGM) { wgm = wgm_; nMp = Mp / BM; nMt = Mt / BM; nN = N_ / BM; nwgP = nMp * nN; G = G_; c = c_; ntk = K_ / BK; ksplit = ksplit_; ktper = ntk / ksplit_; nTail = nMt * nN * ksplit_; }
    __host__ __device__ bool next(int i, Unit& u) const {
        const long L = (long)i * G + c;
        if (L < nwgP) {
            int wgid = (int)L; { const int q = nwgP / NXCD, r = nwgP % NXCD, xcd = wgid % NXCD, off = wgid / NXCD; wgid = (xcd < r ? xcd * (q + 1) : r * (q + 1) + (xcd - r) * q) + off; }
            const int nig = wgm * nN, gid = wgid / nig, fm = gid * wgm, gsz = (nMp - fm) < wgm ? (nMp - fm) : wgm;
            u.pm = fm + ((wgid % nig) % gsz); u.pn = (wgid % nig) / gsz; u.kt0 = 0; u.ktn = ntk; u.slab = -1; return true;
        }
        if (L >= (long)nwgP + G) return false;
        const int cc = (int)(L - nwgP);
        const long j = (G % NXCD == 0) ? (long)(cc % NXCD) * (G / NXCD) + cc / NXCD : (long)cc; if (j >= nTail) return false;
        const int kc = (int)j % ksplit, t = (int)j / ksplit;
        u.pm = nMp + t % nMt; u.pn = t / nMt; u.kt0 = kc * ktper;
        u.ktn = ktper; u.slab = ksplit > 1 ? kc : -1; return true;
    }
};


struct EpiSwiGLU {
    static constexpr bool PERM = true; static constexpr int NEPI = 4, NVM = 8;
    bf16_t* O; int ldc; const float* ss; const float* sb;
    __device__ __forceinline__ bool fused() const { return ss != nullptr; }
    __device__ __forceinline__ void stage(const Unit& u, LAS unsigned char* area, int wr, int wc, int lane) const {
        const int rb0 = u.pm * BM + wr * 64, rb1 = rb0 + HALF, wrow = u.pn * BM + wc * 32 + (lane & 31) + (lane >> 5) * HALF;
        __builtin_amdgcn_global_load_lds((const unsigned*)(ss + rb0 + lane), (LAS unsigned*)(area), 4, 0, 0);
        __builtin_amdgcn_global_load_lds((const unsigned*)(ss + rb1 + lane), (LAS unsigned*)(area + 256), 4, 0, 0);
        __builtin_amdgcn_global_load_lds((const unsigned*)(sb + (size_t)stream_of_row(rb0) * 11264 + wrow), (LAS unsigned*)(area + 512), 4, 0, 0);
        __builtin_amdgcn_global_load_lds((const unsigned*)(sb + (size_t)stream_of_row(rb1) * 11264 + wrow), (LAS unsigned*)(area + 768), 4, 0, 0);
    }
    __device__ __forceinline__ void operator()(const f32x4 (&acc)[2][2][4][2], const Unit& u, int wr, int wc, int fr, int fq, const LAS unsigned char* area) const {
        const int row0 = u.pm * BM + wr * 64 + fr, col0 = u.pn * HALF + wc * 32 + 8 * fq;
#pragma unroll
        for (int ai = 0; ai < 2; ++ai) {
            constexpr float KG = -1.4426950409f, KU = -0.6931471806f;
            f32x4 sg0 = (f32x4){0.f, 0.f, 0.f, 0.f}, sg1 = sg0, su0 = sg0, su1 = sg0;
            if (ss) { const LAS float* sp = (const LAS float*)(area + 512 + ai * 256) + 8 * fq; sg0 = *(const LAS f32x4*)sp * KG; sg1 = *(const LAS f32x4*)(sp + 4) * KG; su0 = *(const LAS f32x4*)(sp + 32) * KU; su1 = *(const LAS f32x4*)(sp + 36) * KU; }
#pragma unroll
            for (int m = 0; m < 4; ++m) {
                const int r = row0 + ai * HALF + m * 16;
                const float rstd = ss ? __builtin_amdgcn_rsqf(((const LAS float*)(area + ai * 256))[m * 16 + fr] * (1.0f / D) + EPS) : 1.0f;
                bf16_t* rowp = O + (size_t)r * ldc + col0;
                const float rg = rstd * KG, ru = rstd * KU;
                const f32x4 g0 = acc[ai][0][m][0] * rg + sg0, g1 = acc[ai][0][m][1] * rg + sg1, u0 = acc[ai][1][m][0] * ru + su0, u1 = acc[ai][1][m][1] * ru + su1;
                const f32x4 t0 = g0, t1 = g1;
                const f32x4 e0 = (f32x4){__builtin_amdgcn_exp2f(t0[0]), __builtin_amdgcn_exp2f(t0[1]), __builtin_amdgcn_exp2f(t0[2]), __builtin_amdgcn_exp2f(t0[3])} + 1.0f;
                const f32x4 e1 = (f32x4){__builtin_amdgcn_exp2f(t1[0]), __builtin_amdgcn_exp2f(t1[1]), __builtin_amdgcn_exp2f(t1[2]), __builtin_amdgcn_exp2f(t1[3])} + 1.0f;
                const f32x4 o0 = (g0 * u0) * (f32x4){__builtin_amdgcn_rcpf(e0[0]), __builtin_amdgcn_rcpf(e0[1]), __builtin_amdgcn_rcpf(e0[2]), __builtin_amdgcn_rcpf(e0[3])};
                const f32x4 o1 = (g1 * u1) * (f32x4){__builtin_amdgcn_rcpf(e1[0]), __builtin_amdgcn_rcpf(e1[1]), __builtin_amdgcn_rcpf(e1[2]), __builtin_amdgcn_rcpf(e1[3])};
                v4u w;
                w.x = cvt_pk_bf16(o0[0], o0[1]); w.y = cvt_pk_bf16(o0[2], o0[3]); w.z = cvt_pk_bf16(o1[0], o1[1]); w.w = cvt_pk_bf16(o1[2], o1[3]);
                __builtin_nontemporal_store(w, (v4u*)rowp);
            }
        }
    }
};

struct EpiNull {
    static constexpr bool PERM = true; static constexpr int NEPI = 0, NVM = 0;
    __device__ __forceinline__ bool fused() const { return false; }
    __device__ __forceinline__ void stage(const Unit&, LAS unsigned char*, int, int, int) const {}
    __device__ __forceinline__ void operator()(const f32x4 (&acc)[2][2][4][2], const Unit&, int, int, int, int, const LAS unsigned char*) const {
#pragma unroll
        for (int a = 0; a < 2; ++a)
#pragma unroll
            for (int b = 0; b < 2; ++b)
#pragma unroll
                for (int m = 0; m < 4; ++m)
#pragma unroll
                    for (int n = 0; n < 2; ++n) asm volatile("" :: "v"(acc[a][b][m][n]));
    }
};

template <bool HB> struct EpiRes {
    static constexpr bool PERM = true;
    const void* base_p; const void* base_s; bf16_t* out; const float* gate; const float* bias; const float* cs; float* slab; bf16_t* an; const float* ng_n; const float* sc_n; float* ss; float alpha; int base_f32;
    static constexpr int NEPI = 0, NVM = 0;
    __device__ __forceinline__ bool fused() const { return false; }
    __device__ __forceinline__ void stage(const Unit&, LAS unsigned char*, int, int, int) const {}
    __device__ __forceinline__ void operator()(const f32x4 (&acc)[2][2][4][2], const Unit& u, int wr, int wc, int fr, int fq, const LAS unsigned char*) const {
        const int col0 = u.pn * BM + wc * 32 + 8 * fq;
#pragma unroll
        for (int ai = 0; ai < 2; ++ai) {
            const int rbase = u.pm * BM + ai * HALF + wr * 64;
            const int s = stream_of_row(rbase);
            float q[4] = {0.f, 0.f, 0.f, 0.f};
            v4u bw8[2][4];
            if (u.slab < 0 && !base_f32) {
                const bf16_t* bp = (const bf16_t*)((rbase < NPR) ? base_p : base_s) + ((rbase < NPR) ? (size_t)(rbase + fr) : (size_t)(rbase + fr - NPR)) * D + col0;
#pragma unroll
                for (int bj = 0; bj < 2; ++bj)
#pragma unroll
                    for (int m = 0; m < 4; ++m) bw8[bj][m] = *(const v4u*)(bp + (size_t)m * 16 * D + bj * HALF);
            } else {
#pragma unroll
                for (int bj = 0; bj < 2; ++bj)
#pragma unroll
                    for (int m = 0; m < 4; ++m) bw8[bj][m] = (v4u){0u, 0u, 0u, 0u}; }
#pragma unroll
            for (int bj = 0; bj < 2; ++bj) {
                const int c = col0 + bj * HALF;
                f32x4 gv[2], bv[2], gn[2];
#pragma unroll
                for (int n = 0; n < 2; ++n) { gv[n] = *(const f32x4*)(gate + (size_t)s * MODS + c + 4 * n) * alpha; bv[n] = (f32x4){0.f, 0.f, 0.f, 0.f}; gn[n] = bv[n];
                    if (HB) { gv[n] = gv[n] * *(const f32x4*)(cs + c + 4 * n); bv[n] = *(const f32x4*)(bias + c + 4 * n); }
                    if (an) gn[n] = *(const f32x4*)(ng_n + c + 4 * n) * (*(const f32x4*)(sc_n + (size_t)s * MODS + c + 4 * n) + 1.0f); }
#pragma unroll
                for (int mh = 0; mh < 2; ++mh) {
                f32x4 bf4[2][2];
                if (u.slab < 0 && base_f32) {
                    const float* bp = (const float*)((rbase < NPR) ? base_p : base_s) + ((rbase < NPR) ? (size_t)(rbase + fr) : (size_t)(rbase + fr - NPR)) * D + c;
#pragma unroll
                    for (int mm = 0; mm < 2; ++mm) { bf4[mm][0] = *(const f32x4*)(bp + (size_t)(2 * mh + mm) * 16 * D); bf4[mm][1] = *(const f32x4*)(bp + (size_t)(2 * mh + mm) * 16 * D + 4); }
                } else {
#pragma unroll
                    for (int mm = 0; mm < 2; ++mm) { bf4[mm][0] = (f32x4){0.f, 0.f, 0.f, 0.f}; bf4[mm][1] = bf4[mm][0]; } }
#pragma unroll
                for (int mm = 0; mm < 2; ++mm) { const int m = 2 * mh + mm;
                    const int r = rbase + m * 16 + fr;
                    if (u.slab >= 0) {
                        float* sp = slab + ((size_t)u.slab * NSR + (size_t)(r - NPR)) * D + c;
                        *(f32x4*)sp = gv[0] * (HB ? acc[ai][bj][m][0] + bv[0] : acc[ai][bj][m][0]); *(f32x4*)(sp + 4) = gv[1] * (HB ? acc[ai][bj][m][1] + bv[1] : acc[ai][bj][m][1]);
                    } else {
                        const size_t boff = ((rbase < NPR) ? (size_t)r : (size_t)(r - NPR)) * D + c; const void* bb = (rbase < NPR) ? base_p : base_s;
                        f32x4 b0, b1;
                        if (base_f32) { b0 = bf4[mm][0]; b1 = bf4[mm][1]; }
                        else { const v4u bw = bw8[bj][m]; b0 = (f32x4){bflo(bw.x), bfhi(bw.x), bflo(bw.y), bfhi(bw.y)}; b1 = (f32x4){bflo(bw.z), bfhi(bw.z), bflo(bw.w), bfhi(bw.w)}; }
                        const f32x4 o0 = b0 + gv[0] * (HB ? acc[ai][bj][m][0] + bv[0] : acc[ai][bj][m][0]), o1 = b1 + gv[1] * (HB ? acc[ai][bj][m][1] + bv[1] : acc[ai][bj][m][1]);
                        { v4u ow; ow.x = cvt_pk_bf16(o0[0], o0[1]); ow.y = cvt_pk_bf16(o0[2], o0[3]); ow.z = cvt_pk_bf16(o1[0], o1[1]); ow.w = cvt_pk_bf16(o1[2], o1[3]); *(v4u*)(out + (size_t)r * D + c) = ow; }
                        if (ss) { const f32x4 sq = o0 * o0 + o1 * o1; q[m] += (sq[0] + sq[1]) + (sq[2] + sq[3]); }
                        if (an) { const f32x4 t0 = o0 * gn[0], t1 = o1 * gn[1]; v4u w; w.x = cvt_pk_bf16(t0[0], t0[1]); w.y = cvt_pk_bf16(t0[2], t0[3]); w.z = cvt_pk_bf16(t1[0], t1[1]); w.w = cvt_pk_bf16(t1[2], t1[3]);
                            *(v4u*)(an + (size_t)r * D + c) = w; }
                    }
                }
                }
            }
            if (ss && u.slab < 0) {
#pragma unroll
                for (int m = 0; m < 4; ++m) { float t = q[m]; t += __shfl_xor(t, 16); t += __shfl_xor(t, 32); if (fq == 0) ss[(size_t)(rbase + m * 16 + fr) * 32 + u.pn * 4 + wc] = t; } }
        }
    }
};

struct EpiInProj {
    static constexpr bool PERM = true;
    bf16_t *U, *V, *GLU; float* vstat; float* ncp; float* ncs; const float* ss; const float* sb;
    static constexpr int NEPI = 4, NVM = 8;
    __device__ __forceinline__ bool fused() const { return true; }
    __device__ __forceinline__ void stage(const Unit& u, LAS unsigned char* area, int wr, int wc, int lane) const {
        const int rb0 = u.pm * BM + wr * 64, rb1 = rb0 + HALF, wrow = u.pn * BM + wc * 32 + (lane & 31) + (lane >> 5) * HALF;
        __builtin_amdgcn_global_load_lds((const unsigned*)(ss + rb0 + lane), (LAS unsigned*)(area), 4, 0, 0);
        __builtin_amdgcn_global_load_lds((const unsigned*)(ss + rb1 + lane), (LAS unsigned*)(area + 256), 4, 0, 0);
        __builtin_amdgcn_global_load_lds((const unsigned*)(sb + (size_t)stream_of_row(rb0) * 4096 + wrow), (LAS unsigned*)(area + 512), 4, 0, 0);
        __builtin_amdgcn_global_load_lds((const unsigned*)(sb + (size_t)stream_of_row(rb1) * 4096 + wrow), (LAS unsigned*)(area + 768), 4, 0, 0);
    }
    __device__ __forceinline__ void operator()(const f32x4 (&acc)[2][2][4][2], const Unit& u, int wr, int wc, int fr, int fq, const LAS unsigned char* area) const {
        const int row0 = u.pm * BM + wr * 64 + fr;
        if (u.pn < 8) {
            const bool isv = u.pn >= 4; bf16_t* O = isv ? V : U; const int col0 = (u.pn & 3) * BM + wc * 32 + 8 * fq;
#pragma unroll
            for (int ai = 0; ai < 2; ++ai) {
                const LAS float* sp = (const LAS float*)(area + 512 + ai * 256) + 8 * fq;
                f32x4 sv[2][2];
#pragma unroll
                for (int bj = 0; bj < 2; ++bj) { sv[bj][0] = *(const LAS f32x4*)(sp + bj * 32); sv[bj][1] = *(const LAS f32x4*)(sp + bj * 32 + 4); }
#pragma unroll
                for (int m = 0; m < 4; ++m) { const int r = row0 + ai * HALF + m * 16; float s1 = 0.f, s2 = 0.f;
                    const float rstd = __builtin_amdgcn_rsqf(((const LAS float*)(area + ai * 256))[m * 16 + fr] * (1.0f / D) + EPS);
#pragma unroll
                    for (int bj = 0; bj < 2; ++bj) { f32x4 v0 = acc[ai][bj][m][0] * rstd + sv[bj][0], v1 = acc[ai][bj][m][1] * rstd + sv[bj][1];
#pragma unroll
                        for (int h2 = 0; h2 < 2; ++h2) { f32x4& x = h2 ? v1 : v0;
                            const f32x4 t = (x * -2.302208198f) * (x * x * 0.044715f + 1.0f);
                            const f32x4 d = (f32x4){__builtin_amdgcn_exp2f(t[0]), __builtin_amdgcn_exp2f(t[1]), __builtin_amdgcn_exp2f(t[2]), __builtin_amdgcn_exp2f(t[3])} + 1.0f;
                            x = x * (f32x4){__builtin_amdgcn_rcpf(d[0]), __builtin_amdgcn_rcpf(d[1]), __builtin_amdgcn_rcpf(d[2]), __builtin_amdgcn_rcpf(d[3])}; }
                        { const f32x4 a1 = v0 + v1, a2 = v0 * v0 + v1 * v1; s1 += (a1[0] + a1[1]) + (a1[2] + a1[3]); s2 += (a2[0] + a2[1]) + (a2[2] + a2[3]); }
                        v4u w; w.x = cvt_pk_bf16(v0[0], v0[1]); w.y = cvt_pk_bf16(v0[2], v0[3]); w.z = cvt_pk_bf16(v1[0], v1[1]); w.w = cvt_pk_bf16(v1[2], v1[3]);
                        *(v4u*)(O + (size_t)r * AW + col0 + bj * HALF) = w; }
                    if (isv) { s1 += __shfl_xor(s1, 16); s1 += __shfl_xor(s1, 32); s2 += __shfl_xor(s2, 16); s2 += __shfl_xor(s2, 32);
                        if (fq == 0) *(f32x2*)(vstat + ((size_t)r * 16 + (u.pn - 4) * 4 + wc) * 2) = (f32x2){s1, s2}; }
                }
            }
        } else {
            const int col0 = (u.pn - 8) * HALF + wc * 32 + 8 * fq;
#pragma unroll
            for (int ai = 0; ai < 2; ++ai) {
                const int rbase = u.pm * BM + ai * HALF + wr * 64;
                const bool tailp = (rbase < NPR) && ((rbase & 8191) == 8128), tails = rbase >= NPR;
                const LAS float* sp = (const LAS float*)(area + 512 + ai * 256) + 8 * fq;
                const f32x4 sa0 = *(const LAS f32x4*)sp, sa1 = *(const LAS f32x4*)(sp + 4), sg0 = *(const LAS f32x4*)(sp + 32), sg1 = *(const LAS f32x4*)(sp + 36);
#pragma unroll
                for (int m = 0; m < 4; ++m) { const int r = rbase + m * 16 + fr;
                    const float rstd = __builtin_amdgcn_rsqf(((const LAS float*)(area + ai * 256))[m * 16 + fr] * (1.0f / D) + EPS);
                    const f32x4 a0 = acc[ai][0][m][0] * rstd + sa0, a1 = acc[ai][0][m][1] * rstd + sa1, g0 = acc[ai][1][m][0] * rstd + sg0, g1 = acc[ai][1][m][1] * rstd + sg1;
                    f32x4 o0, o1;
#pragma unroll
                    for (int h2 = 0; h2 < 2; ++h2) { const f32x4 g = h2 ? g1 : g0, t = g * -1.4426950409f;
                        const f32x4 d = (f32x4){__builtin_amdgcn_exp2f(t[0]), __builtin_amdgcn_exp2f(t[1]), __builtin_amdgcn_exp2f(t[2]), __builtin_amdgcn_exp2f(t[3])} + 1.0f;
                        const f32x4 o = (h2 ? a1 : a0) * (f32x4){__builtin_amdgcn_rcpf(d[0]), __builtin_amdgcn_rcpf(d[1]), __builtin_amdgcn_rcpf(d[2]), __builtin_amdgcn_rcpf(d[3])};
                        if (h2) o1 = o; else o0 = o; }
                    v4u w; w.x = cvt_pk_bf16(o0[0], o0[1]); w.y = cvt_pk_bf16(o0[2], o0[3]); w.z = cvt_pk_bf16(o1[0], o1[1]); w.w = cvt_pk_bf16(o1[2], o1[3]);
                    *(v4u*)(GLU + (size_t)r * AW + col0) = w;
                    if (tailp) { const int t = r & 8191; if (t >= 8162) { float* dst = ncp + ((size_t)((r >> 13) * 30 + (t - 8162)) * 1024 + col0); *(f32x4*)dst = o0; *(f32x4*)(dst + 4) = o1; } }
                    if (tails) { const int rr = r - NPR, t = rr & 63; if (t >= 34) { float* dst = ncs + ((size_t)((rr >> 6) * 30 + (t - 34)) * 1024 + col0); *(f32x4*)dst = o0; *(f32x4*)(dst + 4) = o1; } }
                }
            }
        }
    }
};

template <int NR> __device__ __forceinline__ void wait_vm_sel(int sel) { asm volatile("v_cmp_ne_u32_e32 vcc, 0, %0\n\ts_nop 4\n\ts_cbranch_vccz 1f\n\ts_waitcnt vmcnt(%1)\n\ts_branch 2f\n1:\n\ts_waitcnt vmcnt(8)\n2:" :: "v"(sel), "n"(NR) : "memory", "vcc"); }
template <class Epi, bool ALIGN_EPI>
__device__ __forceinline__ void gemm_phase(LAS unsigned char* lds, const Gemm g, const StaticOrder& S, const Epi& E, unsigned stagger_ticks = 0u) {
    int tid_ = threadIdx.x; asm volatile("" : "+v"(tid_));
    const int tid = tid_, wid = __builtin_amdgcn_readfirstlane(tid >> 6), lane = tid & 63, wr = wid >> 2, wc = wid & 3, fr = lane & 15, fq = lane >> 4;
    const int K = g.K;
    unsigned voffA[2], voffB[2];
#pragma unroll
    for (int i = 0; i < 2; ++i) { int R, C; stage_rc(tid * 16 + i * 8192, R, C); const int Rb = Epi::PERM ? ((R & ~31) + perm32(R & 31)) : R;
        voffA[i] = (unsigned)(R * g.lda + C) * 2u; voffB[i] = (unsigned)(Rb * K + C) * 2u; }
    const size_t kstep = (size_t)(BK * 2);
    const size_t hA = (size_t)HALF * g.lda * 2, hB = (size_t)HALF * K * 2;
    const size_t tA = 2 * hA, tB = 2 * hB;
    const unsigned ldsw = (unsigned)wid * 1024u;
    const int aoff = lds_byte(wr * 64 + fr, fq * 8), boff = lds_byte(wc * 32 + fr, fq * 8);
#define PG8_SA(b, h) (((b) * 2 + (h)) * HTB)
#define PG8_SB(b, h) ((4 + (b) * 2 + (h)) * HTB)
#define PG8_STAGE(bufoff, gbase, voff) do { _Pragma("unroll") for (int _i = 0; _i < 2; ++_i) \
        __builtin_amdgcn_global_load_lds((const unsigned*)((const char*)(gbase) + (voff)[_i]), (LAS unsigned*)(lds + (bufoff) + ldsw + _i * 8192), 16, 0, 0); } while (0)
#define PG8_LDA(dst, b, h) do { _Pragma("unroll") for (int m = 0; m < 4; ++m) _Pragma("unroll") for (int k = 0; k < 2; ++k) dst[m][k] = *(const LAS bf16x8*)(lds + PG8_SA(b, h) + aoff + m * 2048 + k * 1024); } while (0)
#define PG8_LDB(dst, b, h) do { _Pragma("unroll") for (int n = 0; n < 2; ++n) _Pragma("unroll") for (int k = 0; k < 2; ++k) dst[n][k] = *(const LAS bf16x8*)(lds + PG8_SB(b, h) + boff + n * 2048 + k * 1024); } while (0)
#define PG8_MMA(ai, bj, At, Bt) do { __builtin_amdgcn_s_setprio(1); _Pragma("unroll") for (int m = 0; m < 4; ++m) _Pragma("unroll") for (int n = 0; n < 2; ++n) _Pragma("unroll") for (int k = 0; k < 2; ++k) \
        acc[ai][bj][m][n] = __builtin_amdgcn_mfma_f32_16x16x32_bf16(Bt[n][k], At[m][k], acc[ai][bj][m][n], 0, 0, 0); __builtin_amdgcn_s_setprio(0); } while (0)
#define PG8_WAIT_V(n) asm volatile("s_waitcnt vmcnt(" #n ")" ::: "memory")
#define PG8_WAIT_L(n) asm volatile("s_waitcnt lgkmcnt(" #n ")" ::: "memory")
#define PG8_BAR __builtin_amdgcn_s_barrier()
#define PG8_SCHED __builtin_amdgcn_sched_barrier(0)
#define PG8_APTR(u) ((const char*)g.A + (size_t)(u).pm * tA + (g.tpg ? (size_t)((u).pn / g.tpg) * (size_t)K * 2 : (size_t)0) + (size_t)(u).kt0 * kstep)
#define PG8_BPTR(u) ((const char*)g.Bt + (size_t)(u).pn * tB + (size_t)(u).kt0 * kstep)
    Unit cur, nxt; int ui = 0;
    if (!S.next(0, cur)) return;
    if (stagger_ticks) { const unsigned long long t0 = __builtin_amdgcn_s_memrealtime(); while (__builtin_amdgcn_s_memrealtime() - t0 < (unsigned long long)stagger_ticks) __builtin_amdgcn_s_sleep(16); }
    f32x4 acc[2][2][4][2];
#pragma unroll
    for (int a = 0; a < 2; ++a)
#pragma unroll
        for (int b = 0; b < 2; ++b)
#pragma unroll
            for (int m = 0; m < 4; ++m)
#pragma unroll
                for (int n = 0; n < 2; ++n) acc[a][b][m][n] = (f32x4){0.f, 0.f, 0.f, 0.f};
    bf16x8 At[4][2], B0[2][2], B1[2][2];
    const char* cA = PG8_APTR(cur); const char* cB = PG8_BPTR(cur);
    LAS unsigned char* area = lds + EPI_OFF + wid * 1024;
    const bool epi_dma = Epi::NEPI > 0 && E.fused();
    if (epi_dma) E.stage(cur, area, wr, wc, lane);
    PG8_STAGE(PG8_SB(0, 0), cB, voffB); PG8_STAGE(PG8_SB(0, 1), cB + hB, voffB); PG8_STAGE(PG8_SA(0, 0), cA, voffA); PG8_STAGE(PG8_SA(0, 1), cA + hA, voffA);
    if (wr == 1) PG8_BAR;
    PG8_WAIT_V(2); PG8_BAR;
    PG8_STAGE(PG8_SB(1, 0), cB + kstep, voffB); PG8_STAGE(PG8_SA(1, 0), cA + kstep, voffA); PG8_STAGE(PG8_SB(1, 1), cB + hB + kstep, voffB);
    PG8_WAIT_V(6); PG8_BAR;
    for (;;) {
        const bool has_next = S.next(ui + 1, nxt);
        const char* nA = has_next ? PG8_APTR(nxt) : cA; const char* nB = has_next ? PG8_BPTR(nxt) : cB;
        const int nt = cur.ktn;
        for (int t = 0; t < nt; t += 2) {
            const bool last = (t == nt - 2);
            const char* a1 = cA + (size_t)(t + 1) * kstep;
            const char* a2 = last ? nA : cA + (size_t)(t + 2) * kstep; const char* b2 = last ? nB : cB + (size_t)(t + 2) * kstep;
            const char* a3 = a2 + kstep; const char* b3 = b2 + kstep;
            const int first = (t == 0 && ui > 0 && epi_dma) ? 1 : 0;
            PG8_LDB(B0, 0, 0); PG8_LDB(B1, 0, 1); PG8_SCHED; PG8_LDA(At, 0, 0); PG8_STAGE(PG8_SA(1, 1), a1 + hA, voffA);
            wait_vm_sel<8 + Epi::NEPI + Epi::NVM>(first); PG8_WAIT_L(0); PG8_BAR; PG8_MMA(0, 0, At, B0); PG8_MMA(0, 1, At, B1); PG8_BAR; PG8_SCHED;
            PG8_LDA(At, 0, 1); PG8_STAGE(PG8_SB(0, 0), b2, voffB); PG8_STAGE(PG8_SB(0, 1), b2 + hB, voffB); PG8_STAGE(PG8_SA(0, 0), a2, voffA);
            wait_vm_sel<8 + Epi::NEPI + Epi::NVM>(first); PG8_WAIT_L(0); PG8_BAR; PG8_MMA(1, 0, At, B0); PG8_MMA(1, 1, At, B1); PG8_BAR; PG8_SCHED;
            PG8_LDB(B0, 1, 0); PG8_LDB(B1, 1, 1); PG8_SCHED; PG8_LDA(At, 1, 0); PG8_STAGE(PG8_SA(0, 1), a2 + hA, voffA);
            PG8_WAIT_V(8); PG8_WAIT_L(0); PG8_BAR; PG8_MMA(0, 0, At, B0); PG8_MMA(0, 1, At, B1); PG8_BAR; PG8_SCHED;
            PG8_LDA(At, 1, 1); PG8_STAGE(PG8_SB(1, 0), b3, voffB); PG8_STAGE(PG8_SB(1, 1), b3 + hB, voffB); PG8_STAGE(PG8_SA(1, 0), a3, voffA);
            PG8_WAIT_V(8); PG8_WAIT_L(0); PG8_BAR; PG8_MMA(1, 0, At, B0); PG8_MMA(1, 1, At, B1); PG8_BAR; PG8_SCHED;
        }
        if constexpr (ALIGN_EPI) { if (wr == 0) PG8_BAR; }
        E(acc, cur, wr, wc, fr, fq, area);
        if (!has_next) break;
        if (epi_dma) E.stage(nxt, area, wr, wc, lane);
#pragma unroll
        for (int a = 0; a < 2; ++a)
#pragma unroll
            for (int b = 0; b < 2; ++b)
#pragma unroll
                for (int m = 0; m < 4; ++m)
#pragma unroll
                    for (int n = 0; n < 2; ++n) acc[a][b][m][n] = (f32x4){0.f, 0.f, 0.f, 0.f};
        cur = nxt; cA = nA; cB = nB; ++ui;
        if constexpr (ALIGN_EPI) { if (wr == 1) PG8_BAR; }
    }
    PG8_WAIT_V(0);
    if constexpr (!ALIGN_EPI) { if (wr == 0) PG8_BAR; }
    PG8_BAR;
#undef PG8_SA
#undef PG8_SB
#undef PG8_STAGE
#undef PG8_LDA
#undef PG8_LDB
#undef PG8_MMA
#undef PG8_WAIT_V
#undef PG8_WAIT_L
#undef PG8_BAR
#undef PG8_SCHED
#undef PG8_APTR
#undef PG8_BPTR
}
}

#define XB_TMO      128
#define XB_XCNT(j)  (256  + 64 * (j))
#define XB_XSUB(j)  (1280 + 64 * (j))
#define XB_XGEN(j)  (2304 + 64 * (j))
#define XB_TOP      3328
#define XB_TOPGEN   3392
#define XCD_BAR_WORDS 3456
#define XB_SPIN_CAP (1u << 18)
__device__ __forceinline__ unsigned xb_ld(unsigned* p)              { return __hip_atomic_load(p, __ATOMIC_RELAXED, __HIP_MEMORY_SCOPE_AGENT); }
__device__ __forceinline__ unsigned xb_add(unsigned* p, unsigned v) { return __hip_atomic_fetch_add(p, v, __ATOMIC_RELAXED, __HIP_MEMORY_SCOPE_AGENT); }
__device__ __forceinline__ unsigned xb_xcc_id() { return (unsigned)__builtin_amdgcn_s_getreg((3 << 11) | 20) & 0xFu; }
#define XB_SPIN(cond, bar) do { unsigned _sp = 0; while (cond) { __builtin_amdgcn_s_sleep(1); \
    if ((++_sp & 255u) == 0u) { if (xb_ld(&(bar)[XB_TMO])) break; if (_sp > XB_SPIN_CAP) { atomicAdd(&(bar)[XB_TMO], 1u); break; } } } } while (0)
struct XcdBarrier { unsigned* bar; unsigned x; volatile LAS unsigned* st; };
__device__ __forceinline__ XcdBarrier xcd_barrier_post(unsigned* bar, volatile LAS unsigned* st) {
    XcdBarrier b; b.bar = bar; b.x = xb_xcc_id(); b.st = st;
    if (threadIdx.x == 0) (void)xb_add(&bar[XB_XCNT(b.x)], 1u);
    return b;
}
__device__ __forceinline__ void xcd_barrier_complete(unsigned* bar, unsigned x, unsigned& nloc, unsigned& nx) {
    const unsigned G = gridDim.x * gridDim.y * gridDim.z;
    unsigned sum, cnt, mine, sp = 0u;
    for (;;) {
        sum = 0u; cnt = 0u; mine = 0u;
#pragma unroll
        for (unsigned j = 0; j < 16; ++j) { const unsigned c = xb_ld(&bar[XB_XCNT(j)]); sum += c; cnt += (c > 0u) ? 1u : 0u; mine = (j == x) ? c : mine; }
        if (sum == G) break;
        __builtin_amdgcn_s_sleep(1);
        if ((++sp & 255u) == 0u) { if (xb_ld(&bar[XB_TMO])) break; if (sp > XB_SPIN_CAP) { atomicAdd(&bar[XB_TMO], 1u); break; } }
    }
    nloc = mine > 0u ? mine : 1u; nx = cnt > 0u ? cnt : 1u;
}
__device__ __forceinline__ void xcd_barrier(const XcdBarrier& b) {
    asm volatile("s_waitcnt vmcnt(0)" ::: "memory");
    __syncthreads();
    if (threadIdx.x == 0) {
        unsigned* bar = b.bar;
        __builtin_amdgcn_s_waitcnt(0);
        unsigned nloc = b.st[0], nx = b.st[1];
        if (nloc == 0u) { xcd_barrier_complete(bar, b.x, nloc, nx); b.st[0] = nloc; b.st[1] = nx; }
        const unsigned old = xb_add(&bar[XB_XSUB(b.x)], 1u);
        const unsigned gen = old / nloc;
        if (old + 1u == (gen + 1u) * nloc) {
            __builtin_amdgcn_fence(__ATOMIC_RELEASE, "agent");
            asm volatile("s_waitcnt vmcnt(0)" ::: "memory");
            const unsigned og = xb_add(&bar[XB_TOP], 1u);
            const unsigned tg = og / nx;
            if (og + 1u == (tg + 1u) * nx) xb_add(&bar[XB_TOPGEN], 1u);
            else XB_SPIN(xb_ld(&bar[XB_TOPGEN]) == tg, bar);
            __builtin_amdgcn_fence(__ATOMIC_ACQUIRE, "agent");
            xb_add(&bar[XB_XGEN(b.x)], 1u);
            asm volatile("s_waitcnt vmcnt(0)" ::: "memory");
        } else {
            XB_SPIN(xb_ld(&bar[XB_XGEN(b.x)]) == gen, bar);
            __builtin_amdgcn_fence(__ATOMIC_ACQUIRE, "agent");
            asm volatile("s_waitcnt vmcnt(0)" ::: "memory");
        }
    }
    __syncthreads();
}

struct Args { const float* in[25]; float* out; unsigned char* ws; int ph_lo, ph_hi; };
typedef const __attribute__((address_space(4))) Args* CArgsP;
enum { I_XP = 0, I_XS, I_CP, I_CS, I_SCONV, I_SPOOL, I_ADAW, I_ADAB, I_NORMG, I_FNORMG, I_WG, I_WU, I_WD, I_WIN, I_AVG, I_AVB, I_AWS, I_ABS, I_BDW, I_BLNG, I_BLNB, I_WOUT, I_CW, I_CB, I_CSC };

__device__ __forceinline__ void p0_transpose_item(const float* W, int K, int N, bf16* WT, int dest0, LAS float* scr, int k0, int n0, int lane) {
    float v[32];
#pragma unroll
    for (int i = 0; i < 32; ++i) v[i] = __builtin_nontemporal_load(W + (size_t)(k0 + 2 * i + (lane >> 5)) * N + n0 + (lane & 31));
#pragma unroll
    for (int i = 0; i < 32; ++i) scr[(2 * i + (lane >> 5)) * 33 + (lane & 31)] = v[i];
    LDS_WAIT(); asm volatile("" ::: "memory");
    const int c = lane & 7;
#pragma unroll
    for (int j = 0; j < 4; ++j) { const int n = (lane >> 3) + 8 * j; const LAS float* s = scr + (8 * c) * 33 + n;
        v4u o; o.x = pk2(s[0 * 33], s[1 * 33]); o.y = pk2(s[2 * 33], s[3 * 33]); o.z = pk2(s[4 * 33], s[5 * 33]); o.w = pk2(s[6 * 33], s[7 * 33]);
        __builtin_nontemporal_store(o, (v4u*)(WT + (size_t)(dest0 + n) * K + k0 + 8 * c)); }
    LDS_WAIT(); asm volatile("" ::: "memory");
}
__device__ __forceinline__ void p0_ada_item(CArgsP a, float* mod, LAS float* scr, int idx, int lane) {
    const int ks = idx & 15, cb = (idx >> 4) % 72, l = idx / (16 * 72), k0 = ks * 128, n = cb * 256 + 4 * lane;
#pragma unroll
    for (int s = 0; s < NSTREAM; ++s)
#pragma unroll
        for (int h = 0; h < 2; ++h) { const int k = lane + 64 * h; const float cv = (s < 4) ? a->in[I_CP][s * D + k0 + k] : a->in[I_CS][(s - 4) * D + k0 + k]; scr[s * 128 + k] = siluf_(cv); }
    LDS_WAIT(); asm volatile("" ::: "memory");
    f32x4 acc[NSTREAM];
#pragma unroll
    for (int s = 0; s < NSTREAM; ++s) acc[s] = (f32x4){0.f, 0.f, 0.f, 0.f};
    const float* Wp = a->in[I_ADAW] + ((size_t)l * D + k0) * MODS + n;
    f32x4 wb[8], wn[8];
#pragma unroll
    for (int i = 0; i < 8; ++i) { wb[i] = *(const f32x4*)(Wp + (size_t)i * MODS); wn[i] = wb[i]; }
#pragma unroll 1
    for (int kb = 0; kb < 128; kb += 8) {
        if (kb + 8 < 128) {
#pragma unroll
            for (int i = 0; i < 8; ++i) wn[i] = *(const f32x4*)(Wp + (size_t)(kb + 8 + i) * MODS); }
#pragma unroll
        for (int i = 0; i < 8; ++i)
#pragma unroll
            for (int s = 0; s < NSTREAM; ++s) acc[s] += wb[i] * scr[s * 128 + kb + i];
#pragma unroll
        for (int i = 0; i < 8; ++i) wb[i] = wn[i];
    }
    if (ks == 0) { const f32x4 b = *(const f32x4*)(a->in[I_ADAB] + (size_t)l * MODS + n);
#pragma unroll
        for (int s = 0; s < NSTREAM; ++s) acc[s] += b; }
#pragma unroll
    for (int s = 0; s < NSTREAM; ++s) *(f32x4*)(mod + (size_t)ks * (2 * MODL) + (size_t)l * MODL + (size_t)s * MODS + n) = acc[s];
    LDS_WAIT(); asm volatile("" ::: "memory");
}
constexpr int P0_ADA = 2 * 72 * 16, P0_GU = 5632, P0_WD = 5632, P0_WIN = 4096, P0_WOUT = 2048, P0_WC = 128, P0_WM = 16;
constexpr int P0_TR = 2 * P0_GU + P0_WD + P0_WIN + P0_WOUT + 4 * P0_WC, P0_TOTAL = P0_ADA + P0_TR + P0_WM;
__device__ __forceinline__ void conv_gu_item(CArgsP a, unsigned char* ws, LAS float* scr, int f, int r, int lane) {
    const int up = r >= P0_GU, i2 = up ? r - P0_GU : r, kb = i2 / 176, nb = i2 % 176, n0 = 32 * nb;
    p0_transpose_item(a->in[up ? I_WU : I_WG] + (size_t)f * D * DFF, D, DFF, (bf16*)(ws + WS_WGU) + (size_t)f * 11264 * 2048, 256 * (n0 >> 7) + (n0 & 127) + (up ? 128 : 0), scr, 64 * kb, n0, lane);
}
__device__ __forceinline__ void conv_wd_item(CArgsP a, unsigned char* ws, LAS float* scr, int f, int r, int lane) {
    const int kb = r / 64, nb = r % 64;
    p0_transpose_item(a->in[I_WD] + (size_t)f * DFF * D, DFF, D, (bf16*)(ws + WS_WD) + (size_t)f * 2048 * 5632, 32 * nb, scr, 64 * kb, 32 * nb, lane);
}
__device__ __forceinline__ void conv_window(CArgsP a, LAS unsigned char* lds, int fgu, int fwd0, int fwd1, int rank, int nrank, int wave, int lane) {
    __syncthreads();
    LAS float* scr = (LAS float*)(lds + wave * 16384); unsigned char* ws = a->ws;
    const int ngu = fgu >= 0 ? 2 * P0_GU : 0, n1 = fwd0 >= 0 ? P0_WD : 0, n2 = fwd1 >= 0 ? P0_WD : 0;
#pragma unroll 1
    for (int it = rank * NWAVES + wave; it < ngu + n1 + n2; it += nrank * NWAVES) {
        if (it < ngu) conv_gu_item(a, ws, scr, fgu, it, lane);
        else if (it < ngu + n1) conv_wd_item(a, ws, scr, fwd0, it - ngu, lane);
        else conv_wd_item(a, ws, scr, fwd1, it - ngu - n1, lane);
    }
}
__device__ __forceinline__ void p0_prologue(CArgsP a, LAS unsigned char* lds, int gw, int NGW, int wave, int lane) {
    LAS float* scr = (LAS float*)(lds + wave * 16384);
    unsigned char* ws = a->ws;
    const int gwp = wave * (NGW / NWAVES) + gw / NWAVES, heavy = P0_ADA - NGW;
    p0_ada_item(a, (float*)(ws + WS_MODP), scr, gwp, lane);
    if (gwp < heavy) { p0_ada_item(a, (float*)(ws + WS_MODP), scr, NGW + gwp, lane); return; }
    for (int r0 = gwp - heavy; r0 < P0_TR + P0_WM; r0 += NGW - heavy) {
        int r = r0;
        if (r < 2 * P0_GU) { conv_gu_item(a, ws, scr, 0, r, lane); continue; }
        r -= 2 * P0_GU;
        if (r < P0_WD) { conv_wd_item(a, ws, scr, 0, r, lane); continue; }
        r -= P0_WD;
        if (r < P0_WIN) { const int kb = r / 128, nb = r % 128, n0 = 32 * nb; int d0;
            if (n0 < 2048) d0 = n0; else if (n0 < 3072) { const int j = n0 - 2048; d0 = 2048 + 256 * (j >> 7) + (j & 127); } else { const int j = n0 - 3072; d0 = 2048 + 256 * (j >> 7) + 128 + (j & 127); }
            p0_transpose_item(a->in[I_WIN], D, 4096, (bf16*)(ws + WS_WIN), d0, scr, 64 * kb, n0, lane); continue; }
        r -= P0_WIN;
        if (r < P0_WOUT) { const int kb = r / 64, nb = r % 64; p0_transpose_item(a->in[I_WOUT], D, D, (bf16*)(ws + WS_WOUT), 32 * nb, scr, 64 * kb, 32 * nb, lane); continue; }
        r -= P0_WOUT;
        if (r < 4 * P0_WC) { const int g = r / P0_WC, i2 = r % P0_WC, kb = i2 / 16, nb = i2 % 16;
            p0_transpose_item(a->in[I_CW] + (size_t)g * 512 * 512, 512, 512, (bf16*)(ws + WS_WC), g * 512 + 32 * nb, scr, 64 * kb, 32 * nb, lane); continue; }
        r -= 4 * P0_WC;
        { bf16* wm = (bf16*)(ws + WS_WM);
#pragma unroll 4
          for (int i = 0; i < 64; ++i) { const int idx = r * 4096 + i * 64 + lane, ii = (idx >> 7) & 127, jj = idx & 127; const float v = a->in[I_AWS][idx]; wm[idx] = (bf16)(((jj >> 6) <= (ii >> 6)) ? f2bf(v) : 0u); } }
    }
}

__device__ __forceinline__ void thin_norm(const float* hp, const float* hs, const float* ng, const float* shift, const float* scale, bf16* HN, int gw, int NGW, int lane) {
    const int r0 = (int)(((long)gw * M) / NGW), r1 = (int)(((long)(gw + 1) * M) / NGW);
    int cur_s = -1; f32x4 gs[8], sh[8], v[8], vn[8];
#pragma unroll
    for (int j = 0; j < 8; ++j) { gs[j] = (f32x4){0.f, 0.f, 0.f, 0.f}; sh[j] = gs[j]; v[j] = gs[j]; vn[j] = gs[j]; }
    if (r0 < r1) { const float* xr = (r0 < NPR) ? hp + (size_t)r0 * D : hs + (size_t)(r0 - NPR) * D;
#pragma unroll
        for (int j = 0; j < 8; ++j) v[j] = *(const f32x4*)(xr + 4 * lane + 256 * j); }
    for (int r = r0; r < r1; ++r) {
        if (r + 1 < r1) { const int rn = r + 1; const float* xr = (rn < NPR) ? hp + (size_t)rn * D : hs + (size_t)(rn - NPR) * D;
#pragma unroll
            for (int j = 0; j < 8; ++j) vn[j] = *(const f32x4*)(xr + 4 * lane + 256 * j); }
        const int s = stream_of_row(r);
        if (s != cur_s) { cur_s = s;
#pragma unroll
            for (int j = 0; j < 8; ++j) { const int c = 4 * lane + 256 * j; gs[j] = *(const f32x4*)(ng + c) * (*(const f32x4*)(scale + (size_t)s * MODS + c) + 1.0f); sh[j] = *(const f32x4*)(shift + (size_t)s * MODS + c); } }
        float ss = 0.f;
#pragma unroll
        for (int j = 0; j < 8; ++j) ss += (v[j].x * v[j].x + v[j].y * v[j].y) + (v[j].z * v[j].z + v[j].w * v[j].w);
        const float rstd = rsqrtf(wave_sum(ss) * (1.0f / D) + EPS);
        bf16* orow = HN + (size_t)r * D;
#pragma unroll
        for (int j = 0; j < 8; ++j) { const f32x4 o = v[j] * rstd * gs[j] + sh[j]; v2u w; w.x = pk2(o.x, o.y); w.y = pk2(o.z, o.w); *(v2u*)(orow + 4 * lane + 256 * j) = w; }
#pragma unroll
        for (int j = 0; j < 8; ++j) v[j] = vn[j];
    }
}
__device__ __forceinline__ void final_norm(const bf16* h, float* yo, const float* ng, int r0, int r1, int lane) {
    f32x4 gs[8]; v2u w[8], wn[8];
#pragma unroll
    for (int j = 0; j < 8; ++j) { gs[j] = *(const f32x4*)(ng + 4 * lane + 256 * j); w[j] = (v2u){0u, 0u}; wn[j] = w[j]; }
    if (r0 < r1) {
#pragma unroll
        for (int j = 0; j < 8; ++j) w[j] = *(const v2u*)(h + (size_t)r0 * D + 4 * lane + 256 * j); }
    for (int r = r0; r < r1; ++r) {
        if (r + 1 < r1) {
#pragma unroll
            for (int j = 0; j < 8; ++j) wn[j] = *(const v2u*)(h + (size_t)(r + 1) * D + 4 * lane + 256 * j); }
        f32x4 v[8]; float ss = 0.f;
#pragma unroll
        for (int j = 0; j < 8; ++j) { v[j] = (f32x4){bflo(w[j].x), bfhi(w[j].x), bflo(w[j].y), bfhi(w[j].y)}; ss += (v[j].x * v[j].x + v[j].y * v[j].y) + (v[j].z * v[j].z + v[j].w * v[j].w); }
        const float rstd = rsqrtf(wave_sum(ss) * (1.0f / D) + EPS);
#pragma unroll
        for (int j = 0; j < 8; ++j) *(f32x4*)(yo + (size_t)r * D + 4 * lane + 256 * j) = v[j] * rstd * gs[j];
#pragma unroll
        for (int j = 0; j < 8; ++j) w[j] = wn[j];
    }
}

constexpr int VNT_STRIDE_DW = 68;
constexpr int GATE_ST_OFF = 256 * VNT_STRIDE_DW * 4, GATE_WM_OFF = GATE_ST_OFF + 1024, GATE_WM_STRIDE = 272;
__device__ __forceinline__ void gate_stage_wm(CArgsP a, LAS unsigned char* lds, int g, int tid) {
    const bf16* wm = (const bf16*)(a->ws + WS_WM) + (size_t)g * 16384;
    for (int i = tid; i < 128 * 16; i += NWAVES * 64) { const int row = i >> 4, ch16 = i & 15; *(LAS v4u*)(lds + GATE_WM_OFF + row * GATE_WM_STRIDE + ch16 * 16) = *(const v4u*)(wm + row * 128 + ch16 * 8); }
}
__device__ __forceinline__ void mix_gate_unit(CArgsP a, LAS unsigned char* lds, int ch, int g, int tid, int wave, int lane) {
    asm volatile("" : "+v"(tid), "+v"(lane));
    unsigned char* ws = a->ws;
    LAS unsigned* vnT = (LAS unsigned*)lds;
    LAS float* st = (LAS float*)(lds + GATE_ST_OFF);
    const bool smp = ch >= 256; const int r0 = smp ? NPR + 64 * (ch - 256) : 128 * ch, nrows = smp ? 64 : 128;
    const float* vstat = (const float*)(ws + WS_VSP); const bf16* V = (const bf16*)(ws + WS_V); const bf16* U = (const bf16*)(ws + WS_U); bf16* CAT = (bf16*)(ws + WS_CAT);
    if (tid < 128) { float mean = 0.f, rstd = 0.f;
        if (tid < nrows) { float s1 = 0.f, s2 = 0.f;
#pragma unroll
            for (int i = 0; i < 16; ++i) { const f32x2 p = *(const f32x2*)(vstat + ((size_t)(r0 + tid) * 16 + i) * 2); s1 += p.x; s2 += p.y; }
            mean = s1 * (1.0f / AW); const float var = fmaxf(s2 * (1.0f / AW) - mean * mean, 0.f); rstd = rsqrtf(var + EPS); }
        st[2 * tid] = mean; st[2 * tid + 1] = rstd; }
    unsigned vw[4][8];
#pragma unroll
    for (int it = 0; it < 4; ++it) { const int idx = it * 512 + tid, cp = idx & 127, tg = idx >> 7, c = g * 256 + 2 * cp;
        if (8 * tg < nrows) {
#pragma unroll
            for (int j = 0; j < 8; ++j) vw[it][j] = *(const unsigned*)(V + (size_t)(r0 + 8 * tg + j) * AW + c);
        } else {
#pragma unroll
            for (int j = 0; j < 8; ++j) vw[it][j] = 0u; } }
    __syncthreads();
#pragma unroll
    for (int it = 0; it < 4; ++it) {
        const int idx = it * 512 + tid, cp = idx & 127, tg = idx >> 7, c = g * 256 + 2 * cp;
        const f32x2 gg = *(const f32x2*)(a->in[I_AVG] + c), bb = *(const f32x2*)(a->in[I_AVB] + c);
        float v0[8], v1[8];
        if (8 * tg < nrows) {
#pragma unroll
            for (int j = 0; j < 8; ++j) { const int tok = 8 * tg + j; const float mean = st[2 * tok], rstd = st[2 * tok + 1];
                v0[j] = (bflo(vw[it][j]) - mean) * rstd * gg.x + bb.x; v1[j] = (bfhi(vw[it][j]) - mean) * rstd * gg.y + bb.y;
                if (smp) *(f32x2*)(a->out + O_NAV + (size_t)((ch - 256) * 64 + tok) * AW + c) = (f32x2){v0[j], v1[j]}; }
        } else {
#pragma unroll
            for (int j = 0; j < 8; ++j) { v0[j] = 0.f; v1[j] = 0.f; } }
        v4u w0, w1; w0.x = pk2(v0[0], v0[1]); w0.y = pk2(v0[2], v0[3]); w0.z = pk2(v0[4], v0[5]); w0.w = pk2(v0[6], v0[7]); w1.x = pk2(v1[0], v1[1]); w1.y = pk2(v1[2], v1[3]); w1.z = pk2(v1[4], v1[5]); w1.w = pk2(v1[6], v1[7]);
        *(LAS v4u*)(vnT + (2 * cp) * VNT_STRIDE_DW + 4 * tg) = w0; *(LAS v4u*)(vnT + (2 * cp + 1) * VNT_STRIDE_DW + 4 * tg) = w1;
    }
    __syncthreads();
    const int lr = lane & 15, lq = lane >> 4;
    v2u uw[8][2]; float bsv[8];
#pragma unroll
    for (int it = 0; it < 8; ++it) { const int i = 16 * it + lr; bsv[it] = a->in[I_ABS][g * 128 + i];
#pragma unroll
        for (int ct = 0; ct < 2; ++ct) uw[it][ct] = *(const v2u*)(U + (size_t)(r0 + i) * AW + g * 256 + 32 * wave + 16 * ct + 4 * lq); }
    f32x4 acc[2][8];
#pragma unroll
    for (int ct = 0; ct < 2; ++ct)
#pragma unroll
        for (int it = 0; it < 8; ++it) acc[ct][it] = (f32x4){0.f, 0.f, 0.f, 0.f};
#pragma unroll 1
    for (int ks = 0; ks < 4; ++ks) {
        bf16x8 af[2];
#pragma unroll
        for (int ct = 0; ct < 2; ++ct) af[ct] = *(const LAS bf16x8*)((const LAS unsigned char*)vnT + (32 * wave + 16 * ct + lr) * (VNT_STRIDE_DW * 4) + ks * 64 + lq * 16);
#pragma unroll
        for (int it = 0; it < 8; ++it) { const bf16x8 bfrag = *(const LAS bf16x8*)(lds + GATE_WM_OFF + (16 * it + lr) * GATE_WM_STRIDE + ks * 64 + lq * 16);
#pragma unroll
            for (int ct = 0; ct < 2; ++ct) acc[ct][it] = __builtin_amdgcn_mfma_f32_16x16x32_bf16(af[ct], bfrag, acc[ct][it], 0, 0, 0); }
    }
#pragma unroll
    for (int it = 0; it < 8; ++it) { const int i = 16 * it + lr;
        if (i < nrows) {
#pragma unroll
            for (int ct = 0; ct < 2; ++ct) { const int cb = g * 256 + 32 * wave + 16 * ct + 4 * lq; const v2u u2 = uw[it][ct]; const float bs = bsv[it];
                v2u w; w.x = pk2(bflo(u2.x) * (acc[ct][it][0] + bs), bfhi(u2.x) * (acc[ct][it][1] + bs)); w.y = pk2(bflo(u2.y) * (acc[ct][it][2] + bs), bfhi(u2.y) * (acc[ct][it][3] + bs));
                *(v2u*)(CAT + (size_t)(r0 + i) * D + cb) = w; } } }
    __syncthreads();
}
constexpr int CONV_W_BYTES = 31 * 1024 * 4;
__device__ __forceinline__ void conv_stage_weights(CArgsP a, LAS unsigned char* lds, int tid) {
    __syncthreads();
    for (int i = tid; i < 31 * 256; i += NWAVES * 64) *(LAS f32x4*)(lds + 16 * i) = *(const f32x4*)(a->in[I_BDW] + 4 * i);
    __syncthreads();
}
__device__ __forceinline__ f32x2 conv_row(const bf16* GLU, const float* hist, int rowbase, int t, int c) {
    if (t >= 0) { const unsigned w = *(const unsigned*)(GLU + (size_t)(rowbase + t) * AW + c); return (f32x2){bflo(w), bfhi(w)}; }
    if (hist) return *(const f32x2*)(hist + (size_t)(30 + t) * 1024 + c);
    return (f32x2){0.f, 0.f};
}
__device__ __forceinline__ void mix_conv_unit(CArgsP a, LAS unsigned char* lds, int b, int tid, int wave, int lane) {
    unsigned char* ws = a->ws;
    const LAS float* dwl = (const LAS float*)lds;
    LAS float* red = (LAS float*)(lds + CONV_W_BYTES);
    LAS float* stt = red + 128;
    int rowbase, t0; const float* hist = nullptr;
    if (b < 1024) { rowbase = 8192 * (b >> 8); t0 = 32 * (b & 255); } else { const int q = b - 1024; rowbase = NPR + 64 * (q >> 1); t0 = 32 * (q & 1); hist = a->in[I_SCONV] + (size_t)(q >> 1) * 30 * 1024; }
    const bf16* GLU = (const bf16*)(ws + WS_GLU); bf16* CAT = (bf16*)(ws + WS_CAT);
    const int c = 2 * tid;
    const f32x2 lg = *(const f32x2*)(a->in[I_BLNG] + c), lb = *(const f32x2*)(a->in[I_BLNB] + c);
    f32x2 x[62];
    if (t0 >= 30) {
        const bf16* gp = GLU + (size_t)(rowbase + t0 - 30) * AW + c;
        unsigned xw[62];
#pragma unroll
        for (int i = 0; i < 62; ++i) xw[i] = *(const unsigned*)(gp + (size_t)i * AW);
#pragma unroll
        for (int i = 0; i < 62; ++i) x[i] = (f32x2){bflo(xw[i]), bfhi(xw[i])};
    } else {
#pragma unroll
        for (int i = 0; i < 62; ++i) x[i] = conv_row(GLU, hist, rowbase, t0 - 30 + i, c);
    }
#pragma unroll
    for (int sub = 0; sub < 4; ++sub) {
        const int tt0 = t0 + 8 * sub;
        f32x2 acc[8];
#pragma unroll
        for (int t = 0; t < 8; ++t) acc[t] = (f32x2){0.f, 0.f};
#pragma unroll
        for (int k = 0; k < 31; ++k) { const f32x2 wk = *(const LAS f32x2*)(dwl + k * 1024 + c);
#pragma unroll
            for (int t = 0; t < 8; ++t) acc[t] += x[8 * sub + t + k] * wk; }
#pragma unroll
        for (int t = 0; t < 8; ++t) { const float s1 = wave_sum(acc[t].x + acc[t].y), s2 = wave_sum(acc[t].x * acc[t].x + acc[t].y * acc[t].y);
            if (lane == 0) { red[(wave * 8 + t) * 2] = s1; red[(wave * 8 + t) * 2 + 1] = s2; } }
        __syncthreads();
        if (tid < 8) { float s1 = 0.f, s2 = 0.f;
#pragma unroll
            for (int w = 0; w < 8; ++w) { s1 += red[(w * 8 + tid) * 2]; s2 += red[(w * 8 + tid) * 2 + 1]; }
            const float mean = s1 * (1.0f / AW), var = fmaxf(s2 * (1.0f / AW) - mean * mean, 0.f); stt[2 * tid] = mean; stt[2 * tid + 1] = rsqrtf(var + EPS); }
        __syncthreads();
#pragma unroll
        for (int t = 0; t < 8; ++t) { const float mean = stt[2 * t], rstd = stt[2 * t + 1];
            const float y0 = (acc[t].x - mean) * rstd * lg.x + lb.x, y1 = (acc[t].y - mean) * rstd * lg.y + lb.y;
            *(unsigned*)(CAT + (size_t)(rowbase + tt0 + t) * D + AW + c) = pk2(siluf_(y0), siluf_(y1)); }
        asm volatile("" ::: "memory");
    }
}
__device__ __forceinline__ f32x4 tc_hm(const bf16* h, const float* hist, const LAS float* rs, int rowbase, int t0, int t, int c, f32x4 gs, f32x4 sh) {
    if (t >= 0) { const v2u w = *(const v2u*)(h + (size_t)(rowbase + t) * D + c); return (f32x4){bflo(w.x), bfhi(w.x), bflo(w.y), bfhi(w.y)} * rs[t - t0 + 15] * gs + sh; }
    if (hist) return *(const f32x4*)(hist + (size_t)(15 + t) * D + c);
    return (f32x4){0.f, 0.f, 0.f, 0.f};
}
__device__ __forceinline__ f32x4 tc_hm_all(const bf16* h, const LAS float* rs, int rowbase, int t0, int t, int c, f32x4 gs, f32x4 sh) {
    const v2u w = *(const v2u*)(h + (size_t)(rowbase + t) * D + c); return (f32x4){bflo(w.x), bfhi(w.x), bflo(w.y), bfhi(w.y)} * rs[t - t0 + 15] * gs + sh;
}
template <int W, bool ALLV> __device__ __forceinline__ void tc_body(const bf16* h, const float* hist, const LAS float* rs, int rowbase, int t0, int T, int pos0, int c, f32x4 gs, f32x4 sh, bf16* PC, float* np) {
    f32x4 ring[16]; f32x4 S = (f32x4){0.f, 0.f, 0.f, 0.f};
#pragma unroll
    for (int k = 1; k < W; ++k) { ring[(16 - k) & 15] = ALLV ? tc_hm_all(h, rs, rowbase, t0, t0 - k, c, gs, sh) : tc_hm(h, hist, rs, rowbase, t0, t0 - k, c, gs, sh); S += ring[(16 - k) & 15]; }
#pragma unroll
    for (int tt = 0; tt < 32; ++tt) { const int t = t0 + tt;
        const f32x4 cur = ALLV ? tc_hm_all(h, rs, rowbase, t0, t, c, gs, sh) : tc_hm(h, hist, rs, rowbase, t0, t, c, gs, sh);
        S += cur;
        const int pos = pos0 + t; const float inv = 1.0f / (float)(pos + 1 < W ? pos + 1 : W);
        const f32x4 p = S * inv - cur;
        v2u o; o.x = pk2(p.x, p.y); o.y = pk2(p.z, p.w); *(v2u*)(PC + (size_t)(rowbase + t) * D + c) = o;
        if (t >= T - 15) *(f32x4*)(np + (size_t)(t - (T - 15)) * D + c) = cur;
        if (W > 1) { if (W == 2) S -= (tt == 0 ? ring[15] : ring[(tt - 1) & 15]); else S -= ring[(tt - W + 1 + 32) & 15]; }
        ring[tt & 15] = cur;
    }
}
__device__ __forceinline__ void tc_unit(CArgsP a, LAS unsigned char* lds, const bf16* h, const float* ssq, const float* ng, const float* shift, const float* scale, int b, int tid, int wave, int lane) {
    unsigned char* ws = a->ws;
    LAS float* rs = (LAS float*)lds;
    int rowbase, t0, s, T, pos0; const float* hist = nullptr; float* np;
    if (b < 1024) { s = b >> 8; rowbase = 8192 * s; t0 = 32 * (b & 255); T = 8192; pos0 = 0; np = a->out + O_NPP + (size_t)s * 15 * D; }
    else { const int q = b - 1024; s = 4 + (q >> 1); rowbase = NPR + 64 * (q >> 1); t0 = 32 * (q & 1); T = 64; pos0 = 1024; hist = a->in[I_SPOOL] + (size_t)(q >> 1) * 15 * D; np = a->out + O_NPS + (size_t)(q >> 1) * 15 * D; }
    if (tid < 47) { const int t = t0 - 15 + tid; if (t >= 0) rs[tid] = rsqrtf(ssq[rowbase + t] * (1.0f / D) + EPS); }
    __syncthreads();
    const int c = 4 * tid, grp = __builtin_amdgcn_readfirstlane(tid >> 7);
    const f32x4 gs = *(const f32x4*)(ng + c) * (*(const f32x4*)(scale + (size_t)s * MODS + c) + 1.0f), sh = *(const f32x4*)(shift + (size_t)s * MODS + c);
    bf16* PC = (bf16*)(ws + WS_PC);
    if (t0 >= 15) {
        if (grp == 0) tc_body<2, true>(h, hist, rs, rowbase, t0, T, pos0, c, gs, sh, PC, np);
        else if (grp == 1) tc_body<4, true>(h, hist, rs, rowbase, t0, T, pos0, c, gs, sh, PC, np);
        else if (grp == 2) tc_body<8, true>(h, hist, rs, rowbase, t0, T, pos0, c, gs, sh, PC, np);
        else tc_body<16, true>(h, hist, rs, rowbase, t0, T, pos0, c, gs, sh, PC, np);
    } else {
        if (grp == 0) tc_body<2, false>(h, hist, rs, rowbase, t0, T, pos0, c, gs, sh, PC, np);
        else if (grp == 1) tc_body<4, false>(h, hist, rs, rowbase, t0, T, pos0, c, gs, sh, PC, np);
        else if (grp == 2) tc_body<8, false>(h, hist, rs, rowbase, t0, T, pos0, c, gs, sh, PC, np);
        else tc_body<16, false>(h, hist, rs, rowbase, t0, T, pos0, c, gs, sh, PC, np);
    }
    __syncthreads();
}

__device__ __forceinline__ void slab_reduce(const void* base_s, int base_f32, bf16* hS, const float* slab, int ks, bf16* an, const float* ng_n, const float* sc_n, float* ss, int gw, int NGW, int lane) {
    for (int r = gw; r < NSR; r += NGW) {
        const int s = 4 + (r >> 6);
        f32x4 v[8]; float q = 0.f;
#pragma unroll
        for (int j = 0; j < 8; ++j) { const size_t o = (size_t)r * D + 4 * lane + 256 * j;
            if (base_f32) v[j] = *(const f32x4*)((const float*)base_s + o); else { const v2u w = *(const v2u*)((const bf16*)base_s + o); v[j] = (f32x4){bflo(w.x), bfhi(w.x), bflo(w.y), bfhi(w.y)}; } }
#pragma unroll 4
        for (int k = 0; k < ks; ++k) {
#pragma unroll
            for (int j = 0; j < 8; ++j) v[j] += *(const f32x4*)(slab + ((size_t)k * NSR + r) * D + 4 * lane + 256 * j); }
#pragma unroll
        for (int j = 0; j < 8; ++j) { const int c = 4 * lane + 256 * j; { v2u w; w.x = pk2(v[j].x, v[j].y); w.y = pk2(v[j].z, v[j].w); *(v2u*)(hS + (size_t)r * D + c) = w; } q += (v[j].x * v[j].x + v[j].y * v[j].y) + (v[j].z * v[j].z + v[j].w * v[j].w);
            if (an) { const f32x4 t = v[j] * (*(const f32x4*)(ng_n + c) * (*(const f32x4*)(sc_n + (size_t)s * MODS + c) + 1.0f)); v2u w; w.x = pk2(t.x, t.y); w.y = pk2(t.z, t.w); *(v2u*)(an + (size_t)(NPR + r) * D + c) = w; } }
        if (ss) { q = wave_sum(q); if (lane == 0) ss[NPR + r] = q; }
    }
}
__device__ __forceinline__ void slab_reduce_final(const bf16* base_s, const float* slab, int ks, float* yo, const float* ng, int r, int lane) {
    f32x4 v[8]; float q = 0.f;
#pragma unroll
    for (int j = 0; j < 8; ++j) { const v2u w = *(const v2u*)(base_s + (size_t)r * D + 4 * lane + 256 * j); v[j] = (f32x4){bflo(w.x), bfhi(w.x), bflo(w.y), bfhi(w.y)}; }
#pragma unroll 4
    for (int k = 0; k < ks; ++k) {
#pragma unroll
        for (int j = 0; j < 8; ++j) v[j] += *(const f32x4*)(slab + ((size_t)k * NSR + r) * D + 4 * lane + 256 * j); }
#pragma unroll
    for (int j = 0; j < 8; ++j) q += (v[j].x * v[j].x + v[j].y * v[j].y) + (v[j].z * v[j].z + v[j].w * v[j].w);
    const float rstd = rsqrtf(wave_sum(q) * (1.0f / D) + EPS);
#pragma unroll
    for (int j = 0; j < 8; ++j) *(f32x4*)(yo + (size_t)(NPR + r) * D + 4 * lane + 256 * j) = v[j] * rstd * (*(const f32x4*)(ng + 4 * lane + 256 * j));
}
__device__ __forceinline__ void mod_reduce(const float* modp, float* mod, int gtid, int NT) {
    for (int i = gtid; i < 2 * MODL / 4; i += NT) { f32x4 v = ((const f32x4*)modp)[i];
#pragma unroll
        for (int k = 1; k < 16; ++k) v += ((const f32x4*)modp)[(size_t)k * (2 * MODL / 4) + i];
        ((f32x4*)mod)[i] = v; }
}
__device__ __forceinline__ void ss_finalize(const float* ssp, float* ss, int nrows, int gtid, int NT) {
    for (int r = gtid; r < nrows; r += NT) { const f32x4* p = (const f32x4*)(ssp + (size_t)r * 32); f32x4 v = p[0];
#pragma unroll
        for (int k = 1; k < 8; ++k) v += p[k];
        ss[r] = (v.x + v.y) + (v.z + v.w); }
}
constexpr int SHL_STRIDE = D + 8;
__device__ __forceinline__ void sb_gemv(LAS unsigned char* lds, const bf16* Wt, int nrows, const float* shift, float* sb, int gw, int NGW, int tid, int lane) {
    LAS bf16* shl = (LAS bf16*)lds;
    __syncthreads();
    for (int i = tid; i < 16 * (D / 8); i += NWAVES * 64) { const int s = i / (D / 8), c8 = i % (D / 8); v4u w = (v4u){0u, 0u, 0u, 0u};
        if (s < NSTREAM) { const float* p = shift + (size_t)s * MODS + 8 * c8; const f32x4 a = *(const f32x4*)p, b = *(const f32x4*)(p + 4); w.x = pk2(a.x, a.y); w.y = pk2(a.z, a.w); w.z = pk2(b.x, b.y); w.w = pk2(b.z, b.w); }
        *(LAS v4u*)(shl + s * SHL_STRIDE + 8 * c8) = w; }
    __syncthreads();
    const int lr = lane & 15, lq = lane >> 4;
    for (int tile = gw; tile < nrows / 16; tile += NGW) {
        const int n0 = 16 * tile;
        f32x4 acc = (f32x4){0.f, 0.f, 0.f, 0.f};
        const bf16* wp = Wt + (size_t)(n0 + lr) * D + 8 * lq; const LAS bf16* ap = shl + lr * SHL_STRIDE + 8 * lq;
        bf16x8 wf[32];
#pragma unroll 1
        for (int kh = 0; kh < 2; ++kh) {
#pragma unroll
            for (int ks = 0; ks < 32; ++ks) wf[ks] = *(const bf16x8*)(wp + 32 * (32 * kh + ks));
#pragma unroll
            for (int ks = 0; ks < 32; ++ks) acc = __builtin_amdgcn_mfma_f32_16x16x32_bf16(*(const LAS bf16x8*)(ap + 32 * (32 * kh + ks)), wf[ks], acc, 0, 0, 0);
        }
#pragma unroll
        for (int j = 0; j < 4; ++j) { const int s = 4 * lq + j; if (s < NSTREAM) sb[(size_t)s * nrows + n0 + lr] = acc[j]; }
    }
}

constexpr int NPL = 13, NPH = 3 + 2 * NPL;
constexpr int KS_G2 = 11, KS_G4 = 8;
__global__ void __launch_bounds__(NWAVES * 64, 2) mk_fwd(Args args) {
    extern __shared__ __attribute__((aligned(16))) unsigned char lds_raw[];
    LAS unsigned char* lds = (LAS unsigned char*)lds_raw;
    volatile LAS unsigned* MISC = (volatile LAS unsigned*)(lds + MISC_OFF);
    constexpr int G = NCU;
    const int bx = blockIdx.x, vcu = (bx % 8) * (G / 8) + bx / 8; constexpr int NGW = G * NWAVES;
    for (int u = threadIdx.x; u < (LDS_BYTES - LDSCTL_OFF) / 4; u += NWAVES * 64) ((LAS unsigned*)(lds + LDSCTL_OFF))[u] = 0u;
    __syncthreads();
    const int lo = args.ph_lo, hi = args.ph_hi;
    XcdBarrier bar; bar.bar = (unsigned*)(args.ws + WS_CTL) + CW_BAR; bar.x = 0; bar.st = nullptr;
    if (hi - lo > 1) bar = xcd_barrier_post((unsigned*)(args.ws + WS_CTL) + CW_BAR, MISC + 8);
#ifndef PH_MASK
#define PH_MASK 0xFFFFFFFFu
#endif
#define SITE(i) ((PH_MASK >> (i)) & 1u)
#define REP(i) for (int rep_ = 0; rep_ < 1 + (int)((DUP_MASK >> (i)) & 1u); ++rep_)
#define IN(k) (lo <= (k) && (k) < hi)
#define STAGGER(x0, span) ((G % 8 == 0 && (bx % 8) >= (x0)) ? (unsigned)((span) * ((bx % 8) - (x0) + 1) / (9 - (x0))) : 0u)
#define SEAM(k) do { if ((k) + 1 < hi) { xcd_barrier(bar); if ((DUP_MASK >> 7) & 1u) xcd_barrier(bar); } } while (0)
#define SITE_IDS int tid = threadIdx.x; asm volatile("" : "+v"(tid)); const int lane = tid & 63, wave = __builtin_amdgcn_readfirstlane(tid >> 6), gw = vcu * NWAVES + wave; (void)lane; (void)gw; \
    CArgsP ap = (CArgsP)__builtin_amdgcn_kernarg_segment_ptr(); asm volatile("" : "+s"(ap)); unsigned char* ws = ap->ws; bf16* h = (bf16*)(ws + WS_H); bf16* hS = h + (size_t)NPR * D; (void)hS; (void)h; \
    const float* modl = (const float*)(ws + WS_MOD) + (size_t)l * MODL; const float* ngl = ap->in[I_NORMG] + (size_t)l * 3 * D; (void)modl; (void)ngl; \
    bf16* HN = (bf16*)(ws + WS_HN); bf16* ACT = (bf16*)(ws + WS_ACT); float* SLAB = (float*)(ws + WS_SLAB); float* SSQ = (float*)(ws + WS_SS); float* SSP = (float*)(ws + WS_SSP); const int gtid = (int)blockIdx.x * (NWAVES * 64) + tid; (void)HN; (void)ACT; (void)SLAB; (void)SSQ; (void)SSP; (void)gtid

    { const int l = 0; if (SITE(0) && IN(0)) { SITE_IDS; p0_prologue(ap, lds, gw, NGW, wave, lane); SEAM(0); }
      if (SITE(0) && IN(1)) { SITE_IDS; mod_reduce((const float*)(ws + WS_MODP), (float*)(ws + WS_MOD), gtid, G * NWAVES * 64); SEAM(1); } }

#pragma unroll 1
    for (int l = 0; l < 2; ++l) {
        const int pb = 2 + NPL * l;
        if (l == 0 && SITE(1) && IN(pb + 0)) { SITE_IDS; const float* mod0 = (const float*)(ws + WS_MOD); float* SB = (float*)(ws + WS_SB);
            REP(1) thin_norm(ap->in[I_XP], ap->in[I_XS], ngl, modl + 0 * D, modl + 1 * D, HN, gw, NGW, lane);
            sb_gemv(lds, (const bf16*)(ws + WS_WIN), 4096, mod0 + 3 * D, SB + (size_t)4 * 12 * 11264, gw, NGW, tid, lane);
            SEAM(pb + 0); }
        if (SITE(2) && IN(pb + 1)) { SITE_IDS; pg8::Gemm g{HN, (const bf16*)(ws + WS_WGU) + (size_t)(2 * l) * 11264 * 2048, M, 11264, D, D, 0}; pg8::StaticOrder S; S.init(NPR, NSR, 11264, D, G, bx, 1);
            pg8::EpiSwiGLU E{ACT, DFF, l == 0 ? nullptr : SSQ + (size_t)2 * M, (const float*)(ws + WS_SB) + (size_t)2 * 12 * 11264}; REP(0) pg8::gemm_phase<pg8::EpiSwiGLU, true>(lds, g, S, E, 0u);
            { const int c0 = (S.nTail + 31) / 32 * 32;
              if (vcu >= c0) conv_window(ap, lds, 2 * l + 1, -1, -1, vcu - c0, G - c0, wave, lane); } SEAM(pb + 1); }
        if (SITE(3) && IN(pb + 2)) { SITE_IDS; pg8::Gemm g{ACT, (const bf16*)(ws + WS_WD) + (size_t)(2 * l) * 2048 * 5632, M, D, DFF, DFF, 0}; pg8::StaticOrder S; S.init(NPR, NSR, D, DFF, G, bx, KS_G2, 4);
            pg8::EpiRes<false> E{l == 0 ? (const void*)ap->in[I_XP] : (const void*)h, l == 0 ? (const void*)ap->in[I_XS] : (const void*)hS, h, modl + 2 * D, nullptr, nullptr, SLAB, l == 0 ? HN : nullptr, ngl + D, modl + 4 * D, SSP + (size_t)(l == 0 ? 0 : 3) * M * 32, 0.5f, l == 0 ? 1 : 0};
            if ((DUP_MASK >> 5) & 1u) { pg8::EpiRes<false> E2 = E; E2.out = (bf16*)(ws + WS_DUMMY); E2.an = nullptr; E2.ss = nullptr; pg8::gemm_phase<pg8::EpiRes<false>, true>(lds, g, S, E2); }
            pg8::gemm_phase<pg8::EpiRes<false>, true>(lds, g, S, E); SEAM(pb + 2); }
        if (SITE(3) && IN(pb + 3)) { SITE_IDS; slab_reduce(l == 0 ? (const void*)ap->in[I_XS] : (const void*)hS, l == 0 ? 1 : 0, hS, SLAB, KS_G2, l == 0 ? HN : nullptr, ngl + D, modl + 4 * D, SSQ + (size_t)(l == 0 ? 0 : 3) * M, gw, NGW, lane);
            ss_finalize(SSP + (size_t)(l == 0 ? 0 : 3) * M * 32, SSQ + (size_t)(l == 0 ? 0 : 3) * M, NPR, gtid, G * NWAVES * 64);
            SEAM(pb + 3); }
        if (l == 0) {
            if (SITE(5) && IN(pb + 5)) { SITE_IDS; pg8::Gemm g{HN, (const bf16*)(ws + WS_WIN), M, 4096, D, D, 0}; pg8::StaticOrder S; S.init(NPR, NSR, 4096, D, G, bx, 1);
                pg8::EpiInProj E{(bf16*)(ws + WS_U), (bf16*)(ws + WS_V), (bf16*)(ws + WS_GLU), (float*)(ws + WS_VSP), ap->out + O_NCP, ap->out + O_NCS, SSQ, (const float*)(ws + WS_SB) + (size_t)4 * 12 * 11264};
                if ((DUP_MASK >> 6) & 1u) { pg8::EpiInProj E2 = E; E2.vstat = (float*)(ws + WS_DUMMY); pg8::gemm_phase<pg8::EpiInProj, true>(lds, g, S, E2); }
                pg8::gemm_phase<pg8::EpiInProj, true>(lds, g, S, E, 0u);
                if (vcu >= S.nTail) { const int rank = vcu - S.nTail, nrank = G - S.nTail; conv_window(ap, lds, -1, 1, 2, rank, nrank, wave, lane);
                    sb_gemv(lds, (const bf16*)(ws + WS_WGU) + (size_t)1 * 11264 * 2048, 11264, (const float*)(ws + WS_MOD) + 6 * D, (float*)(ws + WS_SB) + (size_t)1 * 12 * 11264, rank * NWAVES + wave, nrank * NWAVES, tid, lane); }
                SEAM(pb + 5); }
            if (SITE(6) && IN(pb + 6)) { SITE_IDS;
                REP(2) { bool staged = false; gate_stage_wm(ap, lds, vcu & 3, tid);
                  for (int u = vcu; u < 1056 + 1040; u += G) { if (u < 1056) { if (SITE(20)) mix_gate_unit(ap, lds, u >> 2, u & 3, tid, wave, lane); } else { if (!staged) { conv_stage_weights(ap, lds, tid); staged = true; } if (SITE(21)) mix_conv_unit(ap, lds, u - 1056, tid, wave, lane); } } __syncthreads(); }
                SEAM(pb + 6); }
            if (SITE(7) && IN(pb + 7)) { SITE_IDS; pg8::Gemm g{(const bf16*)(ws + WS_CAT), (const bf16*)(ws + WS_WOUT), M, D, D, D, 0}; pg8::StaticOrder S; S.init(NPR, NSR, D, D, G, bx, KS_G4);
                pg8::EpiRes<false> E{h, hS, h, modl + 5 * D, nullptr, nullptr, SLAB, HN, ngl + 2 * D, modl + 7 * D, SSP + (size_t)1 * M * 32, 1.0f, 0};
                if ((DUP_MASK >> 6) & 1u) { pg8::EpiRes<false> E2 = E; E2.out = (bf16*)(ws + WS_DUMMY); E2.an = nullptr; E2.ss = nullptr; pg8::gemm_phase<pg8::EpiRes<false>, true>(lds, g, S, E2); }
                pg8::gemm_phase<pg8::EpiRes<false>, true>(lds, g, S, E); SEAM(pb + 7); }
            if (SITE(7) && IN(pb + 8)) { SITE_IDS; slab_reduce(hS, 0, hS, SLAB, KS_G4, HN, ngl + 2 * D, modl + 7 * D, SSQ + (size_t)1 * M, gw, NGW, lane); ss_finalize(SSP + (size_t)1 * M * 32, SSQ + (size_t)1 * M, NPR, gtid, G * NWAVES * 64); SEAM(pb + 8); }
        } else {
            if (SITE(8) && IN(pb + 4)) { SITE_IDS; REP(3) for (int u = vcu; u < 1040; u += G) tc_unit(ap, lds, h, SSQ + (size_t)3 * M, ngl + D, modl + 3 * D, modl + 4 * D, u, tid, wave, lane); SEAM(pb + 4); }
            if (SITE(9) && IN(pb + 7)) { SITE_IDS; pg8::Gemm g{(const bf16*)(ws + WS_PC), (const bf16*)(ws + WS_WC), M, D, 512, D, 2}; pg8::StaticOrder S; S.init(NPR, NSR, D, 512, G, bx, 1);
                pg8::EpiRes<true> E{h, hS, h, modl + 5 * D, ap->in[I_CB], ap->in[I_CSC], SLAB, HN, ngl + 2 * D, modl + 7 * D, SSP + (size_t)4 * M * 32, 1.0f, 0};
                if ((DUP_MASK >> 6) & 1u) { pg8::EpiRes<true> E2 = E; E2.out = (bf16*)(ws + WS_DUMMY); E2.an = nullptr; E2.ss = nullptr; pg8::gemm_phase<pg8::EpiRes<true>, true>(lds, g, S, E2); }
                pg8::gemm_phase<pg8::EpiRes<true>, true>(lds, g, S, E);
                if (vcu >= S.nTail) sb_gemv(lds, (const bf16*)(ws + WS_WGU) + (size_t)3 * 11264 * 2048, 11264, (const float*)(ws + WS_MOD) + MODL + 6 * D, (float*)(ws + WS_SB) + (size_t)3 * 12 * 11264, (vcu - S.nTail) * NWAVES + wave, (G - S.nTail) * NWAVES, tid, lane);
                SEAM(pb + 7); }
            if (SITE(9) && IN(pb + 8)) { SITE_IDS; ss_finalize(SSP + (size_t)4 * M * 32, SSQ + (size_t)4 * M, M, gtid, G * NWAVES * 64); SEAM(pb + 8); }
        }
        if (SITE(11) && IN(pb + 10)) { SITE_IDS; pg8::Gemm g{HN, (const bf16*)(ws + WS_WGU) + (size_t)(2 * l + 1) * 11264 * 2048, M, 11264, D, D, 0}; pg8::StaticOrder S; S.init(NPR, NSR, 11264, D, G, bx, 1);
            pg8::EpiSwiGLU E{ACT, DFF, SSQ + (size_t)(l == 0 ? 1 : 4) * M, (const float*)(ws + WS_SB) + (size_t)(2 * l + 1) * 12 * 11264}; REP(0) pg8::gemm_phase<pg8::EpiSwiGLU, true>(lds, g, S, E, 0u);
            { const int c0 = (S.nTail + 31) / 32 * 32; if (vcu >= c0) conv_window(ap, lds, l == 0 ? 2 : -1, l == 0 ? -1 : 3, -1, vcu - c0, G - c0, wave, lane); } SEAM(pb + 10); }
        if (SITE(12) && IN(pb + 11)) { SITE_IDS; pg8::Gemm g{ACT, (const bf16*)(ws + WS_WD) + (size_t)(2 * l + 1) * 2048 * 5632, M, D, DFF, DFF, 0}; pg8::StaticOrder S; S.init(NPR, NSR, D, DFF, G, bx, KS_G2, 4);
            const float* ng1 = ap->in[I_NORMG] + (size_t)3 * D; const float* mod1 = (const float*)(ws + WS_MOD) + MODL;
            pg8::EpiRes<false> E{h, hS, h, modl + 8 * D, nullptr, nullptr, SLAB, l == 0 ? HN : nullptr, ng1, mod1 + 1 * D, l == 0 ? SSP + (size_t)2 * M * 32 : nullptr, 0.5f, 0};
            if ((DUP_MASK >> 5) & 1u) { pg8::EpiRes<false> E2 = E; E2.out = (bf16*)(ws + WS_DUMMY); E2.an = nullptr; E2.ss = nullptr; pg8::gemm_phase<pg8::EpiRes<false>, true>(lds, g, S, E2); }
            pg8::gemm_phase<pg8::EpiRes<false>, true>(lds, g, S, E);
            if (l == 0 && vcu >= S.nTail) sb_gemv(lds, (const bf16*)(ws + WS_WGU) + (size_t)2 * 11264 * 2048, 11264, mod1 + 0 * D, (float*)(ws + WS_SB) + (size_t)2 * 12 * 11264, (vcu - S.nTail) * NWAVES + wave, (G - S.nTail) * NWAVES, tid, lane);
            SEAM(pb + 11); }
        if (SITE(12) && IN(pb + 12)) { SITE_IDS; const float* ng1 = ap->in[I_NORMG] + (size_t)3 * D; const float* mod1 = (const float*)(ws + WS_MOD) + MODL;
            if (l == 0) slab_reduce(hS, 0, hS, SLAB, KS_G2, HN, ng1, mod1 + 1 * D, SSQ + (size_t)2 * M, gw, NGW, lane);
            if (l == 0) ss_finalize(SSP + (size_t)2 * M * 32, SSQ + (size_t)2 * M, NPR, gtid, G * NWAVES * 64);
            if (l == 0) SEAM(pb + 12); }
    }
    { const int l = 0; if (SITE(13) && IN(NPH - 1)) { SITE_IDS;
        static_assert(NGW == 2048 && NSR * 4 == NGW && NPR == 512 * 64, "row dealing of the final phase");
        const int q4 = gw & 3, r0 = (gw >> 2) * 64 + (q4 == 0 ? 0 : 10 + 18 * (q4 - 1)), r1 = r0 + (q4 == 0 ? 10 : 18);
        if (q4 == 0) slab_reduce_final(hS, SLAB, KS_G2, ap->out, ap->in[I_FNORMG], gw >> 2, lane);
        final_norm(h, ap->out, ap->in[I_FNORMG], r0, r1, lane); } }
#undef IN
#undef SEAM
#undef SITE
#undef SITE_IDS
}

extern "C" void kernel_launch(void* const* d_in, const int* in_sizes, int n_in, void* d_out, int out_size, void* d_ws, size_t ws_size, hipStream_t stream) {
    static int grid = 0;
    if (grid == 0) {
        if (n_in != 25 || in_sizes[0] != NPR * D || (size_t)out_size != O_END || ws_size < WS_END) { fprintf(stderr, "kernel_launch: unexpected shapes (n_in %d, in0 %d, out %d, ws %zu); nothing launched\n", n_in, n_in > 0 ? in_sizes[0] : -1, out_size, ws_size); grid = -1; return; }
        int dev = 0, cus = 0, per_cu = 0;
        if (hipGetDevice(&dev) != hipSuccess || hipDeviceGetAttribute(&cus, hipDeviceAttributeMultiprocessorCount, dev) != hipSuccess) { fprintf(stderr, "kernel_launch: device query failed\n"); grid = -1; return; }
        if (hipFuncSetAttribute((const void*)mk_fwd, hipFuncAttributeMaxDynamicSharedMemorySize, LDS_BYTES) != hipSuccess) { fprintf(stderr, "kernel_launch: hipFuncSetAttribute failed\n"); grid = -1; return; }
        if (hipOccupancyMaxActiveBlocksPerMultiprocessor(&per_cu, (const void*)mk_fwd, NWAVES * 64, LDS_BYTES) != hipSuccess || per_cu < 1) fprintf(stderr, "kernel_launch: note: occupancy query reports %d workgroups per CU\n", per_cu);
        (void)hipGetLastError();
        if (cus != NCU) fprintf(stderr, "kernel_launch: built for a %d-CU device (one workgroup per CU), this one reports %d\n", NCU, cus);
        grid = NCU;
    }
    if (grid < 0) return;
    if (hipMemsetAsync((char*)d_ws + WS_CTL, 0, CTL_ZERO_BYTES, stream) != hipSuccess) { fprintf(stderr, "kernel_launch: memset failed\n"); return; }
    Args a{};
    for (int i = 0; i < 25; ++i) a.in[i] = (const float*)d_in[i];
    a.out = (float*)d_out; a.ws = (unsigned char*)d_ws;
#if MK_N_LAUNCHES == 1
    a.ph_lo = 0; a.ph_hi = NPH;
    hipLaunchKernelGGL(mk_fwd, dim3(grid), dim3(NWAVES * 64), LDS_BYTES, stream, a);
#else
    for (int p = 0; p < NPH; ++p) { if (p == 2 + 4 || p == 2 + 9 || p == 2 + NPL + 0 || p == 2 + NPL + 5 || p == 2 + NPL + 6 || p == 2 + NPL + 9) continue; a.ph_lo = p; a.ph_hi = p + 1; hipLaunchKernelGGL(mk_fwd, dim3(grid), dim3(NWAVES * 64), LDS_BYTES, stream, a); }
#endif
    const hipError_t le = hipPeekAtLastError();
    if (le != hipSuccess) fprintf(stderr, "kernel_launch: launch failed: %s\n", hipGetErrorName(le));
}
```
